# Optimizing an MI355X kernel written in HIP

```python
import math
import jax, jax.numpy as jnp
from jax import lax
import numpy as np

D_MODEL = 2048
BATCH = 4
SEQ = 2048
DEPTH = 2
DEC_BATCH = 128
DEC_SEQ = 8
PAST_LEN = 8192
PAGE_SIZE = 128

N_META = 16
N_MIXERS = 2
N_HGRN_LAYERS = (DEPTH + 1) // 2
N_SWA_LAYERS = DEPTH // 2
HGRN_EXPAND = 128
HGRN_WIDTH = D_MODEL
HGRN_HEADS = HGRN_WIDTH // HGRN_EXPAND
HGRN_DK = HGRN_EXPAND
HGRN_DV = HGRN_WIDTH // HGRN_HEADS
HGRN_CHUNK = 64
SWA_HEAD_DIM = 64
SWA_Q_HEADS = D_MODEL // SWA_HEAD_DIM
SWA_KV_HEADS = SWA_Q_HEADS // 8
SWA_GROUP = SWA_Q_HEADS // SWA_KV_HEADS
SWA_WIDTH = SWA_Q_HEADS * SWA_HEAD_DIM
SWA_KV_WIDTH = SWA_KV_HEADS * SWA_HEAD_DIM
SWA_SCALE = SWA_HEAD_DIM ** -0.5
WINDOW = 128
SWA_BLOCK = 128
DEEPNORM_ALPHA = (2.0 * DEPTH) ** 0.25
DEEPNORM_BETA = (8.0 * DEPTH) ** -0.25
LN_EPS = 1e-5
RMS_EPS = 1e-6

kernel_name = 'hybrid_hgrn2_swa_sink_deepnorm_step'


def layer_norm(x, g, b):
    mu = jnp.mean(x, axis=-1, keepdims=True)
    var = jnp.mean(jnp.square(x - mu), axis=-1, keepdims=True)
    return (x - mu) * lax.rsqrt(var + LN_EPS) * g.astype(jnp.float32) + b.astype(jnp.float32)


def hgrn_chunk(q, logf, k, v, s0):
    c = q.shape[1]
    b = jnp.cumsum(logf, axis=1)
    causal = jnp.tril(jnp.ones((c, c), dtype=bool))[None, :, :, None, None]
    diff = jnp.where(causal, b[:, :, None] - b[:, None, :], -jnp.inf)
    a = jnp.sum(q[:, :, None] * jnp.exp(diff) * k[:, None, :], axis=-1)
    o = (jnp.einsum('bthk,bhkv->bthv', q * jnp.exp(b), s0)
         + jnp.einsum('btsh,bshv->bthv', a, v))
    b_last = b[:, -1]
    s_new = (jnp.exp(b_last)[..., None] * s0
             + jnp.einsum('bshk,bshv->bhkv', k * jnp.exp(b_last[:, None] - b), v))
    return o, s_new


def hgrn_branch(xin, w_in, lb, norm_w, w_out, s0, n_lead, chunk):
    bsz, t, _ = xin.shape
    h = jnp.einsum('btd,de->bte', xin, w_in.astype(jnp.float32))
    q, fx, i_in, g = jnp.split(h, 4, axis=-1)
    heads = lambda a: a.reshape(bsz, t, HGRN_HEADS, -1)
    f = lb + (1.0 - lb) * jax.nn.sigmoid(heads(fx))
    q, logf, k, v = heads(q), jnp.log(f), 1.0 - f, heads(i_in)
    outs = []
    s = s0
    if n_lead > 0:
        o_lead, s = hgrn_chunk(q[:, :n_lead], logf[:, :n_lead], k[:, :n_lead], v[:, :n_lead], s)
        outs.append(o_lead)
    rest = t - n_lead
    nc = rest // chunk
    blocks = tuple(a[:, n_lead:].reshape(bsz, nc, chunk, HGRN_HEADS, -1).swapaxes(0, 1)
                   for a in (q, logf, k, v))

    def step(state, blk):
        o_blk, state = hgrn_chunk(*blk, state)
        return state, o_blk

    s, o_blocks = lax.scan(step, s, blocks)
    outs.append(o_blocks.swapaxes(0, 1).reshape(bsz, rest, HGRN_HEADS, HGRN_DV))
    o = jnp.concatenate(outs, axis=1)
    o = o * lax.rsqrt(jnp.mean(jnp.square(o), axis=-1, keepdims=True) + RMS_EPS) * norm_w.astype(jnp.float32)
    o = o.reshape(bsz, t, HGRN_WIDTH) * jax.nn.silu(g)
    y = jnp.einsum('bte,ed->btd', o, w_out.astype(jnp.float32))
    return y, s


def swa_project(xin, w_in):
    bsz, t, _ = xin.shape
    h = jnp.einsum('btd,de->bte', xin, w_in.astype(jnp.float32))
    q, k, v, g = jnp.split(h, [SWA_WIDTH, SWA_WIDTH + SWA_KV_WIDTH, SWA_WIDTH + 2 * SWA_KV_WIDTH], axis=-1)
    q = q.reshape(bsz, t, SWA_KV_HEADS, SWA_GROUP, SWA_HEAD_DIM)
    k = k.reshape(bsz, t, SWA_KV_HEADS, SWA_HEAD_DIM)
    v = v.reshape(bsz, t, SWA_KV_HEADS, SWA_HEAD_DIM)
    return q, k, v, g


def sink_attention(q, k, v, mask, sinks):
    s = jnp.einsum('bnqhgd,bnshd->bnhgqs', q, k) * SWA_SCALE
    s = jnp.where(mask[None, :, None, None], s, -jnp.inf)
    sink = sinks.astype(jnp.float32)[None, None, :, :, None, None]
    m = jnp.maximum(jnp.max(s, axis=-1, keepdims=True), sink)
    p = jnp.exp(s - m)
    p = p / (jnp.sum(p, axis=-1, keepdims=True) + jnp.exp(sink - m))
    return jnp.einsum('bnhgqs,bnshd->bnqhgd', p, v)


def swa_output(o, g, w_out):
    return jnp.einsum('bte,ed->btd', o * jax.nn.silu(g), w_out.astype(jnp.float32))


def swa_prompt(xin, w_in, sinks, w_out):
    bsz, t, _ = xin.shape
    q, k, v, g = swa_project(xin, w_in)
    nb = -(-t // SWA_BLOCK)
    pad = nb * SWA_BLOCK - t

    def blocks(a):
        a = jnp.pad(a, ((0, 0), (0, pad)) + ((0, 0),) * (a.ndim - 2))
        return a.reshape((bsz, nb, SWA_BLOCK) + a.shape[2:])

    def band(a):
        ab = blocks(a)
        prev = jnp.concatenate([jnp.zeros_like(ab[:, :1]), ab[:, :-1]], axis=1)
        return jnp.concatenate([prev, ab], axis=2)

    qb = blocks(q)
    kb, vb = band(k), band(v)
    qi = jnp.arange(SWA_BLOCK)[:, None]
    kj = jnp.arange(2 * SWA_BLOCK)[None, :]
    dist = SWA_BLOCK + qi - kj
    in_window = (dist >= 0) & (dist < WINDOW)
    kpos = (jnp.arange(nb)[:, None] - 1) * SWA_BLOCK + kj
    mask = in_window[None] & (kpos >= 0)[:, None, :]
    o = sink_attention(qb, kb, vb, mask, sinks.reshape(SWA_KV_HEADS, SWA_GROUP))
    o = o.reshape(bsz, nb * SWA_BLOCK, SWA_WIDTH)[:, :t]
    y = swa_output(o, g, w_out)
    return y, k[:, t - WINDOW:], v[:, t - WINDOW:]


def swa_sample(xin, cache_k, cache_v, w_in, sinks, w_out):
    bsz, t, _ = xin.shape
    q, k, v, g = swa_project(xin, w_in)
    keys = jnp.concatenate([cache_k.astype(jnp.float32), k], axis=1)
    vals = jnp.concatenate([cache_v.astype(jnp.float32), v], axis=1)
    qi = jnp.arange(t)[:, None]
    kj = jnp.arange(WINDOW + t)[None, :]
    dist = WINDOW + qi - kj
    mask = ((dist >= 0) & (dist < WINDOW))[None]
    o = sink_attention(q[:, None], keys[:, None], vals[:, None], mask,
                       sinks.reshape(SWA_KV_HEADS, SWA_GROUP))
    o = o.reshape(bsz, t, SWA_WIDTH)
    y = swa_output(o, g, w_out)
    return y, keys[:, -WINDOW:], vals[:, -WINDOW:]


def setup_inputs(seed: int = 0) -> dict:
    key = jax.random.key(seed)
    ks = jax.random.split(key, 16)
    nrm = jax.random.normal
    f32 = jnp.float32
    swa_in_width = 2 * SWA_WIDTH + 2 * SWA_KV_WIDTH
    return {
        'x_prompt': nrm(ks[0], (BATCH, SEQ, D_MODEL), f32),
        'x_sample': nrm(ks[1], (DEC_BATCH, DEC_SEQ, D_MODEL), f32),
        'state_hgrn': 0.5 * nrm(ks[2], (N_HGRN_LAYERS, DEC_BATCH, HGRN_HEADS, HGRN_DK, HGRN_DV), f32),
        'cache_swa_k': nrm(ks[3], (N_SWA_LAYERS, DEC_BATCH, WINDOW, SWA_KV_HEADS, SWA_HEAD_DIM), f32),
        'cache_swa_v': nrm(ks[4], (N_SWA_LAYERS, DEC_BATCH, WINDOW, SWA_KV_HEADS, SWA_HEAD_DIM), f32),
        'meta_tokens': nrm(ks[5], (N_META, D_MODEL), f32),
        'hgrn_w_in': nrm(ks[6], (N_HGRN_LAYERS, D_MODEL, 4 * HGRN_WIDTH), f32) * D_MODEL ** -0.5,
        'hgrn_lb_logits': 0.1 * nrm(ks[7], (DEPTH + 1, HGRN_WIDTH), f32),
        'hgrn_norm_w': 1.0 + 0.02 * nrm(ks[8], (N_HGRN_LAYERS, HGRN_HEADS, HGRN_DV), f32),
        'hgrn_w_out': nrm(ks[9], (N_HGRN_LAYERS, HGRN_WIDTH, D_MODEL), f32) * (HGRN_WIDTH ** -0.5 * DEEPNORM_BETA),
        'swa_w_in': nrm(ks[10], (N_SWA_LAYERS, D_MODEL, swa_in_width), f32) * D_MODEL ** -0.5,
        'swa_sinks': 0.5 * nrm(ks[11], (N_SWA_LAYERS, SWA_Q_HEADS), f32),
        'swa_w_out': nrm(ks[12], (N_SWA_LAYERS, SWA_WIDTH, D_MODEL), f32) * (SWA_WIDTH ** -0.5 * DEEPNORM_BETA),
        'ln_g': 1.0 + 0.02 * nrm(ks[13], (DEPTH, D_MODEL), f32),
        'ln_b': 0.02 * nrm(ks[14], (DEPTH, D_MODEL), f32),
    }


def reference(x_prompt, x_sample, state_hgrn, cache_swa_k, cache_swa_v, meta_tokens,
              hgrn_w_in, hgrn_lb_logits, hgrn_norm_w, hgrn_w_out,
              swa_w_in, swa_sinks, swa_w_out, ln_g, ln_b):
    out_dtype = x_prompt.dtype
    f32 = jnp.float32
    bsz = x_prompt.shape[0]
    meta = jnp.broadcast_to(meta_tokens.astype(f32)[None], (bsz, N_META, D_MODEL))
    xp = jnp.concatenate([meta, x_prompt.astype(f32)], axis=1)
    xs = x_sample.astype(f32)
    lb_all = jnp.cumsum(jax.nn.softmax(hgrn_lb_logits.astype(f32), axis=0), axis=0)
    st_p, st_s, kp, vp, ksm, vsm = [], [], [], [], [], []
    for i in range(DEPTH):
        j = i // N_MIXERS
        if i % N_MIXERS == 0:
            lb = lb_all[i].reshape(HGRN_HEADS, HGRN_DK)
            s0p = jnp.zeros((bsz, HGRN_HEADS, HGRN_DK, HGRN_DV), f32)
            yp, sp = hgrn_branch(xp, hgrn_w_in[j], lb, hgrn_norm_w[j], hgrn_w_out[j], s0p, N_META, HGRN_CHUNK)
            ys, ss = hgrn_branch(xs, hgrn_w_in[j], lb, hgrn_norm_w[j], hgrn_w_out[j],
                                 state_hgrn[j].astype(f32), 0, xs.shape[1])
            st_p.append(sp)
            st_s.append(ss)
        else:
            yp, kpr, vpr = swa_prompt(xp, swa_w_in[j], swa_sinks[j], swa_w_out[j])
            ys, ksr, vsr = swa_sample(xs, cache_swa_k[j], cache_swa_v[j], swa_w_in[j], swa_sinks[j], swa_w_out[j])
            kp.append(kpr)
            vp.append(vpr)
            ksm.append(ksr)
            vsm.append(vsr)
        xp = layer_norm(DEEPNORM_ALPHA * xp + yp, ln_g[i], ln_b[i])
        xs = layer_norm(DEEPNORM_ALPHA * xs + ys, ln_g[i], ln_b[i])
    y_prompt = xp[:, N_META:].astype(out_dtype)
    y_sample = xs.astype(out_dtype)
    new_state_hgrn_prompt = jnp.stack(st_p).astype(out_dtype)
    new_state_hgrn_sample = jnp.stack(st_s).astype(out_dtype)
    new_cache_swa_k_prompt = jnp.stack(kp).astype(out_dtype)
    new_cache_swa_v_prompt = jnp.stack(vp).astype(out_dtype)
    new_cache_swa_k_sample = jnp.stack(ksm).astype(out_dtype)
    new_cache_swa_v_sample = jnp.stack(vsm).astype(out_dtype)
    return (y_prompt, y_sample, new_state_hgrn_prompt, new_state_hgrn_sample,
            new_cache_swa_k_prompt, new_cache_swa_v_prompt, new_cache_swa_k_sample, new_cache_swa_v_sample)
```

```cpp
#include <hip/hip_runtime.h>
#include <hip/hip_cooperative_groups.h>
#include <cstdio>
#include <cstdint>
namespace pg8 {
#define PG8_LAS __attribute__((address_space(3)))
typedef unsigned short bf16_t;
typedef short bf16x8 __attribute__((ext_vector_type(8)));
typedef float f32x4 __attribute__((ext_vector_type(4)));
typedef unsigned u32x4 __attribute__((ext_vector_type(4)));
constexpr int BM = 256, BK = 64, HALF = 128, HTB = HALF * BK * 2  , STAGE_BYTES = 8 * HTB, NXCD = 8, WGM = 8;

__host__ __device__ __forceinline__ int lds_byte(int r, int c) { const int st = (r >> 4) * 2 + (c >> 5), rr = r & 15, cc = c & 31, ob = rr * 64 + cc * 2; return st * 1024 + (ob ^ (((ob >> 9) & 1) << 5)); }
__host__ __device__ __forceinline__ void stage_rc(int b, int& R, int& C) { const int st = b / 1024, sb = b % 1024, swz = sb ^ (((sb >> 9) & 1) << 5); R = (st >> 1) * 16 + swz / 64; C = (st & 1) * 32 + (swz % 64) / 2; }
__host__ __device__ __forceinline__ int perm32(int rho) { const int n = rho >> 4, i = rho & 15; return 8 * (i >> 2) + 4 * n + (i & 3); }

struct Unit { int pm, pn; };
struct Gemm { const bf16_t* A; const bf16_t* Bt; int M, N, K; };

struct StaticOrder {
    int nM, nN, nwg, G, c;
    __host__ __device__ void init(int M, int N, int G_, int c_) { nM = M / BM; nN = N / BM; nwg = nM * nN; G = G_; c = c_; }
    __host__ __device__ bool next(int i, Unit& u) const {
        const long L = (long)i * G + c; if (L >= nwg) return false;
        int wgid = (int)L; { const int q = nwg / NXCD, r = nwg % NXCD, xcd = wgid % NXCD, off = wgid / NXCD; wgid = (xcd < r ? xcd * (q + 1) : r * (q + 1) + (xcd - r) * q) + off; }
        const int nig = WGM * nN, gid = wgid / nig, fm = gid * WGM, gsz = (nM - fm) < WGM ? (nM - fm) : WGM;
        u.pm = fm + ((wgid % nig) % gsz); u.pn = (wgid % nig) / gsz; return true;
    }
    __device__ __forceinline__ void a_ready(const Unit&) const {}
    __device__ __forceinline__ void done(const Unit&) const {}
};
__device__ __forceinline__ unsigned cvt_pk_bf16(float lo, float hi) { unsigned r; asm volatile("v_cvt_pk_bf16_f32 %0, %1, %2" : "=v"(r) : "v"(lo), "v"(hi)); return r; }
template <class Epi, class Sched, bool STAMP = false>
__device__ __forceinline__ void gemm_phase(PG8_LAS unsigned char* lds, const Gemm g, const Sched& S, const Epi& E, unsigned long long* stamps) {
    const int tid = threadIdx.x, wid = __builtin_amdgcn_readfirstlane(tid >> 6), lane = tid & 63, wr = wid >> 2, wc = wid & 3, fr = lane & 15, fq = lane >> 4;
    const int K = g.K, nt = K / BK;
    int ts_lo = 0, ts_hi = 0, nts = 0; const unsigned long long rt_entry = STAMP ? (unsigned long long)wall_clock64() : 0ull;
#define PG8_STAMP() do { if (STAMP && wid == 0 && nts < 64) { const unsigned long long _c = (unsigned long long)clock64(); \
        ts_lo = (lane == nts) ? (int)(unsigned)_c : ts_lo; ts_hi = (lane == nts) ? (int)(unsigned)(_c >> 32) : ts_hi; ++nts; } } while (0)
    PG8_STAMP();
    unsigned voffA[2], voffB[2];
#pragma unroll
    for (int i = 0; i < 2; ++i) { int R, C; stage_rc(tid * 16 + i * 8192, R, C); const int Rb = Epi::PERM ? ((R & ~31) + perm32(R & 31)) : R;
        voffA[i] = (unsigned)(R * K + C) * 2u; voffB[i] = (unsigned)(Rb * K + C) * 2u; }
    const size_t kstep = (size_t)(BK * 2);
    const size_t hstep = (size_t)HALF * K * 2;
    const size_t tstep = 2 * hstep;
    const unsigned ldsw = (unsigned)wid * 1024u;
    const int aoff = lds_byte(wr * 64 + fr, fq * 8), boff = lds_byte(wc * 32 + fr, fq * 8);
#define PG8_SA(b, h) (((b) * 2 + (h)) * HTB)
#define PG8_SB(b, h) ((4 + (b) * 2 + (h)) * HTB)
#define PG8_STAGE(bufoff, gbase, voff) do { _Pragma("unroll") for (int _i = 0; _i < 2; ++_i) \
        __builtin_amdgcn_global_load_lds((const unsigned*)((const char*)(gbase) + (voff)[_i]), (PG8_LAS unsigned*)(lds + (bufoff) + ldsw + _i * 8192), 16, 0, 0); } while (0)
#define PG8_LDA(dst, b, h) do { _Pragma("unroll") for (int m = 0; m < 4; ++m) _Pragma("unroll") for (int k = 0; k < 2; ++k) dst[m][k] = *(const PG8_LAS bf16x8*)(lds + PG8_SA(b, h) + aoff + m * 2048 + k * 1024); } while (0)
#define PG8_LDB(dst, b, h) do { _Pragma("unroll") for (int n = 0; n < 2; ++n) _Pragma("unroll") for (int k = 0; k < 2; ++k) dst[n][k] = *(const PG8_LAS bf16x8*)(lds + PG8_SB(b, h) + boff + n * 2048 + k * 1024); } while (0)
#define PG8_MMA(ai, bj, At, Bt) do { __builtin_amdgcn_s_setprio(1); _Pragma("unroll") for (int m = 0; m < 4; ++m) _Pragma("unroll") for (int n = 0; n < 2; ++n) _Pragma("unroll") for (int k = 0; k < 2; ++k) \
        acc[ai][bj][m][n] = __builtin_amdgcn_mfma_f32_16x16x32_bf16(Bt[n][k], At[m][k], acc[ai][bj][m][n], 0, 0, 0); __builtin_amdgcn_s_setprio(0); } while (0)
#define PG8_WAIT_V(n) asm volatile("s_waitcnt vmcnt(" #n ")" ::: "memory")
#define PG8_WAIT_L(n) asm volatile("s_waitcnt lgkmcnt(" #n ")" ::: "memory")
#define PG8_BAR __builtin_amdgcn_s_barrier()
#define PG8_SCHED __builtin_amdgcn_sched_barrier(0)
    Unit cur, nxt; int ui = 0;
    if (!S.next(0, cur)) return;
    f32x4 acc[2][2][4][2];
#pragma unroll
    for (int a = 0; a < 2; ++a)
#pragma unroll
        for (int b = 0; b < 2; ++b)
#pragma unroll
            for (int m = 0; m < 4; ++m)
#pragma unroll
                for (int n = 0; n < 2; ++n) acc[a][b][m][n] = (f32x4){0.f, 0.f, 0.f, 0.f};
    bf16x8 At[4][2], B0[2][2], B1[2][2];
    const char* cA = (const char*)g.A + (size_t)cur.pm * tstep; const char* cB = (const char*)g.Bt + (size_t)cur.pn * tstep;
    S.a_ready(cur);
    PG8_STAGE(PG8_SB(0, 0), cB, voffB); PG8_STAGE(PG8_SA(0, 0), cA, voffA); PG8_STAGE(PG8_SB(0, 1), cB + hstep, voffB); PG8_STAGE(PG8_SA(0, 1), cA + hstep, voffA);
    if (wr == 1) PG8_BAR;
    PG8_WAIT_V(4); PG8_BAR;
    PG8_STAGE(PG8_SB(1, 0), cB + kstep, voffB); PG8_STAGE(PG8_SA(1, 0), cA + kstep, voffA); PG8_STAGE(PG8_SB(1, 1), cB + hstep + kstep, voffB);
    PG8_WAIT_V(6); PG8_BAR;
    PG8_STAMP();
    for (;;) {
        const bool has_next = S.next(ui + 1, nxt);
        const char* nA = has_next ? (const char*)g.A + (size_t)nxt.pm * tstep : cA; const char* nB = has_next ? (const char*)g.Bt + (size_t)nxt.pn * tstep : cB;
        for (int t = 0; t < nt; t += 2) {
            const bool last = (t == nt - 2);
            const char* a1 = cA + (size_t)(t + 1) * kstep;
            const char* a2 = last ? nA : cA + (size_t)(t + 2) * kstep; const char* b2 = last ? nB : cB + (size_t)(t + 2) * kstep;
            const char* a3 = a2 + kstep; const char* b3 = b2 + kstep;
            if (last && has_next) S.a_ready(nxt);
            PG8_LDB(B0, 0, 0); PG8_SCHED; PG8_LDA(At, 0, 0); PG8_STAGE(PG8_SA(1, 1), a1 + hstep, voffA);
            PG8_WAIT_L(8); PG8_BAR; PG8_WAIT_L(0); PG8_MMA(0, 0, At, B0); PG8_BAR; PG8_SCHED;
            PG8_LDB(B1, 0, 1); PG8_STAGE(PG8_SB(0, 0), b2, voffB);
            PG8_BAR; PG8_WAIT_L(0); PG8_MMA(0, 1, At, B1); PG8_BAR;
            PG8_LDA(At, 0, 1); PG8_STAGE(PG8_SA(0, 0), a2, voffA);
            PG8_BAR; PG8_WAIT_L(0); PG8_MMA(1, 0, At, B0); PG8_BAR; PG8_SCHED;
            PG8_STAGE(PG8_SB(0, 1), b2 + hstep, voffB);
            PG8_WAIT_V(6); PG8_BAR; PG8_MMA(1, 1, At, B1); PG8_BAR;
            PG8_LDB(B0, 1, 0); PG8_SCHED; PG8_LDA(At, 1, 0); PG8_STAGE(PG8_SA(0, 1), a2 + hstep, voffA);
            PG8_WAIT_L(8); PG8_BAR; PG8_WAIT_L(0); PG8_MMA(0, 0, At, B0); PG8_BAR; PG8_SCHED;
            PG8_LDB(B1, 1, 1); PG8_STAGE(PG8_SB(1, 0), b3, voffB);
            PG8_BAR; PG8_WAIT_L(0); PG8_MMA(0, 1, At, B1); PG8_BAR;
            PG8_LDA(At, 1, 1); PG8_STAGE(PG8_SA(1, 0), a3, voffA);
            PG8_BAR; PG8_WAIT_L(0); PG8_MMA(1, 0, At, B0); PG8_BAR; PG8_SCHED;
            PG8_STAGE(PG8_SB(1, 1), b3 + hstep, voffB);
            PG8_WAIT_V(6); PG8_BAR; PG8_MMA(1, 1, At, B1); PG8_BAR;
        }
        PG8_STAMP();
        if constexpr (!Epi::AFTER_DRAIN) { E(acc, cur, wr, wc, fr, fq); S.done(cur); }
        PG8_STAMP();
        if (!has_next) break;
#pragma unroll
        for (int a = 0; a < 2; ++a)
#pragma unroll
            for (int b = 0; b < 2; ++b)
#pragma unroll
                for (int m = 0; m < 4; ++m)
#pragma unroll
                    for (int n = 0; n < 2; ++n) acc[a][b][m][n] = (f32x4){0.f, 0.f, 0.f, 0.f};
        cur = nxt; cA = nA; cB = nB; ++ui;
    }
    PG8_WAIT_V(0);
    if (wr == 0) PG8_BAR;
    PG8_BAR;
    if constexpr (Epi::AFTER_DRAIN) { E.fused(acc, cur, wr, wc, fr, fq, lds, wid, lane); S.done(cur); }
    PG8_STAMP();
    if (STAMP && wid == 0) { stamps[lane] = lane < nts ? (((unsigned long long)(unsigned)ts_hi << 32) | (unsigned)ts_lo) : 0ull;
        if (lane == 62) stamps[62] = rt_entry; if (lane == 63) stamps[63] = (unsigned long long)wall_clock64(); }
#undef PG8_STAMP
#undef PG8_SA
#undef PG8_SB
#undef PG8_STAGE
#undef PG8_LDA
#undef PG8_LDB
#undef PG8_MMA
#undef PG8_WAIT_V
#undef PG8_WAIT_L
#undef PG8_BAR
#undef PG8_SCHED
}
}
namespace cg = cooperative_groups;
using pg8::bf16_t; using pg8::bf16x8; using pg8::f32x4; using pg8::u32x4;
#define LAS __attribute__((address_space(3)))
typedef unsigned u32x2 __attribute__((ext_vector_type(2)));
typedef float f32x2v __attribute__((ext_vector_type(2)));

constexpr int D = 2048, TP = 2064, NBP = 4, MPR = NBP * TP, NBS = 128, TSM = 8, MSM = NBS * TSM, MTOT = MPR + MSM, MPAD = 9472;
constexpr float ALPHA = 1.41421356237309515f;
constexpr float LN_EPS = 1e-5f, RMS_EPS = 1e-6f;
constexpr int LDS_BYTES = 131072;
constexpr size_t OUT_YP = 0, OUT_YS = 16777216, OUT_SP = 18874368, OUT_SS = 19922944, OUT_KP = 53477376, OUT_VP = 53608448, OUT_KS = 53739520, OUT_VS = 57933824;
constexpr size_t SZ_BF = (size_t)MPAD * D * 2, SZ_F32 = (size_t)MPAD * D * 4;
constexpr size_t WS_WT0 = 0, WS_WTO0 = WS_WT0 + 33554432, WS_WT1 = WS_WTO0 + 8388608, WS_WTO1 = WS_WT1 + 18874368, WS_XB = WS_WTO1 + 8388608,
                 WS_QB = WS_XB + SZ_BF, WS_VB = WS_QB + SZ_BF, WS_GB = WS_VB + SZ_BF, WS_OB = WS_GB + SZ_BF, WS_LF = WS_OB + SZ_BF, WS_ZB = WS_LF + SZ_F32,
                 WS_K1 = WS_ZB + SZ_F32, WS_V1 = WS_K1 + 4849664, WS_LB = WS_V1 + 4849664, WS_END = WS_LB + 8192;

struct Params {
    const float *x_prompt, *x_sample, *state, *cache_k, *cache_v, *meta, *w_in0, *lb_logits, *norm_w, *w_out0, *w_in1, *sinks, *w_out1, *ln_g, *ln_b;
    float* out; unsigned char* ws;
};

__device__ __forceinline__ float bf2f(unsigned short b) { return __uint_as_float(((unsigned)b) << 16); }
__device__ __forceinline__ unsigned short f2bf(float f) { unsigned u = __float_as_uint(f); u += 0x7FFFu + ((u >> 16) & 1u); return (unsigned short)(u >> 16); }
__device__ __forceinline__ unsigned pk2(float lo, float hi) { return pg8::cvt_pk_bf16(lo, hi); }
__device__ __forceinline__ float sigmoidf_(float x) { return 1.0f / (1.0f + __expf(-x)); }
__device__ __forceinline__ float siluf_(float x) { return x / (1.0f + __expf(-x)); }
#define LDS_WAIT() asm volatile("s_waitcnt lgkmcnt(0)" ::: "memory")

__device__ __forceinline__ const float* xrow_ptr(const Params& p, int row) {
    if (row < MPR) { const int b = row / TP, t = row - b * TP; return t < 16 ? p.meta + (size_t)t * D : p.x_prompt + ((size_t)b * 2048 + (t - 16)) * D; }
    return p.x_sample + (size_t)(row - MPR) * D;
}

__device__ __forceinline__ void p0_transpose_item(const float* __restrict__ W, int K, int N, bf16_t* __restrict__ WT, LAS float* scr, int item, int lane) {
    const int nblk = N / 32, kb = item / nblk, nb = item % nblk, k0 = 64 * kb, n0 = 32 * nb;
#pragma unroll 8
    for (int i = 0; i < 32; ++i) { const int kk = 2 * i + (lane >> 5); scr[kk * 33 + (lane & 31)] = W[(size_t)(k0 + kk) * N + n0 + (lane & 31)]; }
    LDS_WAIT();
    const int c = lane & 7;
#pragma unroll
    for (int j = 0; j < 4; ++j) { const int n = (lane >> 3) + 8 * j; const LAS float* s = scr + (8 * c) * 33 + n;
        u32x4 o; o.x = pk2(s[0 * 33], s[1 * 33]); o.y = pk2(s[2 * 33], s[3 * 33]); o.z = pk2(s[4 * 33], s[5 * 33]); o.w = pk2(s[6 * 33], s[7 * 33]);
        *(u32x4*)(WT + (size_t)(n0 + n) * K + k0 + 8 * c) = o; }
    LDS_WAIT();
}

__device__ __forceinline__ void phase0(const Params& p, LAS unsigned char* lds) {
    const int tid = threadIdx.x, wave = tid >> 6, lane = tid & 63;
    const int gw = blockIdx.x * 8 + wave, NGW = gridDim.x * 8;
    LAS float* scr = (LAS float*)(lds + wave * 8448);
    constexpr int I0 = 32 * 256, I1 = 32 * 64, I2 = 32 * 144, I3 = 32 * 64;
    bf16_t* WT0 = (bf16_t*)(p.ws + WS_WT0); bf16_t* WTO0 = (bf16_t*)(p.ws + WS_WTO0); bf16_t* WT1 = (bf16_t*)(p.ws + WS_WT1); bf16_t* WTO1 = (bf16_t*)(p.ws + WS_WTO1);
    for (int it = gw; it < I0 + I1 + I2 + I3; it += NGW) {
        int r = it;
        if (r < I0) { p0_transpose_item(p.w_in0, 2048, 8192, WT0, scr, r, lane); continue; } r -= I0;
        if (r < I1) { p0_transpose_item(p.w_out0, 2048, 2048, WTO0, scr, r, lane); continue; } r -= I1;
        if (r < I2) { p0_transpose_item(p.w_in1, 2048, 4608, WT1, scr, r, lane); continue; } r -= I2;
        p0_transpose_item(p.w_out1, 2048, 2048, WTO1, scr, r, lane);
    }
    bf16_t* XB = (bf16_t*)(p.ws + WS_XB);
    for (int m = gw; m < MTOT; m += NGW) {
        const f32x4* src = (const f32x4*)xrow_ptr(p, m) + lane; u32x2* dst = (u32x2*)(XB + (size_t)m * D) + lane;
#pragma unroll
        for (int j = 0; j < 8; ++j) { const f32x4 v = src[64 * j]; u32x2 o; o.x = pk2(v.x, v.y); o.y = pk2(v.z, v.w); dst[64 * j] = o; }
    }
    const int gt = blockIdx.x * 512 + tid, NGT = gridDim.x * 512;
    float* LB = (float*)(p.ws + WS_LB);
    for (int c = gt; c < D; c += NGT) { const float a = p.lb_logits[c], b = p.lb_logits[D + c], cc = p.lb_logits[2 * D + c]; const float m = fmaxf(a, fmaxf(b, cc));
        const float ea = __expf(a - m), eb = __expf(b - m), ec = __expf(cc - m); LB[c] = ea / (ea + eb + ec); }
    { const f32x4* ck = (const f32x4*)p.cache_k; const f32x4* cv = (const f32x4*)p.cache_v; f32x4* ok = (f32x4*)(p.out + OUT_KS); f32x4* ov = (f32x4*)(p.out + OUT_VS);
      constexpr int PER_B = 120 * 64;
      for (int i = gt; i < NBS * PER_B; i += NGT) { const int b = i / PER_B, r = i - b * PER_B; ok[(size_t)b * 8192 + r] = ck[(size_t)b * 8192 + 512 + r]; ov[(size_t)b * 8192 + r] = cv[(size_t)b * 8192 + 512 + r]; } }
}

struct EpiHgrnIn {
    static constexpr bool PERM = true, AFTER_DRAIN = false;
    unsigned char* ws; float* LF; const float* LB;
    __device__ __forceinline__ void operator()(const f32x4 (&acc)[2][2][4][2], const pg8::Unit& u, int wr, int wc, int fr, int fq) const {
        const int sec = u.pn >> 3, colt = (u.pn & 7) * 256;
        const size_t secoff = sec == 0 ? WS_QB : (sec == 2 ? WS_VB : WS_GB);
        bf16_t* dst = (bf16_t*)(ws + secoff);
        const int row0 = u.pm * 256 + wr * 64 + fr, col0 = colt + wc * 32 + 8 * fq;
        float lb[2][8];
        if (sec == 1) {
#pragma unroll
            for (int bj = 0; bj < 2; ++bj) { const f32x4 a = *(const f32x4*)(LB + col0 + bj * 128), b = *(const f32x4*)(LB + col0 + bj * 128 + 4);
                lb[bj][0] = a.x; lb[bj][1] = a.y; lb[bj][2] = a.z; lb[bj][3] = a.w; lb[bj][4] = b.x; lb[bj][5] = b.y; lb[bj][6] = b.z; lb[bj][7] = b.w; }
        }
#pragma unroll
        for (int ai = 0; ai < 2; ++ai)
#pragma unroll
            for (int m = 0; m < 4; ++m) {
                const int row = row0 + ai * 128 + m * 16; if (row >= MTOT) continue;
#pragma unroll
                for (int bj = 0; bj < 2; ++bj) {
                    const size_t off = (size_t)row * D + col0 + bj * 128;
                    const f32x4 v0 = acc[ai][bj][m][0], v1 = acc[ai][bj][m][1];
                    float x[8] = {v0.x, v0.y, v0.z, v0.w, v1.x, v1.y, v1.z, v1.w};
                    if (sec == 1) {
#pragma unroll
                        for (int j = 0; j < 8; ++j) { const float l = lb[bj][j]; x[j] = __logf(l + (1.0f - l) * sigmoidf_(x[j])); }
                        *(f32x4*)(LF + off) = (f32x4){x[0], x[1], x[2], x[3]}; *(f32x4*)(LF + off + 4) = (f32x4){x[4], x[5], x[6], x[7]};
                    } else {
                        if (sec == 3) {
#pragma unroll
                            for (int j = 0; j < 8; ++j) x[j] = siluf_(x[j]);
                        }
                        u32x4 w; w.x = pk2(x[0], x[1]); w.y = pk2(x[2], x[3]); w.z = pk2(x[4], x[5]); w.w = pk2(x[6], x[7]);
                        *(u32x4*)(dst + off) = w;
                    }
                }
            }
    }
};
struct EpiSwaIn {
    static constexpr bool PERM = true, AFTER_DRAIN = false;
    bf16_t* Q; bf16_t* K1; bf16_t* V1; bf16_t* G; float* out;
    __device__ __forceinline__ void operator()(const f32x4 (&acc)[2][2][4][2], const pg8::Unit& u, int wr, int wc, int fr, int fq) const {
        const int pn = u.pn;
        const int row0 = u.pm * 256 + wr * 64 + fr, cw = wc * 32 + 8 * fq;
#pragma unroll
        for (int ai = 0; ai < 2; ++ai)
#pragma unroll
            for (int m = 0; m < 4; ++m) {
                const int row = row0 + ai * 128 + m * 16; if (row >= MTOT) continue;
#pragma unroll
                for (int bj = 0; bj < 2; ++bj) {
                    const f32x4 v0 = acc[ai][bj][m][0], v1 = acc[ai][bj][m][1];
                    float x[8] = {v0.x, v0.y, v0.z, v0.w, v1.x, v1.y, v1.z, v1.w};
                    const int c = cw + bj * 128;
                    if (pn < 8) {
                        u32x4 w; w.x = pk2(x[0] * 0.125f, x[1] * 0.125f); w.y = pk2(x[2] * 0.125f, x[3] * 0.125f); w.z = pk2(x[4] * 0.125f, x[5] * 0.125f); w.w = pk2(x[6] * 0.125f, x[7] * 0.125f);
                        *(u32x4*)(Q + (size_t)row * D + pn * 256 + c) = w;
                    } else if (pn >= 10) {
#pragma unroll
                        for (int j = 0; j < 8; ++j) x[j] = siluf_(x[j]);
                        u32x4 w; w.x = pk2(x[0], x[1]); w.y = pk2(x[2], x[3]); w.z = pk2(x[4], x[5]); w.w = pk2(x[6], x[7]);
                        *(u32x4*)(G + (size_t)row * D + (pn - 10) * 256 + c) = w;
                    } else {
                        u32x4 w; w.x = pk2(x[0], x[1]); w.y = pk2(x[2], x[3]); w.z = pk2(x[4], x[5]); w.w = pk2(x[6], x[7]);
                        bf16_t* dst = pn == 8 ? K1 : V1;
                        *(u32x4*)(dst + (size_t)row * 256 + c) = w;
                        float* co = nullptr;
                        if (row < MPR) { const int b = row / TP, t = row - b * TP; if (t >= TP - 128) co = out + (pn == 8 ? OUT_KP : OUT_VP) + ((size_t)b * 128 + (t - (TP - 128))) * 256 + c; }
                        else { const int r = row - MPR, b = r >> 3, t = r & 7; co = out + (pn == 8 ? OUT_KS : OUT_VS) + ((size_t)b * 128 + 120 + t) * 256 + c; }
                        if (co) { *(f32x4*)co = v0; *(f32x4*)(co + 4) = v1; }
                    }
                }
            }
    }
};
template <int LAYER> struct EpiOut {
    static constexpr bool PERM = false, AFTER_DRAIN = false;
    float* Z; Params p;
    __device__ __forceinline__ void operator()(const f32x4 (&acc)[2][2][4][2], const pg8::Unit& u, int wr, int wc, int fr, int fq) const {
        const int row0 = u.pm * 256 + wr * 64 + fr, col0 = u.pn * 256 + wc * 32 + 4 * fq;
#pragma unroll
        for (int ai = 0; ai < 2; ++ai)
#pragma unroll
            for (int m = 0; m < 4; ++m) {
                const int row = row0 + ai * 128 + m * 16; if (row >= MTOT) continue;
                float* zr = Z + (size_t)row * D + col0;
                const float* xr = LAYER == 0 ? xrow_ptr(p, row) + col0 : zr;
#pragma unroll
                for (int bj = 0; bj < 2; ++bj)
#pragma unroll
                    for (int n = 0; n < 2; ++n) { const f32x4 x = *(const f32x4*)(xr + bj * 128 + n * 16); *(f32x4*)(zr + bj * 128 + n * 16) = x * ALPHA + acc[ai][bj][m][n]; }
            }
    }
};

template <int MODE> __device__ __forceinline__ void phase_ln(const Params& p, int layer) {
    const int tid = threadIdx.x, wave = tid >> 6, lane = tid & 63;
    const int gw = blockIdx.x * 8 + wave, NGW = gridDim.x * 8;
    float* ZB = (float*)(p.ws + WS_ZB); bf16_t* XB = (bf16_t*)(p.ws + WS_XB);
    const f32x4* gp = (const f32x4*)(p.ln_g + (size_t)layer * D) + lane; const f32x4* bp = (const f32x4*)(p.ln_b + (size_t)layer * D) + lane;
    for (int m = gw; m < MTOT; m += NGW) {
        f32x4* zr = (f32x4*)(ZB + (size_t)m * D) + lane;
        f32x4 v[8]; float s = 0.f;
#pragma unroll
        for (int j = 0; j < 8; ++j) { v[j] = zr[64 * j]; s += (v[j].x + v[j].y) + (v[j].z + v[j].w); }
#pragma unroll
        for (int o = 1; o < 64; o <<= 1) s += __shfl_xor(s, o);
        const float mean = s * (1.0f / D); float s2 = 0.f;
#pragma unroll
        for (int j = 0; j < 8; ++j) { v[j] = v[j] - mean; s2 += (v[j].x * v[j].x + v[j].y * v[j].y) + (v[j].z * v[j].z + v[j].w * v[j].w); }
#pragma unroll
        for (int o = 1; o < 64; o <<= 1) s2 += __shfl_xor(s2, o);
        const float rstd = rsqrtf(s2 * (1.0f / D) + LN_EPS);
        if (MODE == 1) {
            u32x2* xb = (u32x2*)(XB + (size_t)m * D) + lane;
#pragma unroll
            for (int j = 0; j < 8; ++j) { const f32x4 y = v[j] * rstd * gp[64 * j] + bp[64 * j]; zr[64 * j] = y; u32x2 o; o.x = pk2(y.x, y.y); o.y = pk2(y.z, y.w); xb[64 * j] = o; }
        } else {
            float* dst = nullptr;
            if (m < MPR) { const int b = m / TP, t = m - b * TP; if (t >= 16) dst = p.out + OUT_YP + ((size_t)b * 2048 + (t - 16)) * D; }
            else dst = p.out + OUT_YS + (size_t)(m - MPR) * D;
            if (dst) { f32x4* d4 = (f32x4*)dst + lane;
#pragma unroll
                for (int j = 0; j < 8; ++j) d4[64 * j] = v[j] * rstd * gp[64 * j] + bp[64 * j]; }
        }
    }
}

constexpr int H_QT = 0, H_KT = 17408, H_KTT = 34816, H_VT = 53248, H_AM = 71680, H_S0T = 80896, H_DEC = 115712, H_SEG = 116224;
#define MFMA16(a, b, c) __builtin_amdgcn_mfma_f32_16x16x32_bf16((a), (b), (c), 0, 0, 0)

__device__ __forceinline__ void hgrn_chain(const Params& p, LAS unsigned char* lds, int ci) {
    const int tid = threadIdx.x, w = tid >> 6, lane = tid & 63, r16 = lane & 15, quad = lane >> 4;
    const int kcol = tid & 127, seg = tid >> 7;
    const int b = ci >> 4, h = ci & 15;
    const bf16_t* QB = (const bf16_t*)(p.ws + WS_QB); const float* LF = (const float*)(p.ws + WS_LF); const bf16_t* VB = (const bf16_t*)(p.ws + WS_VB);
    const bf16_t* GB = (const bf16_t*)(p.ws + WS_GB); bf16_t* OB = (bf16_t*)(p.ws + WS_OB);
    const int colbase = h * 128;
    const int tt = w >> 1, vh = w & 1;
    f32x4 S[8];
#pragma unroll
    for (int i = 0; i < 8; ++i) S[i] = (f32x4){0.f, 0.f, 0.f, 0.f};
    for (int i = tid; i < 34816 / 16; i += 512) ((LAS u32x4*)(lds + H_S0T))[i] = (u32x4){0u, 0u, 0u, 0u};
    float lf[16]; unsigned short qr[16], vr[16];
#define HG_LOAD(c_) do { const int t0_ = 64 * (c_); _Pragma("unroll") for (int i = 0; i < 16; ++i) { const int t_ = t0_ + 16 * seg + i; const bool ok_ = t_ < TP; \
        const size_t off_ = ((size_t)(b * TP + (ok_ ? t_ : 0))) * D + colbase + kcol; \
        const float l_ = LF[off_]; const unsigned short q_ = QB[off_]; const unsigned short v_ = VB[off_]; lf[i] = ok_ ? l_ : 0.f; qr[i] = ok_ ? q_ : (unsigned short)0; vr[i] = ok_ ? v_ : (unsigned short)0; } } while (0)
    HG_LOAD(0);
    for (int c = 0; c < 33; ++c) {
        float bl[16]; float run = 0.f;
#pragma unroll
        for (int i = 0; i < 16; ++i) { run += lf[i]; bl[i] = run; }
        ((LAS float*)(lds + H_SEG))[seg * 128 + kcol] = run;
        __syncthreads();
        float pre = 0.f;
        for (int s = 0; s < seg; ++s) pre += ((LAS float*)(lds + H_SEG))[s * 128 + kcol];
        unsigned ktp[8], vtp[8]; float eb_last = 1.f;
#pragma unroll
        for (int i = 0; i < 16; i += 2) {
            float kt2[2];
#pragma unroll
            for (int e = 0; e < 2; ++e) { const float bt = pre + bl[i + e]; const float eb = __expf(bt), enb = __expf(-bt); const float q = bf2f(qr[i + e]); const float kk = 1.0f - __expf(lf[i + e]);
                const float qt = q * eb; kt2[e] = kk * enb; eb_last = eb;
                const int ts = 16 * seg + i + e;
                *(LAS unsigned short*)(lds + H_QT + ts * 272 + kcol * 2) = f2bf(qt);
                *(LAS unsigned short*)(lds + H_KT + ts * 272 + kcol * 2) = f2bf(kt2[e]); }
            ktp[i >> 1] = pk2(kt2[0], kt2[1]); vtp[i >> 1] = (unsigned)vr[i] | ((unsigned)vr[i + 1] << 16);
        }
        *(LAS u32x4*)(lds + H_KTT + kcol * 144 + seg * 32) = (u32x4){ktp[0], ktp[1], ktp[2], ktp[3]};
        *(LAS u32x4*)(lds + H_KTT + kcol * 144 + seg * 32 + 16) = (u32x4){ktp[4], ktp[5], ktp[6], ktp[7]};
        *(LAS u32x4*)(lds + H_VT + kcol * 144 + seg * 32) = (u32x4){vtp[0], vtp[1], vtp[2], vtp[3]};
        *(LAS u32x4*)(lds + H_VT + kcol * 144 + seg * 32 + 16) = (u32x4){vtp[4], vtp[5], vtp[6], vtp[7]};
        if (seg == 3) ((LAS float*)(lds + H_DEC))[kcol] = eb_last;
        if (c + 1 < 33) HG_LOAD(c + 1);
        __syncthreads();
        bf16x8 qa[4];
#pragma unroll
        for (int ks = 0; ks < 4; ++ks) qa[ks] = *(const LAS bf16x8*)(lds + H_QT + (16 * tt + r16) * 272 + (32 * ks + 8 * quad) * 2);
        f32x4 O[4];
#pragma unroll
        for (int j = 0; j < 4; ++j) { O[j] = (f32x4){0.f, 0.f, 0.f, 0.f}; const int vt = 4 * vh + j;
#pragma unroll
            for (int ks = 0; ks < 4; ++ks) { const bf16x8 sb = *(const LAS bf16x8*)(lds + H_S0T + (16 * vt + r16) * 272 + (32 * ks + 8 * quad) * 2); O[j] = MFMA16(qa[ks], sb, O[j]); } }
#pragma unroll
        for (int j = 0; j < 2; ++j) { const int st = 2 * vh + j; f32x4 a = (f32x4){0.f, 0.f, 0.f, 0.f};
            if (st <= tt) {
#pragma unroll
                for (int ks = 0; ks < 4; ++ks) { const bf16x8 kb = *(const LAS bf16x8*)(lds + H_KT + (16 * st + r16) * 272 + (32 * ks + 8 * quad) * 2); a = MFMA16(qa[ks], kb, a); } }
#pragma unroll
            for (int r = 0; r < 4; ++r) { const int tl = 16 * tt + 4 * quad + r, sl = 16 * st + r16; const float val = (sl <= tl) ? a[r] : 0.f;
                *(LAS unsigned short*)(lds + H_AM + tl * 144 + sl * 2) = f2bf(val); } }
        __syncthreads();
#pragma unroll
        for (int ss = 0; ss < 2; ++ss) { const bf16x8 aa = *(const LAS bf16x8*)(lds + H_AM + (16 * tt + r16) * 144 + (32 * ss + 8 * quad) * 2);
#pragma unroll
            for (int j = 0; j < 4; ++j) { const int vt = 4 * vh + j; const bf16x8 vb = *(const LAS bf16x8*)(lds + H_VT + (16 * vt + r16) * 144 + (32 * ss + 8 * quad) * 2); O[j] = MFMA16(aa, vb, O[j]); } }
#pragma unroll
        for (int ss = 0; ss < 2; ++ss) { const bf16x8 ka = *(const LAS bf16x8*)(lds + H_KTT + (16 * w + r16) * 144 + (32 * ss + 8 * quad) * 2);
#pragma unroll
            for (int vt = 0; vt < 8; ++vt) { const bf16x8 vb = *(const LAS bf16x8*)(lds + H_VT + (16 * vt + r16) * 144 + (32 * ss + 8 * quad) * 2); S[vt] = MFMA16(ka, vb, S[vt]); } }
        const f32x4 dec = *(const LAS f32x4*)(lds + H_DEC + (16 * w + 4 * quad) * 4);
#pragma unroll
        for (int vt = 0; vt < 8; ++vt) { S[vt] = S[vt] * dec;
            *(LAS u32x2*)(lds + H_S0T + (16 * vt + r16) * 272 + (16 * w + 4 * quad) * 2) = (u32x2){pk2(S[vt].x, S[vt].y), pk2(S[vt].z, S[vt].w)}; }
#pragma unroll
        for (int j = 0; j < 4; ++j) { const int vt = 4 * vh + j;
#pragma unroll
            for (int r = 0; r < 4; ++r) ((LAS float*)lds)[(16 * tt + 4 * quad + r) * 132 + 16 * vt + r16] = O[j][r]; }
        __syncthreads();
        { const int t = tid >> 3, jj = tid & 7; const int tg = 64 * c + t;
          f32x4 o4[4]; float ss = 0.f;
#pragma unroll
          for (int i = 0; i < 4; ++i) { o4[i] = *(const LAS f32x4*)(lds + (t * 132 + 16 * jj + 4 * i) * 4); ss += (o4[i].x * o4[i].x + o4[i].y * o4[i].y) + (o4[i].z * o4[i].z + o4[i].w * o4[i].w); }
          ss += __shfl_xor(ss, 1); ss += __shfl_xor(ss, 2); ss += __shfl_xor(ss, 4);
          const float rstd = rsqrtf(ss * (1.0f / 128.0f) + RMS_EPS);
          if (tg < TP) { const size_t off = ((size_t)(b * TP + tg)) * D + colbase + 16 * jj;
              const u32x4 g0 = *(const u32x4*)(GB + off), g1 = *(const u32x4*)(GB + off + 8);
              const unsigned gw_[8] = {g0.x, g0.y, g0.z, g0.w, g1.x, g1.y, g1.z, g1.w};
              const float* nw = p.norm_w + colbase + 16 * jj;
              unsigned ow[8];
#pragma unroll
              for (int i = 0; i < 4; ++i) { const f32x4 n4 = *(const f32x4*)(nw + 4 * i);
                  const float y0 = o4[i].x * rstd * n4.x * bf2f((unsigned short)(gw_[2 * i] & 0xffffu)), y1 = o4[i].y * rstd * n4.y * bf2f((unsigned short)(gw_[2 * i] >> 16));
                  const float y2 = o4[i].z * rstd * n4.z * bf2f((unsigned short)(gw_[2 * i + 1] & 0xffffu)), y3 = o4[i].w * rstd * n4.w * bf2f((unsigned short)(gw_[2 * i + 1] >> 16));
                  ow[2 * i] = pk2(y0, y1); ow[2 * i + 1] = pk2(y2, y3); }
              *(u32x4*)(OB + off) = (u32x4){ow[0], ow[1], ow[2], ow[3]}; *(u32x4*)(OB + off + 8) = (u32x4){ow[4], ow[5], ow[6], ow[7]}; }
        }
    }
#undef HG_LOAD
    float* so = p.out + OUT_SP + ((size_t)(b * 16 + h)) * 16384;
#pragma unroll
    for (int vt = 0; vt < 8; ++vt)
#pragma unroll
        for (int r = 0; r < 4; ++r) so[(16 * w + 4 * quad + r) * 128 + 16 * vt + r16] = S[vt][r];
    __syncthreads();
}

constexpr int SS_Q = 0, SS_K = 4096, SS_V = 8192, SS_E8 = 12288, SS_A = 12800, SS_B = 13056, SS_QR = 17152, SS_KK = 21248, SS_PART = 25600;
__device__ __forceinline__ void hgrn_sample_item(const Params& p, LAS unsigned char* lds, int it) {
    const int tid = threadIdx.x, lane = tid & 63;
    const int b = it >> 4, h = it & 15;
    const bf16_t* QB = (const bf16_t*)(p.ws + WS_QB); const float* LF = (const float*)(p.ws + WS_LF); const bf16_t* VB = (const bf16_t*)(p.ws + WS_VB);
    const bf16_t* GB = (const bf16_t*)(p.ws + WS_GB); bf16_t* OB = (bf16_t*)(p.ws + WS_OB);
    const size_t rbase = ((size_t)(MPR + b * 8)) * D + h * 128;
    LAS float* SQ = (LAS float*)(lds + SS_Q); LAS float* SK = (LAS float*)(lds + SS_K); LAS float* SV = (LAS float*)(lds + SS_V); LAS float* SE8 = (LAS float*)(lds + SS_E8);
    LAS float* SA = (LAS float*)(lds + SS_A); LAS float* SB = (LAS float*)(lds + SS_B); LAS float* SQR = (LAS float*)(lds + SS_QR); LAS float* SKK = (LAS float*)(lds + SS_KK);
    LAS float* PART = (LAS float*)(lds + SS_PART);
    const int v4 = tid & 31, kg = tid >> 5;
    const float* S0 = p.state + ((size_t)(b * 16 + h)) * 16384; float* S1 = p.out + OUT_SS + ((size_t)(b * 16 + h)) * 16384;
    f32x4 s0[8];
#pragma unroll
    for (int i = 0; i < 8; ++i) s0[i] = *(const f32x4*)(S0 + (8 * kg + i) * 128 + 4 * v4);
    if (tid < 128) { const int k = tid; float lfv[8], qv[8], bt[8]; float run = 0.f;
#pragma unroll
        for (int t = 0; t < 8; ++t) { lfv[t] = LF[rbase + (size_t)t * D + k]; qv[t] = bf2f(QB[rbase + (size_t)t * D + k]); }
#pragma unroll
        for (int t = 0; t < 8; ++t) { run += lfv[t]; bt[t] = run; }
#pragma unroll
        for (int t = 0; t < 8; ++t) { const float eb = __expf(bt[t]); const float kk = 1.0f - __expf(lfv[t]);
            SQ[k * 8 + t] = qv[t] * eb; SK[k * 8 + t] = kk * __expf(run - bt[t]); SB[t * 128 + k] = bt[t]; SQR[t * 128 + k] = qv[t]; SKK[t * 128 + k] = kk; }
        SE8[k] = __expf(run);
    } else if (tid < 256) { const int v = tid - 128;
#pragma unroll
        for (int s = 0; s < 8; ++s) SV[s * 128 + v] = bf2f(VB[rbase + (size_t)s * D + v]);
    }
    __syncthreads();
    if (tid < 64) { const int t = tid >> 3, s = tid & 7; float a = 0.f;
        if (s <= t) for (int k = 0; k < 128; ++k) a += SQR[t * 128 + k] * SKK[s * 128 + k] * __expf(SB[t * 128 + k] - SB[s * 128 + k]);
        SA[t * 8 + s] = a; }
    {
        f32x4 vv[8], o[8];
#pragma unroll
        for (int s = 0; s < 8; ++s) { vv[s] = *(const LAS f32x4*)(SV + s * 128 + 4 * v4); o[s] = (f32x4){0.f, 0.f, 0.f, 0.f}; }
#pragma unroll
        for (int i = 0; i < 8; ++i) { const int k = 8 * kg + i;
            const f32x4 qa = *(const LAS f32x4*)(SQ + k * 8), qb = *(const LAS f32x4*)(SQ + k * 8 + 4), ka = *(const LAS f32x4*)(SK + k * 8), kb = *(const LAS f32x4*)(SK + k * 8 + 4);
            const float q8[8] = {qa.x, qa.y, qa.z, qa.w, qb.x, qb.y, qb.z, qb.w}, k8[8] = {ka.x, ka.y, ka.z, ka.w, kb.x, kb.y, kb.z, kb.w};
            f32x4 sn = s0[i] * SE8[k];
#pragma unroll
            for (int t = 0; t < 8; ++t) { o[t] = o[t] + s0[i] * q8[t]; sn = sn + vv[t] * k8[t]; }
            *(f32x4*)(S1 + k * 128 + 4 * v4) = sn; }
#pragma unroll
        for (int t = 0; t < 8; ++t) *(LAS f32x4*)(PART + (kg * 8 + t) * 128 + 4 * v4) = o[t];
    }
    __syncthreads();
    { const int t = tid >> 6, vp = lane; f32x2v o2 = (f32x2v){0.f, 0.f};
#pragma unroll
        for (int g = 0; g < 16; ++g) o2 = o2 + *(const LAS f32x2v*)(PART + (g * 8 + t) * 128 + 2 * vp);
        for (int s = 0; s <= t; ++s) o2 = o2 + *(const LAS f32x2v*)(SV + s * 128 + 2 * vp) * SA[t * 8 + s];
        float ss = o2.x * o2.x + o2.y * o2.y;
#pragma unroll
        for (int m = 1; m < 64; m <<= 1) ss += __shfl_xor(ss, m);
        const float rstd = rsqrtf(ss * (1.0f / 128.0f) + RMS_EPS);
        const size_t off = rbase + (size_t)t * D + 2 * vp;
        const unsigned g = *(const unsigned*)(GB + off); const f32x2v nw = *(const f32x2v*)(p.norm_w + h * 128 + 2 * vp);
        *(unsigned*)(OB + off) = pk2(o2.x * rstd * nw.x * bf2f((unsigned short)(g & 0xffffu)), o2.y * rstd * nw.y * bf2f((unsigned short)(g >> 16))); }
    __syncthreads();
}

__device__ __forceinline__ void phase_hgrn(const Params& p, LAS unsigned char* lds) {
    const int G = gridDim.x, blk = blockIdx.x;
    int cb, cs, sb, ss;
    if (G > 64) { cb = blk; cs = G; sb = blk >= 64 ? blk - 64 : 2048; ss = G - 64; } else { cb = blk; cs = G; sb = blk; ss = G; }
    for (int ci = cb; ci < 64; ci += cs) hgrn_chain(p, lds, ci);
    for (int it = sb; it < 2048; it += ss) hgrn_sample_item(p, lds, it);
}

constexpr int A_KS = 0, A_VT = 23040;
constexpr int ATT_PROMPT_ITEMS = NBP * 4 * 65, ATT_ITEMS = ATT_PROMPT_ITEMS + NBS * 4;
__device__ __forceinline__ void attn_item(const Params& p, LAS unsigned char* lds, int it) {
    const int tid = threadIdx.x, w = tid >> 6, lane = tid & 63, r16 = lane & 15, quad = lane >> 4;
    const bf16_t* Q1 = (const bf16_t*)(p.ws + WS_QB); const bf16_t* K1 = (const bf16_t*)(p.ws + WS_K1); const bf16_t* V1 = (const bf16_t*)(p.ws + WS_V1);
    const bf16_t* GB = (const bf16_t*)(p.ws + WS_GB); bf16_t* OB = (bf16_t*)(p.ws + WS_OB);
    const bool samp = it >= ATT_PROMPT_ITEMS;
    int b, kvh, t0 = 0;
    if (!samp) { b = it / 260; const int rem = it - b * 260; kvh = rem / 65; t0 = 32 * (rem - kvh * 65); } else { const int j = it - ATT_PROMPT_ITEMS; b = j >> 2; kvh = j & 3; }
    __syncthreads();
    for (int idx = tid; idx < 1280; idx += 512) { const int key = idx >> 3, c8 = idx & 7;
        u32x4 kv = (u32x4){0u, 0u, 0u, 0u}, vv = (u32x4){0u, 0u, 0u, 0u};
        if (!samp) { const int pz = t0 - 128 + key; if (pz >= 0 && pz < TP) { const size_t o = ((size_t)(b * TP + pz)) * 256 + kvh * 64 + 8 * c8; kv = *(const u32x4*)(K1 + o); vv = *(const u32x4*)(V1 + o); } }
        else if (key < 128) { const size_t o = (((size_t)b * 128 + key) * 4 + kvh) * 64 + 8 * c8;
            const f32x4 a = *(const f32x4*)(p.cache_k + o), bq = *(const f32x4*)(p.cache_k + o + 4), c = *(const f32x4*)(p.cache_v + o), d = *(const f32x4*)(p.cache_v + o + 4);
            kv = (u32x4){pk2(a.x, a.y), pk2(a.z, a.w), pk2(bq.x, bq.y), pk2(bq.z, bq.w)}; vv = (u32x4){pk2(c.x, c.y), pk2(c.z, c.w), pk2(d.x, d.y), pk2(d.z, d.w)}; }
        else if (key < 136) { const size_t o = ((size_t)(MPR + b * 8 + key - 128)) * 256 + kvh * 64 + 8 * c8; kv = *(const u32x4*)(K1 + o); vv = *(const u32x4*)(V1 + o); }
        *(LAS u32x4*)(lds + A_KS + key * 144 + c8 * 16) = kv;
        const unsigned vw[4] = {vv.x, vv.y, vv.z, vv.w};
#pragma unroll
        for (int j = 0; j < 4; ++j) { *(LAS unsigned short*)(lds + A_VT + (8 * c8 + 2 * j) * 336 + key * 2) = (unsigned short)(vw[j] & 0xffffu);
            *(LAS unsigned short*)(lds + A_VT + (8 * c8 + 2 * j + 1) * 336 + key * 2) = (unsigned short)(vw[j] >> 16); }
    }
    __syncthreads();
    const int hq = kvh * 8 + w;
    bf16x8 qf[2][2]; bool qok[2]; size_t qrow[2];
#pragma unroll
    for (int tt = 0; tt < 2; ++tt) { const int i = 16 * tt + r16;
        if (!samp) { const int t = t0 + i; qok[tt] = t < TP; qrow[tt] = (size_t)(b * TP + (qok[tt] ? t : 0)); } else { qok[tt] = i < 8; qrow[tt] = (size_t)(MPR + b * 8 + (qok[tt] ? i : 0)); }
#pragma unroll
        for (int ds = 0; ds < 2; ++ds) { bf16x8 q = *(const bf16x8*)(Q1 + qrow[tt] * D + hq * 64 + 32 * ds + 8 * quad); if (!qok[tt]) q = (bf16x8){0, 0, 0, 0, 0, 0, 0, 0}; qf[tt][ds] = q; } }
    f32x4 st[10][2];
#pragma unroll
    for (int kt = 0; kt < 10; ++kt) { st[kt][0] = (f32x4){0.f, 0.f, 0.f, 0.f}; st[kt][1] = (f32x4){0.f, 0.f, 0.f, 0.f};
#pragma unroll
        for (int ds = 0; ds < 2; ++ds) { const bf16x8 ka = *(const LAS bf16x8*)(lds + A_KS + (16 * kt + r16) * 144 + (32 * ds + 8 * quad) * 2);
            st[kt][0] = MFMA16(ka, qf[0][ds], st[kt][0]); st[kt][1] = MFMA16(ka, qf[1][ds], st[kt][1]); } }
    const float sink = p.sinks[hq];
    const int kminv = samp ? 0 : (128 - t0 > 0 ? 128 - t0 : 0);
    bf16x8 pb[5][2];
#pragma unroll
    for (int tt = 0; tt < 2; ++tt) { const int i = 16 * tt + r16; const int lo = (i + 1 > kminv) ? i + 1 : kminv, hi = i + 128;
        float m = -INFINITY;
#pragma unroll
        for (int kt = 0; kt < 10; ++kt)
#pragma unroll
            for (int r = 0; r < 4; ++r) { const int kp = 16 * kt + 4 * quad + r; const float s = (kp >= lo && kp <= hi) ? st[kt][tt][r] : -INFINITY; st[kt][tt][r] = s; m = fmaxf(m, s); }
        m = fmaxf(m, __shfl_xor(m, 16)); m = fmaxf(m, __shfl_xor(m, 32)); m = fmaxf(m, sink);
        float sum = 0.f;
#pragma unroll
        for (int kt = 0; kt < 10; ++kt)
#pragma unroll
            for (int r = 0; r < 4; ++r) { const float e = __expf(st[kt][tt][r] - m); st[kt][tt][r] = e; sum += e; }
        sum += __shfl_xor(sum, 16); sum += __shfl_xor(sum, 32); sum += __expf(sink - m);
        const float inv = 1.0f / sum;
#pragma unroll
        for (int ks = 0; ks < 5; ++ks) { const f32x4 a = st[2 * ks][tt] * inv, c = st[2 * ks + 1][tt] * inv;
            const u32x4 pw = (u32x4){pk2(a.x, a.y), pk2(a.z, a.w), pk2(c.x, c.y), pk2(c.z, c.w)}; pb[ks][tt] = __builtin_bit_cast(bf16x8, pw); }
    }
    f32x4 o[4][2];
#pragma unroll
    for (int dt = 0; dt < 4; ++dt) { o[dt][0] = (f32x4){0.f, 0.f, 0.f, 0.f}; o[dt][1] = (f32x4){0.f, 0.f, 0.f, 0.f}; }
#pragma unroll
    for (int ks = 0; ks < 5; ++ks)
#pragma unroll
        for (int dt = 0; dt < 4; ++dt) { const u32x2 l8 = *(const LAS u32x2*)(lds + A_VT + (16 * dt + r16) * 336 + (32 * ks + 4 * quad) * 2), h8 = *(const LAS u32x2*)(lds + A_VT + (16 * dt + r16) * 336 + (32 * ks + 16 + 4 * quad) * 2);
            const bf16x8 va = __builtin_bit_cast(bf16x8, (u32x4){l8.x, l8.y, h8.x, h8.y});
            o[dt][0] = MFMA16(va, pb[ks][0], o[dt][0]); o[dt][1] = MFMA16(va, pb[ks][1], o[dt][1]); }
#pragma unroll
    for (int tt = 0; tt < 2; ++tt) if (qok[tt]) {
#pragma unroll
        for (int dt = 0; dt < 4; ++dt) { const size_t off = qrow[tt] * D + hq * 64 + 16 * dt + 4 * quad; const u32x2 g = *(const u32x2*)(GB + off);
            const f32x4 x = o[dt][tt];
            *(u32x2*)(OB + off) = (u32x2){pk2(x.x * bf2f((unsigned short)(g.x & 0xffffu)), x.y * bf2f((unsigned short)(g.x >> 16))), pk2(x.z * bf2f((unsigned short)(g.y & 0xffffu)), x.w * bf2f((unsigned short)(g.y >> 16)))}; } }
}

__global__ void __launch_bounds__(512, 2) fwd_megakernel(Params p) {
    extern __shared__ __attribute__((aligned(16))) unsigned char shm[];
    LAS unsigned char* lds = (LAS unsigned char*)shm;
    cg::grid_group grid = cg::this_grid();
    const int G = gridDim.x;
    bf16_t* XB = (bf16_t*)(p.ws + WS_XB); bf16_t* OB = (bf16_t*)(p.ws + WS_OB); bf16_t* QB = (bf16_t*)(p.ws + WS_QB); bf16_t* VB = (bf16_t*)(p.ws + WS_VB); bf16_t* GB = (bf16_t*)(p.ws + WS_GB);
    float* ZB = (float*)(p.ws + WS_ZB);
    phase0(p, lds);
    grid.sync();
    { pg8::Gemm g{XB, (const bf16_t*)(p.ws + WS_WT0), MPAD, 8192, 2048}; pg8::StaticOrder S; S.init(MPAD, 8192, G, blockIdx.x);
      EpiHgrnIn E{p.ws, (float*)(p.ws + WS_LF), (const float*)(p.ws + WS_LB)};
      pg8::gemm_phase<EpiHgrnIn, pg8::StaticOrder, false>(lds, g, S, E, nullptr); }
    grid.sync();
    phase_hgrn(p, lds);
    grid.sync();
    { pg8::Gemm g{OB, (const bf16_t*)(p.ws + WS_WTO0), MPAD, 2048, 2048}; pg8::StaticOrder S; S.init(MPAD, 2048, G, blockIdx.x);
      EpiOut<0> E{ZB, p};
      pg8::gemm_phase<EpiOut<0>, pg8::StaticOrder, false>(lds, g, S, E, nullptr); }
    grid.sync();
    phase_ln<1>(p, 0);
    grid.sync();
    { pg8::Gemm g{XB, (const bf16_t*)(p.ws + WS_WT1), MPAD, 4608, 2048}; pg8::StaticOrder S; S.init(MPAD, 4608, G, blockIdx.x);
      EpiSwaIn E{QB, (bf16_t*)(p.ws + WS_K1), (bf16_t*)(p.ws + WS_V1), GB, p.out};
      pg8::gemm_phase<EpiSwaIn, pg8::StaticOrder, false>(lds, g, S, E, nullptr); }
    grid.sync();
    for (int it = blockIdx.x; it < ATT_ITEMS; it += G) attn_item(p, lds, it);
    grid.sync();
    { pg8::Gemm g{OB, (const bf16_t*)(p.ws + WS_WTO1), MPAD, 2048, 2048}; pg8::StaticOrder S; S.init(MPAD, 2048, G, blockIdx.x);
      EpiOut<1> E{ZB, p};
      pg8::gemm_phase<EpiOut<1>, pg8::StaticOrder, false>(lds, g, S, E, nullptr); }
    grid.sync();
    phase_ln<2>(p, 1);
}

extern "C" void kernel_launch(void* const* d_in, const int* in_sizes, int n_in, void* d_out, int out_size, void* d_ws, size_t ws_size, hipStream_t stream) {
    static int grid_blocks = 0;
    if (!grid_blocks) {
        int dev = 0, cus = 0, per_cu = 0;
        hipGetDevice(&dev);
        hipDeviceGetAttribute(&cus, hipDeviceAttributeMultiprocessorCount, dev);
        hipFuncSetAttribute((const void*)fwd_megakernel, hipFuncAttributeMaxDynamicSharedMemorySize, LDS_BYTES);
        hipOccupancyMaxActiveBlocksPerMultiprocessor(&per_cu, (const void*)fwd_megakernel, 512, LDS_BYTES);
        if (per_cu < 1) { fprintf(stderr, "kernel_launch: occupancy query reports %d blocks/CU\n", per_cu); per_cu = 1; }
        grid_blocks = cus;
    }
    if (ws_size < WS_END) { fprintf(stderr, "kernel_launch: workspace too small (%zu < %zu)\n", ws_size, (size_t)WS_END); return; }
    Params p{};
    p.x_prompt = (const float*)d_in[0]; p.x_sample = (const float*)d_in[1]; p.state = (const float*)d_in[2]; p.cache_k = (const float*)d_in[3]; p.cache_v = (const float*)d_in[4];
    p.meta = (const float*)d_in[5]; p.w_in0 = (const float*)d_in[6]; p.lb_logits = (const float*)d_in[7]; p.norm_w = (const float*)d_in[8]; p.w_out0 = (const float*)d_in[9];
    p.w_in1 = (const float*)d_in[10]; p.sinks = (const float*)d_in[11]; p.w_out1 = (const float*)d_in[12]; p.ln_g = (const float*)d_in[13]; p.ln_b = (const float*)d_in[14];
    p.out = (float*)d_out; p.ws = (unsigned char*)d_ws;
    void* args[] = {&p};
    hipError_t e = hipLaunchCooperativeKernel((const void*)fwd_megakernel, dim3(grid_blocks), dim3(512), args, LDS_BYTES, stream);
    if (e != hipSuccess) fprintf(stderr, "cooperative launch failed: %s (grid %d)\n", hipGetErrorString(e), grid_blocks);
}
```

```cpp
#include <hip/hip_runtime.h>
#include <hip/hip_cooperative_groups.h>
#include <cstdio>
#include <cstdint>
namespace pg8 {
#define PG8_LAS __attribute__((address_space(3)))
typedef unsigned short bf16_t;
typedef short bf16x8 __attribute__((ext_vector_type(8)));
typedef float f32x4 __attribute__((ext_vector_type(4)));
typedef unsigned u32x4 __attribute__((ext_vector_type(4)));
constexpr int BM = 256, BK = 64, HALF = 128, HTB = HALF * BK * 2  , STAGE_BYTES = 8 * HTB, NXCD = 8, WGM = 8;

__host__ __device__ __forceinline__ int lds_byte(int r, int c) { const int st = (r >> 4) * 2 + (c >> 5), rr = r & 15, cc = c & 31, ob = rr * 64 + cc * 2; return st * 1024 + (ob ^ (((ob >> 9) & 1) << 5)); }
__host__ __device__ __forceinline__ void stage_rc(int b, int& R, int& C) { const int st = b / 1024, sb = b % 1024, swz = sb ^ (((sb >> 9) & 1) << 5); R = (st >> 1) * 16 + swz / 64; C = (st & 1) * 32 + (swz % 64) / 2; }
__host__ __device__ __forceinline__ int perm32(int rho) { const int n = rho >> 4, i = rho & 15; return 8 * (i >> 2) + 4 * n + (i & 3); }

struct Unit { int pm, pn, kt0, nkt; };
struct Gemm { const bf16_t* A; const bf16_t* Bt; int M, N, K; };

struct StaticOrder {
    int reps = 1;
    int nM, nN, nwg, G, c, nkt, nfull, sk;
    __host__ __device__ void init(int M, int N, int G_, int c_, int K = 2048, int split = 0) { nM = M / BM; nN = N / BM; nwg = nM * nN; G = G_; c = c_; nkt = K / BK; nfull = nwg; sk = 1;
        if (split) { const int R = nwg / G, rem = nwg - R * G; if (rem > 0 && rem * 4 <= G && (nkt % 8) == 0) { nfull = R * G; sk = 4; } } }
    __host__ __device__ bool next(int i, Unit& u) const {
        if (reps > 1) { const int R = (nwg + G - 1) / G; if (i >= R * reps) return false; i = i % R; }
        long L = (long)i * G + c; u.kt0 = 0; u.nkt = nkt;
        if (L >= nfull && sk > 1) { if (L >= nfull + G) return false; const int j = (int)(L - nfull); L = nfull + j / sk; u.nkt = nkt / sk; u.kt0 = (j % sk) * u.nkt; }
        if (L >= nwg) return false;
        int wgid = (int)L; { const int q = nwg / NXCD, r = nwg % NXCD, xcd = wgid % NXCD, off = wgid / NXCD; wgid = (xcd < r ? xcd * (q + 1) : r * (q + 1) + (xcd - r) * q) + off; }
        const int nig = WGM * nN, gid = wgid / nig, fm = gid * WGM, gsz = (nM - fm) < WGM ? (nM - fm) : WGM;
        u.pm = fm + ((wgid % nig) % gsz); u.pn = (wgid % nig) / gsz; return true;
    }
    __device__ __forceinline__ void a_ready(const Unit&) const {}
    __device__ __forceinline__ void done(const Unit&) const {}
};
__device__ __forceinline__ unsigned cvt_pk_bf16(float lo, float hi) { unsigned r; asm volatile("v_cvt_pk_bf16_f32 %0, %1, %2" : "=v"(r) : "v"(lo), "v"(hi)); return r; }
template <class Epi, class Sched, bool STAMP = false>
__device__ __forceinline__ void gemm_phase(PG8_LAS unsigned char* lds, const Gemm g, const Sched& S, const Epi& E, unsigned long long* stamps) {
    int tid_l = threadIdx.x; asm volatile("" : "+v"(tid_l));
    const int tid = tid_l, wid = __builtin_amdgcn_readfirstlane(tid >> 6), lane = tid & 63, wr = wid >> 2, wc = wid & 3, fr = lane & 15, fq = lane >> 4;
    const int K = g.K;
    int ts_lo = 0, ts_hi = 0, nts = 0; const unsigned long long rt_entry = STAMP ? (unsigned long long)wall_clock64() : 0ull;
#define PG8_STAMP() do { if (STAMP && wid == 0 && nts < 64) { const unsigned long long _c = (unsigned long long)clock64(); \
        ts_lo = (lane == nts) ? (int)(unsigned)_c : ts_lo; ts_hi = (lane == nts) ? (int)(unsigned)(_c >> 32) : ts_hi; ++nts; } } while (0)
    PG8_STAMP();
    unsigned voffA[2], voffB[2];
#pragma unroll
    for (int i = 0; i < 2; ++i) { int R, C; stage_rc(tid * 16 + i * 8192, R, C); const int Rb = Epi::PERM ? ((R & ~31) + perm32(R & 31)) : R;
        voffA[i] = (unsigned)(R * K + C) * 2u; voffB[i] = (unsigned)(Rb * K + C) * 2u; }
    const size_t kstep = (size_t)(BK * 2);
    const size_t hstep = (size_t)HALF * K * 2;
    const size_t tstep = 2 * hstep;
    const unsigned ldsw = (unsigned)wid * 1024u;
    const int aoff = lds_byte(wr * 64 + fr, fq * 8), boff = lds_byte(wc * 32 + fr, fq * 8);
#define PG8_SA(b, h) (((b) * 2 + (h)) * HTB)
#define PG8_SB(b, h) ((4 + (b) * 2 + (h)) * HTB)
#define PG8_STAGE(bufoff, gbase, voff) do { _Pragma("unroll") for (int _i = 0; _i < 2; ++_i) \
        __builtin_amdgcn_global_load_lds((const unsigned*)((const char*)(gbase) + (voff)[_i]), (PG8_LAS unsigned*)(lds + (bufoff) + ldsw + _i * 8192), 16, 0, 0); } while (0)
#define PG8_LDA(dst, b, h) do { _Pragma("unroll") for (int m = 0; m < 4; ++m) _Pragma("unroll") for (int k = 0; k < 2; ++k) dst[m][k] = *(const PG8_LAS bf16x8*)(lds + PG8_SA(b, h) + aoff + m * 2048 + k * 1024); } while (0)
#define PG8_LDB(dst, b, h) do { _Pragma("unroll") for (int n = 0; n < 2; ++n) _Pragma("unroll") for (int k = 0; k < 2; ++k) dst[n][k] = *(const PG8_LAS bf16x8*)(lds + PG8_SB(b, h) + boff + n * 2048 + k * 1024); } while (0)
#define PG8_MMA(ai, bj, At, Bt) do { __builtin_amdgcn_s_setprio(1); _Pragma("unroll") for (int m = 0; m < 4; ++m) _Pragma("unroll") for (int n = 0; n < 2; ++n) _Pragma("unroll") for (int k = 0; k < 2; ++k) \
        acc[ai][bj][m][n] = __builtin_amdgcn_mfma_f32_16x16x32_bf16(Bt[n][k], At[m][k], acc[ai][bj][m][n], 0, 0, 0); __builtin_amdgcn_s_setprio(0); } while (0)
#define PG8_WAIT_V(n) asm volatile("s_waitcnt vmcnt(" #n ")" ::: "memory")
#define PG8_WAIT_L(n) asm volatile("s_waitcnt lgkmcnt(" #n ")" ::: "memory")
#define PG8_BAR __builtin_amdgcn_s_barrier()
#define PG8_SCHED __builtin_amdgcn_sched_barrier(0)
    Unit cur, nxt; int ui = 0;
    if (!S.next(0, cur)) return;
    f32x4 acc[2][2][4][2];
#pragma unroll
    for (int a = 0; a < 2; ++a)
#pragma unroll
        for (int b = 0; b < 2; ++b)
#pragma unroll
            for (int m = 0; m < 4; ++m)
#pragma unroll
                for (int n = 0; n < 2; ++n) acc[a][b][m][n] = (f32x4){0.f, 0.f, 0.f, 0.f};
    bf16x8 At[4][2], B0[2][2], B1[2][2];
    const char* cA = (const char*)g.A + (size_t)cur.pm * tstep + (size_t)cur.kt0 * kstep; const char* cB = (const char*)g.Bt + (size_t)cur.pn * tstep + (size_t)cur.kt0 * kstep;
    int nt = cur.nkt;
    S.a_ready(cur);
    PG8_STAGE(PG8_SB(0, 0), cB, voffB); PG8_STAGE(PG8_SB(0, 1), cB + hstep, voffB); PG8_STAGE(PG8_SA(0, 0), cA, voffA); PG8_STAGE(PG8_SA(0, 1), cA + hstep, voffA);
    if (wr == 1) PG8_BAR;
    PG8_WAIT_V(2); PG8_BAR;
    PG8_STAGE(PG8_SB(1, 0), cB + kstep, voffB); PG8_STAGE(PG8_SA(1, 0), cA + kstep, voffA); PG8_STAGE(PG8_SB(1, 1), cB + hstep + kstep, voffB);
    PG8_WAIT_V(6); PG8_BAR;
    PG8_STAMP();
    for (;;) {
        const bool has_next = S.next(ui + 1, nxt);
        const char* nA = has_next ? (const char*)g.A + (size_t)nxt.pm * tstep + (size_t)nxt.kt0 * kstep : cA; const char* nB = has_next ? (const char*)g.Bt + (size_t)nxt.pn * tstep + (size_t)nxt.kt0 * kstep : cB;
        for (int t = 0; t < nt; t += 2) {
            const bool last = (t == nt - 2);
            const char* a1 = cA + (size_t)(t + 1) * kstep;
            const char* a2 = last ? nA : cA + (size_t)(t + 2) * kstep; const char* b2 = last ? nB : cB + (size_t)(t + 2) * kstep;
            const char* a3 = a2 + kstep; const char* b3 = b2 + kstep;
            if (last && has_next) S.a_ready(nxt);
            PG8_LDB(B0, 0, 0); PG8_LDB(B1, 0, 1); PG8_SCHED; PG8_LDA(At, 0, 0); PG8_STAGE(PG8_SA(1, 1), a1 + hstep, voffA);
            PG8_WAIT_V(8); PG8_WAIT_L(0); PG8_BAR; PG8_MMA(0, 0, At, B0); PG8_MMA(0, 1, At, B1); PG8_BAR; PG8_SCHED;
            PG8_LDA(At, 0, 1); PG8_STAGE(PG8_SB(0, 0), b2, voffB); PG8_STAGE(PG8_SB(0, 1), b2 + hstep, voffB); PG8_STAGE(PG8_SA(0, 0), a2, voffA);
            PG8_WAIT_V(8); PG8_WAIT_L(0); PG8_BAR; PG8_MMA(1, 0, At, B0); PG8_MMA(1, 1, At, B1); PG8_BAR; PG8_SCHED;
            PG8_LDB(B0, 1, 0); PG8_LDB(B1, 1, 1); PG8_SCHED; PG8_LDA(At, 1, 0); PG8_STAGE(PG8_SA(0, 1), a2 + hstep, voffA);
            PG8_WAIT_V(8); PG8_WAIT_L(0); PG8_BAR; PG8_MMA(0, 0, At, B0); PG8_MMA(0, 1, At, B1); PG8_BAR; PG8_SCHED;
            PG8_LDA(At, 1, 1); PG8_STAGE(PG8_SB(1, 0), b3, voffB); PG8_STAGE(PG8_SB(1, 1), b3 + hstep, voffB); PG8_STAGE(PG8_SA(1, 0), a3, voffA);
            PG8_WAIT_V(8); PG8_WAIT_L(0); PG8_BAR; PG8_MMA(1, 0, At, B0); PG8_MMA(1, 1, At, B1); PG8_BAR; PG8_SCHED;
        }
        PG8_STAMP();
        if (wr == 0) PG8_BAR;
        if constexpr (!Epi::AFTER_DRAIN) { E(acc, cur, wr, wc, fr, fq); S.done(cur); }
        PG8_STAMP();
        if (!has_next) break;
#pragma unroll
        for (int a = 0; a < 2; ++a)
#pragma unroll
            for (int b = 0; b < 2; ++b)
#pragma unroll
                for (int m = 0; m < 4; ++m)
#pragma unroll
                    for (int n = 0; n < 2; ++n) acc[a][b][m][n] = (f32x4){0.f, 0.f, 0.f, 0.f};
        cur = nxt; cA = nA; cB = nB; ++ui; nt = cur.nkt;
        if (wr == 1) PG8_BAR;
    }
    PG8_WAIT_V(0);
    PG8_BAR;
    if constexpr (Epi::AFTER_DRAIN) { E.fused(acc, cur, wr, wc, fr, fq, lds, wid, lane); S.done(cur); }
    PG8_STAMP();
    if (STAMP && wid == 0) { stamps[lane] = lane < nts ? (((unsigned long long)(unsigned)ts_hi << 32) | (unsigned)ts_lo) : 0ull;
        if (lane == 62) stamps[62] = rt_entry; if (lane == 63) stamps[63] = (unsigned long long)wall_clock64(); }
#undef PG8_STAMP
#undef PG8_SA
#undef PG8_SB
#undef PG8_STAGE
#undef PG8_LDA
#undef PG8_LDB
#undef PG8_MMA
#undef PG8_WAIT_V
#undef PG8_WAIT_L
#undef PG8_BAR
#undef PG8_SCHED
}
}
#define LAS __attribute__((address_space(3)))
#include <vector>

#define XB_TMO      128
#define XB_XCNT(j)  (256  + 64 * (j))
#define XB_XSUB(j)  (1280 + 64 * (j))
#define XB_XGEN(j)  (2304 + 64 * (j))
#define XB_TOP      3328
#define XB_TOPGEN   3392
#define XCD_BAR_WORDS 3456
#define XB_SPIN_CAP (1u << 18)

__device__ __forceinline__ unsigned xb_ld(unsigned* p)              { return __hip_atomic_load(p, __ATOMIC_RELAXED, __HIP_MEMORY_SCOPE_AGENT); }
__device__ __forceinline__ unsigned xb_add(unsigned* p, unsigned v) { return __hip_atomic_fetch_add(p, v, __ATOMIC_RELAXED, __HIP_MEMORY_SCOPE_AGENT); }
__device__ __forceinline__ unsigned xb_xcc_id() { return (unsigned)__builtin_amdgcn_s_getreg((3 << 11) | 20) & 0xFu; }
#define XB_SPIN(cond, bar) do { unsigned _sp = 0; while (cond) { __builtin_amdgcn_s_sleep(1); \
    if ((++_sp & 255u) == 0u) { if (xb_ld(&(bar)[XB_TMO])) break; if (_sp > XB_SPIN_CAP) { atomicAdd(&(bar)[XB_TMO], 1u); break; } } } } while (0)

struct XcdBarrier {
    unsigned* bar; unsigned x;
    volatile LAS unsigned* st;
};

__device__ __forceinline__ XcdBarrier xcd_barrier_post(unsigned* bar, volatile LAS unsigned* st) {
    XcdBarrier b; b.bar = bar; b.x = xb_xcc_id(); b.st = st;
    if (threadIdx.x == 0) (void)xb_add(&bar[XB_XCNT(b.x)], 1u);
    return b;
}
__device__ __forceinline__ void xcd_barrier_complete(unsigned* bar, unsigned x, unsigned& nloc, unsigned& nx) {
    const unsigned G = gridDim.x * gridDim.y * gridDim.z;
    unsigned sum, cnt, mine, sp = 0u;
    for (;;) {
        sum = 0u; cnt = 0u; mine = 0u;
#pragma unroll
        for (unsigned j = 0; j < 16; ++j) { const unsigned c = xb_ld(&bar[XB_XCNT(j)]); sum += c; cnt += (c > 0u) ? 1u : 0u; mine = (j == x) ? c : mine; }
        if (sum == G) break;
        __builtin_amdgcn_s_sleep(1);
        if ((++sp & 255u) == 0u) { if (xb_ld(&bar[XB_TMO])) break; if (sp > XB_SPIN_CAP) { atomicAdd(&bar[XB_TMO], 1u); break; } }
    }
    nloc = mine > 0u ? mine : 1u; nx = cnt > 0u ? cnt : 1u;
}

__device__ __forceinline__ void xcd_barrier(const XcdBarrier& b) {
    asm volatile("s_waitcnt vmcnt(0)" ::: "memory");
    __syncthreads();
    if (threadIdx.x == 0) {
        unsigned* bar = b.bar;
        __builtin_amdgcn_s_waitcnt(0);
        unsigned nloc = b.st[0], nx = b.st[1];
        if (nloc == 0u) { xcd_barrier_complete(bar, b.x, nloc, nx); b.st[0] = nloc; b.st[1] = nx; }
        const unsigned old = xb_add(&bar[XB_XSUB(b.x)], 1u);
        const unsigned gen = old / nloc;
        if (old + 1u == (gen + 1u) * nloc) {
            __builtin_amdgcn_fence(__ATOMIC_RELEASE, "agent");
            asm volatile("s_waitcnt vmcnt(0)" ::: "memory");
            const unsigned og = xb_add(&bar[XB_TOP], 1u);
            const unsigned tg = og / nx;
            if (og + 1u == (tg + 1u) * nx) xb_add(&bar[XB_TOPGEN], 1u);
            else XB_SPIN(xb_ld(&bar[XB_TOPGEN]) == tg, bar);
            __builtin_amdgcn_fence(__ATOMIC_ACQUIRE, "agent");
            xb_add(&bar[XB_XGEN(b.x)], 1u);
            asm volatile("s_waitcnt vmcnt(0)" ::: "memory");
        } else {
            XB_SPIN(xb_ld(&bar[XB_XGEN(b.x)]) == gen, bar);
            __builtin_amdgcn_fence(__ATOMIC_ACQUIRE, "agent");
            asm volatile("s_waitcnt vmcnt(0)" ::: "memory");
        }
    }
    __syncthreads();
}
namespace cg = cooperative_groups;
using pg8::bf16_t; using pg8::bf16x8; using pg8::f32x4; using pg8::u32x4;

typedef unsigned u32x2 __attribute__((ext_vector_type(2)));
typedef float f32x2v __attribute__((ext_vector_type(2)));

constexpr int D = 2048, TP = 2064, NBP = 4, MPR = NBP * TP, NBS = 128, TSM = 8, MSM = NBS * TSM, MTOT = MPR + MSM, MPAD = 9472;
constexpr float ALPHA = 1.41421356237309515f;
#ifndef REP_P0
#define REP_P0 1
#endif
#ifndef REP_HGRN
#define REP_HGRN 1
#endif
#ifndef REP_ATT
#define REP_ATT 1
#endif
#ifndef REP_LN
#define REP_LN 1
#endif
#ifndef REP_G1
#define REP_G1 1
#endif
#ifndef REP_G2
#define REP_G2 1
#endif
constexpr float LN_EPS = 1e-5f, RMS_EPS = 1e-6f;
constexpr int LDS_BYTES = 131072 + 64;
constexpr size_t OUT_YP = 0, OUT_YS = 16777216, OUT_SP = 18874368, OUT_SS = 19922944, OUT_KP = 53477376, OUT_VP = 53608448, OUT_KS = 53739520, OUT_VS = 57933824;
constexpr size_t SZ_BF = (size_t)MPAD * D * 2, SZ_F32 = (size_t)MPAD * D * 4;
constexpr size_t WS_WT0 = 0, WS_WTO0 = WS_WT0 + 33554432, WS_WT1 = WS_WTO0 + 8388608, WS_WTO1 = WS_WT1 + 18874368, WS_XB = WS_WTO1 + 8388608,
                 WS_QB = WS_XB + SZ_BF, WS_VB = WS_QB + SZ_BF, WS_GB = WS_VB + SZ_BF, WS_OB = WS_GB + SZ_BF, WS_LF = WS_OB + SZ_BF, WS_ZB = WS_LF + SZ_F32,
                 WS_K1 = WS_ZB + SZ_F32, WS_V1 = WS_K1 + 4849664, WS_LB = WS_V1 + 4849664, WS_BAR = WS_LB + 8192, WS_HU = WS_BAR + 16384, WS_HD = WS_HU + 256 * 65536, WS_END = WS_HD + 256 * 512;

struct Params {
    const float *x_prompt, *x_sample, *state, *cache_k, *cache_v, *meta, *w_in0, *lb_logits, *norm_w, *w_out0, *w_in1, *sinks, *w_out1, *ln_g, *ln_b;
    float* out; unsigned char* ws;
};

__device__ __forceinline__ float bf2f(unsigned short b) { return __uint_as_float(((unsigned)b) << 16); }
__device__ __forceinline__ unsigned short f2bf(float f) { unsigned u = __float_as_uint(f); u += 0x7FFFu + ((u >> 16) & 1u); return (unsigned short)(u >> 16); }
__device__ __forceinline__ unsigned pk2(float lo, float hi) { return pg8::cvt_pk_bf16(lo, hi); }
__device__ __forceinline__ float sigmoidf_(float x) { return 1.0f / (1.0f + __expf(-x)); }
__device__ __forceinline__ float siluf_(float x) { return x / (1.0f + __expf(-x)); }
#define LDS_WAIT() asm volatile("s_waitcnt lgkmcnt(0)" ::: "memory")

__device__ __forceinline__ const float* xrow_ptr(const Params& p, int row) {
    if (row < MPR) { const int b = row / TP, t = row - b * TP; return t < 16 ? p.meta + (size_t)t * D : p.x_prompt + ((size_t)b * 2048 + (t - 16)) * D; }
    return p.x_sample + (size_t)(row - MPR) * D;
}

__device__ __forceinline__ void p0_transpose_item(const float* __restrict__ W, int K, int N, bf16_t* __restrict__ WT, LAS float* scr, int item, int lane) {
    const int nblk = N / 32, kb = item / nblk, nb = item % nblk, k0 = 64 * kb, n0 = 32 * nb;
    f32x4 wv[8];
#pragma unroll
    for (int i = 0; i < 8; ++i) wv[i] = __builtin_nontemporal_load((const f32x4*)(W + (size_t)(k0 + 8 * i + (lane >> 3)) * N + n0 + 4 * (lane & 7)));
#pragma unroll
    for (int i = 0; i < 8; ++i) { LAS float* d_ = scr + (8 * i + (lane >> 3)) * 33 + 4 * (lane & 7); d_[0] = wv[i].x; d_[1] = wv[i].y; d_[2] = wv[i].z; d_[3] = wv[i].w; }
    LDS_WAIT();
    const int c = lane & 7;
#pragma unroll
    for (int j = 0; j < 4; ++j) { const int n = (lane >> 3) + 8 * j; const LAS float* s = scr + (8 * c) * 33 + n;
        u32x4 o; o.x = pk2(s[0 * 33], s[1 * 33]); o.y = pk2(s[2 * 33], s[3 * 33]); o.z = pk2(s[4 * 33], s[5 * 33]); o.w = pk2(s[6 * 33], s[7 * 33]);
        *(u32x4*)(WT + (size_t)(n0 + n) * K + k0 + 8 * c) = o; }
    LDS_WAIT();
}

__device__ __forceinline__ void phase0(const Params& p, LAS unsigned char* lds) {
    int tid_l = threadIdx.x; asm volatile("" : "+v"(tid_l)); const int tid = tid_l, wave = tid >> 6, lane = tid & 63;
    const int NGW = gridDim.x * 8, gw = wave * gridDim.x + blockIdx.x;
    LAS float* scr = (LAS float*)(lds + wave * 8448);
    constexpr int I0 = 32 * 256;
    bf16_t* WT0 = (bf16_t*)(p.ws + WS_WT0);
    for (int it = gw; it < I0; it += NGW) p0_transpose_item(p.w_in0, 2048, 8192, WT0, scr, it, lane);
    bf16_t* XB = (bf16_t*)(p.ws + WS_XB);
    for (int m = gw; m < MTOT; m += NGW) {
        const f32x4* src = (const f32x4*)xrow_ptr(p, m) + lane; u32x2* dst = (u32x2*)(XB + (size_t)m * D) + lane;
#pragma unroll
        for (int j = 0; j < 8; ++j) { const f32x4 v = __builtin_nontemporal_load(src + 64 * j); u32x2 o; o.x = pk2(v.x, v.y); o.y = pk2(v.z, v.w); dst[64 * j] = o; }
    }
    const int gt = blockIdx.x * 512 + tid, NGT = gridDim.x * 512;
    float* LB = (float*)(p.ws + WS_LB);
    for (int c = gt; c < D; c += NGT) { const float a = p.lb_logits[c], b = p.lb_logits[D + c], cc = p.lb_logits[2 * D + c]; const float m = fmaxf(a, fmaxf(b, cc));
        const float ea = __expf(a - m), eb = __expf(b - m), ec = __expf(cc - m); LB[c] = ea / (ea + eb + ec); }
}
__device__ __forceinline__ void phase0_rest(const Params& p, LAS unsigned char* lds, int li, int nl) {
    int tid_l = threadIdx.x; asm volatile("" : "+v"(tid_l)); const int tid = tid_l, wave = tid >> 6, lane = tid & 63;
    const int gw = li * 8 + wave, NGW = nl * 8;
    LAS float* scr = (LAS float*)(lds + wave * 8448);
    constexpr int I1 = 32 * 64, I2 = 32 * 144, I3 = 32 * 64;
    bf16_t* WTO0 = (bf16_t*)(p.ws + WS_WTO0); bf16_t* WT1 = (bf16_t*)(p.ws + WS_WT1); bf16_t* WTO1 = (bf16_t*)(p.ws + WS_WTO1);
    for (int it = gw; it < I1 + I2 + I3; it += NGW) {
        int r = it;
        if (r < I1) { p0_transpose_item(p.w_out0, 2048, 2048, WTO0, scr, r, lane); continue; } r -= I1;
        if (r < I2) { p0_transpose_item(p.w_in1, 2048, 4608, WT1, scr, r, lane); continue; } r -= I2;
        p0_transpose_item(p.w_out1, 2048, 2048, WTO1, scr, r, lane);
    }
}
__device__ __forceinline__ void phase_cache_shift(const Params& p, int li, int nl) {
    const int gt = li * 512 + threadIdx.x, NGT = nl * 512;
    const f32x4* ck = (const f32x4*)p.cache_k; const f32x4* cv = (const f32x4*)p.cache_v; f32x4* ok = (f32x4*)(p.out + OUT_KS); f32x4* ov = (f32x4*)(p.out + OUT_VS);
    constexpr int PER_B = 120 * 64;
    for (int i0 = gt; i0 < NBS * PER_B; i0 += 4 * NGT) { f32x4 a[4], c[4]; size_t o[4]; bool ok_[4];
#pragma unroll
        for (int u = 0; u < 4; ++u) { const int i = i0 + u * NGT; ok_[u] = i < NBS * PER_B; const int ii = ok_[u] ? i : 0; const int b = ii / PER_B, r = ii - b * PER_B; o[u] = (size_t)b * 8192 + r;
            a[u] = __builtin_nontemporal_load(ck + o[u] + 512); c[u] = __builtin_nontemporal_load(cv + o[u] + 512); }
#pragma unroll
        for (int u = 0; u < 4; ++u) if (ok_[u]) { __builtin_nontemporal_store(a[u], ok + o[u]); __builtin_nontemporal_store(c[u], ov + o[u]); } }
}

struct EpiHgrnIn {
    static constexpr bool PERM = true, AFTER_DRAIN = false;
    unsigned char* ws; float* LF; const float* LB;
    __device__ __forceinline__ void operator()(const f32x4 (&acc)[2][2][4][2], const pg8::Unit& u, int wr, int wc, int fr, int fq) const {
        const int sec = u.pn >> 3, colt = (u.pn & 7) * 256;
        const size_t secoff = sec == 0 ? WS_QB : (sec == 2 ? WS_VB : WS_GB);
        bf16_t* dst = (bf16_t*)(ws + secoff);
        const int row0 = u.pm * 256 + wr * 64 + fr, col0 = colt + wc * 32 + 8 * fq;
        float lb[2][8];
        if (sec == 1) {
#pragma unroll
            for (int bj = 0; bj < 2; ++bj) { const f32x4 a = *(const f32x4*)(LB + col0 + bj * 128), b = *(const f32x4*)(LB + col0 + bj * 128 + 4);
                lb[bj][0] = a.x; lb[bj][1] = a.y; lb[bj][2] = a.z; lb[bj][3] = a.w; lb[bj][4] = b.x; lb[bj][5] = b.y; lb[bj][6] = b.z; lb[bj][7] = b.w; }
        }
#pragma unroll
        for (int ai = 0; ai < 2; ++ai)
#pragma unroll
            for (int m = 0; m < 4; ++m) {
                const int row = row0 + ai * 128 + m * 16; if (row >= MTOT) continue;
#pragma unroll
                for (int bj = 0; bj < 2; ++bj) {
                    const size_t off = (size_t)row * D + col0 + bj * 128;
                    const f32x4 v0 = acc[ai][bj][m][0], v1 = acc[ai][bj][m][1];
                    float x[8] = {v0.x, v0.y, v0.z, v0.w, v1.x, v1.y, v1.z, v1.w};
                    if (sec == 1) {
#pragma unroll
                        for (int j = 0; j < 8; ++j) { const float l = lb[bj][j]; x[j] = l + (1.0f - l) * sigmoidf_(x[j]); }
                        *(f32x4*)(LF + off) = (f32x4){x[0], x[1], x[2], x[3]}; *(f32x4*)(LF + off + 4) = (f32x4){x[4], x[5], x[6], x[7]};
                    } else {
                        if (sec == 3) {
#pragma unroll
                            for (int j = 0; j < 8; ++j) x[j] = siluf_(x[j]);
                        }
                        u32x4 w; w.x = pk2(x[0], x[1]); w.y = pk2(x[2], x[3]); w.z = pk2(x[4], x[5]); w.w = pk2(x[6], x[7]);
                        *(u32x4*)(dst + off) = w;
                    }
                }
            }
    }
};
struct EpiSwaIn {
    static constexpr bool PERM = true, AFTER_DRAIN = false;
    bf16_t* Q; bf16_t* K1; bf16_t* V1; bf16_t* G; float* out;
    __device__ __forceinline__ void operator()(const f32x4 (&acc)[2][2][4][2], const pg8::Unit& u, int wr, int wc, int fr, int fq) const {
        const int pn = u.pn;
        const int row0 = u.pm * 256 + wr * 64 + fr, cw = wc * 32 + 8 * fq;
#pragma unroll
        for (int ai = 0; ai < 2; ++ai)
#pragma unroll
            for (int m = 0; m < 4; ++m) {
                const int row = row0 + ai * 128 + m * 16; if (row >= MTOT) continue;
#pragma unroll
                for (int bj = 0; bj < 2; ++bj) {
                    const f32x4 v0 = acc[ai][bj][m][0], v1 = acc[ai][bj][m][1];
                    float x[8] = {v0.x, v0.y, v0.z, v0.w, v1.x, v1.y, v1.z, v1.w};
                    const int c = cw + bj * 128;
                    if (pn < 8) {
                        constexpr float QS = 0.125f * 1.44269504089f;
                        u32x4 w; w.x = pk2(x[0] * QS, x[1] * QS); w.y = pk2(x[2] * QS, x[3] * QS); w.z = pk2(x[4] * QS, x[5] * QS); w.w = pk2(x[6] * QS, x[7] * QS);
                        *(u32x4*)(Q + (size_t)row * D + pn * 256 + c) = w;
                    } else if (pn >= 10) {
#pragma unroll
                        for (int j = 0; j < 8; ++j) x[j] = siluf_(x[j]);
                        u32x4 w; w.x = pk2(x[0], x[1]); w.y = pk2(x[2], x[3]); w.z = pk2(x[4], x[5]); w.w = pk2(x[6], x[7]);
                        *(u32x4*)(G + (size_t)row * D + (pn - 10) * 256 + c) = w;
                    } else {
                        u32x4 w; w.x = pk2(x[0], x[1]); w.y = pk2(x[2], x[3]); w.z = pk2(x[4], x[5]); w.w = pk2(x[6], x[7]);
                        bf16_t* dst = pn == 8 ? K1 : V1;
                        *(u32x4*)(dst + (size_t)row * 256 + c) = w;
                        float* co = nullptr;
                        if (row < MPR) { const int b = row / TP, t = row - b * TP; if (t >= TP - 128) co = out + (pn == 8 ? OUT_KP : OUT_VP) + ((size_t)b * 128 + (t - (TP - 128))) * 256 + c; }
                        else { const int r = row - MPR, b = r >> 3, t = r & 7; co = out + (pn == 8 ? OUT_KS : OUT_VS) + ((size_t)b * 128 + 120 + t) * 256 + c; }
                        if (co) { __builtin_nontemporal_store(v0, (f32x4*)co); __builtin_nontemporal_store(v1, (f32x4*)(co + 4)); }
                    }
                }
            }
    }
};
constexpr int SPLIT_ROW0 = 8192, SLAB_ROWS = MTOT - 8192;
struct OrderOut {
    pg8::StaticOrder S32; int G, c;
    __device__ void init(int G_, int c_) { S32.init(SPLIT_ROW0, 2048, G_, c_, 2048, 0); G = G_; c = c_; }
    __device__ bool next(int i, pg8::Unit& u) const {
        if (S32.next(i, u)) return true;
        const int R = (256 + G - 1) / G; if (i < R) return false;
        const long j = (long)(i - R) * G + c; if (j >= 160) return false;
        const int un = (int)(j >> 2); u.pm = 32 + (un >> 3); u.pn = un & 7; u.nkt = 8; u.kt0 = 8 * (int)(j & 3); return true;
    }
    __device__ __forceinline__ void a_ready(const pg8::Unit&) const {}
    __device__ __forceinline__ void done(const pg8::Unit&) const {}
};
struct EpiY {
    static constexpr bool PERM = true, AFTER_DRAIN = false;
    bf16_t* Y; float* slab;
    __device__ __forceinline__ void operator()(const f32x4 (&acc)[2][2][4][2], const pg8::Unit& u, int wr, int wc, int fr, int fq) const {
        const int row0 = u.pm * 256 + wr * 64 + fr, col0 = u.pn * 256 + wc * 32 + 8 * fq;
        const bool whole = u.nkt == 32;
        float* sbase = slab + ((size_t)(u.kt0 >> 3) * SLAB_ROWS - SPLIT_ROW0) * D;
#pragma unroll
        for (int ai = 0; ai < 2; ++ai)
#pragma unroll
            for (int m = 0; m < 4; ++m) {
                const int row = row0 + ai * 128 + m * 16; if (row >= MTOT) continue;
#pragma unroll
                for (int bj = 0; bj < 2; ++bj) { const f32x4 v0 = acc[ai][bj][m][0], v1 = acc[ai][bj][m][1]; const size_t off = (size_t)row * D + col0 + bj * 128;
                    if (whole) { u32x4 w; w.x = pk2(v0.x, v0.y); w.y = pk2(v0.z, v0.w); w.z = pk2(v1.x, v1.y); w.w = pk2(v1.z, v1.w); *(u32x4*)(Y + off) = w; }
                    else { *(f32x4*)(sbase + off) = v0; *(f32x4*)(sbase + off + 4) = v1; } }
            }
    }
};

template <int MODE> __device__ __forceinline__ void phase_ln(const Params& p, int layer) {
    int tid_l = threadIdx.x; asm volatile("" : "+v"(tid_l)); const int tid = tid_l, wave = tid >> 6, lane = tid & 63;
    const int NGW = gridDim.x * 8, gw = wave * gridDim.x + blockIdx.x;
    float* ZB = (float*)(p.ws + WS_ZB); bf16_t* XB = (bf16_t*)(p.ws + WS_XB); const bf16_t* YB = (const bf16_t*)(p.ws + WS_VB); const float* SL = (const float*)(p.ws + WS_LF);
    const f32x4* gp = (const f32x4*)(p.ln_g + (size_t)layer * D) + lane; const f32x4* bp = (const f32x4*)(p.ln_b + (size_t)layer * D) + lane;
    f32x4 nv[8]; u32x2 ny[8];
#define LN_LOAD(m_) do { const u32x2* y_ = (const u32x2*)(YB + (size_t)(m_) * D) + lane; \
        if (MODE == 1) { const f32x4* x_ = (const f32x4*)xrow_ptr(p, (m_)) + lane; _Pragma("unroll") for (int j = 0; j < 8; ++j) nv[j] = __builtin_nontemporal_load(x_ + 64 * j); } \
        else { const u32x2* x_ = (const u32x2*)(XB + (size_t)(m_) * D) + lane; _Pragma("unroll") for (int j = 0; j < 8; ++j) { const u32x2 w_ = x_[64 * j]; nv[j] = (f32x4){bf2f((unsigned short)(w_.x & 0xffffu)), bf2f((unsigned short)(w_.x >> 16)), bf2f((unsigned short)(w_.y & 0xffffu)), bf2f((unsigned short)(w_.y >> 16))}; } } \
        if ((m_) < SPLIT_ROW0) { _Pragma("unroll") for (int j = 0; j < 8; ++j) ny[j] = __builtin_nontemporal_load(y_ + 64 * j); } } while (0)
    if (gw < MTOT) LN_LOAD(gw);
    for (int m = gw; m < MTOT; m += NGW) {
        f32x4 v[8]; float s = 0.f;
        if (m < SPLIT_ROW0) {
#pragma unroll
            for (int j = 0; j < 8; ++j) { const f32x4 y = (f32x4){bf2f((unsigned short)(ny[j].x & 0xffffu)), bf2f((unsigned short)(ny[j].x >> 16)), bf2f((unsigned short)(ny[j].y & 0xffffu)), bf2f((unsigned short)(ny[j].y >> 16))}; v[j] = nv[j] * ALPHA + y; }
        } else {
#pragma unroll
            for (int j = 0; j < 8; ++j) v[j] = nv[j] * ALPHA;
            const f32x4* sl = (const f32x4*)(SL + (size_t)(m - SPLIT_ROW0) * D) + lane;
#pragma unroll
            for (int pc = 0; pc < 4; ++pc)
#pragma unroll
                for (int j = 0; j < 8; ++j) v[j] = v[j] + __builtin_nontemporal_load(sl + (size_t)pc * SLAB_ROWS * (D / 4) + 64 * j);
        }
        if (m + NGW < MTOT) LN_LOAD(m + NGW);
#pragma unroll
        for (int j = 0; j < 8; ++j) s += (v[j].x + v[j].y) + (v[j].z + v[j].w);
#pragma unroll
        for (int o = 1; o < 64; o <<= 1) s += __shfl_xor(s, o);
        const float mean = s * (1.0f / D); float s2 = 0.f;
#pragma unroll
        for (int j = 0; j < 8; ++j) { v[j] = v[j] - mean; s2 += (v[j].x * v[j].x + v[j].y * v[j].y) + (v[j].z * v[j].z + v[j].w * v[j].w); }
#pragma unroll
        for (int o = 1; o < 64; o <<= 1) s2 += __shfl_xor(s2, o);
        const float rstd = rsqrtf(s2 * (1.0f / D) + LN_EPS);
        if (MODE == 1) {
            u32x2* xb = (u32x2*)(XB + (size_t)m * D) + lane;
#pragma unroll
            for (int j = 0; j < 8; ++j) { const f32x4 y = v[j] * rstd * gp[64 * j] + bp[64 * j]; u32x2 o; o.x = pk2(y.x, y.y); o.y = pk2(y.z, y.w); xb[64 * j] = o; }
        } else {
            float* dst = nullptr;
            if (m < MPR) { const int b = m / TP, t = m - b * TP; if (t >= 16) dst = p.out + OUT_YP + ((size_t)b * 2048 + (t - 16)) * D; }
            else dst = p.out + OUT_YS + (size_t)(m - MPR) * D;
            if (dst) { f32x4* d4 = (f32x4*)dst + lane;
#pragma unroll
                for (int j = 0; j < 8; ++j) __builtin_nontemporal_store(v[j] * rstd * gp[64 * j] + bp[64 * j], d4 + 64 * j); }
        }
    }
#undef LN_LOAD
}

constexpr int H_QT = 0, H_KT = 17408, H_KTT = 34816, H_VT = 53248, H_AM = 71680, H_S0T = 80896, H_DEC = 115712, H_SEG = 116224;
#define MFMA16(a, b, c) __builtin_amdgcn_mfma_f32_16x16x32_bf16((a), (b), (c), 0, 0, 0)

__device__ __forceinline__ void hgrn_chain(const Params& p, LAS unsigned char* lds, int item, int pass) {
    const int ci = item >> 2, sg = item & 3;
    const int c_begin = sg == 0 ? 0 : 1 + 8 * sg, c_end = 9 + 8 * sg;
    const bool full = pass != 0;
    if (!full && sg == 3) return;
    int tid_l = threadIdx.x; asm volatile("" : "+v"(tid_l)); const int tid = tid_l, w = tid >> 6, lane = tid & 63, r16 = lane & 15, quad = lane >> 4;
    const int kcol = tid & 127, seg = tid >> 7;
    const int b = ci >> 4, h = ci & 15;
    const bf16_t* QB = (const bf16_t*)(p.ws + WS_QB); const float* LF = (const float*)(p.ws + WS_LF); const bf16_t* VB = (const bf16_t*)(p.ws + WS_VB);
    const bf16_t* GB = (const bf16_t*)(p.ws + WS_GB); bf16_t* OB = (bf16_t*)(p.ws + WS_OB);
    const int colbase = h * 128;
    const int tt = w >> 1, vh = w & 1;
    f32x4 S[8];
#pragma unroll
    for (int i = 0; i < 8; ++i) S[i] = (f32x4){0.f, 0.f, 0.f, 0.f};
    f32x4 dprod = (f32x4){1.f, 1.f, 1.f, 1.f};
    float* HU = (float*)(p.ws + WS_HU); float* HD = (float*)(p.ws + WS_HD);
    if (full) {
        for (int j = 0; j < sg; ++j) { const float* U = HU + (size_t)(ci * 4 + j) * 16384; const f32x4 dj = *(const f32x4*)(HD + (ci * 4 + j) * 128 + 16 * w + 4 * quad);
#pragma unroll
            for (int vt = 0; vt < 8; ++vt)
#pragma unroll
                for (int r = 0; r < 4; ++r) S[vt][r] = dj[r] * S[vt][r] + U[(16 * w + 4 * quad + r) * 128 + 16 * vt + r16]; }
#pragma unroll
        for (int vt = 0; vt < 8; ++vt) *(LAS u32x2*)(lds + H_S0T + (16 * vt + r16) * 272 + (16 * w + 4 * quad) * 2) = (u32x2){pk2(S[vt].x, S[vt].y), pk2(S[vt].z, S[vt].w)};
    }
    float lf[16]; unsigned short qr[16], vr[16];
#define HG_LOAD(c_) do { const int t0_ = 64 * (c_); _Pragma("unroll") for (int i = 0; i < 16; ++i) { const int t_ = t0_ + 16 * seg + i; const bool ok_ = t_ < TP; \
        const size_t off_ = ((size_t)(b * TP + (ok_ ? t_ : 0))) * D + colbase + kcol; \
        float l_; unsigned short q_ = 0, v_; if (full) { l_ = __builtin_nontemporal_load(LF + off_); q_ = __builtin_nontemporal_load(QB + off_); v_ = __builtin_nontemporal_load(VB + off_); } else { l_ = LF[off_]; v_ = VB[off_]; } \
        lf[i] = ok_ ? l_ : 1.f; qr[i] = ok_ ? q_ : (unsigned short)0; vr[i] = ok_ ? v_ : (unsigned short)0; } } while (0)
    HG_LOAD(c_begin);
    for (int c = c_begin; c < c_end; ++c) {
        float bl[16]; float run = 1.f;
#pragma unroll
        for (int i = 0; i < 16; ++i) { run *= lf[i]; bl[i] = run; }
        ((LAS float*)(lds + H_SEG))[seg * 128 + kcol] = run;
        __syncthreads();
        float pre = 1.f;
        for (int s = 0; s < seg; ++s) pre *= ((LAS float*)(lds + H_SEG))[s * 128 + kcol];
        unsigned ktp[8], vtp[8]; float eb_last = 1.f;
#pragma unroll
        for (int i = 0; i < 16; i += 2) {
            float kt2[2], qt2[2];
#pragma unroll
            for (int e = 0; e < 2; ++e) { const float eb = pre * bl[i + e], enb = __builtin_amdgcn_rcpf(eb); const float q = bf2f(qr[i + e]); const float kk = 1.0f - lf[i + e];
                qt2[e] = q * eb; kt2[e] = kk * enb; eb_last = eb; }
            ktp[i >> 1] = pk2(kt2[0], kt2[1]); vtp[i >> 1] = (unsigned)vr[i] | ((unsigned)vr[i + 1] << 16);
            if (full) { const unsigned qp = pk2(qt2[0], qt2[1]); const int ts = 16 * seg + i;
                *(LAS unsigned short*)(lds + H_QT + ts * 272 + kcol * 2) = (unsigned short)qp; *(LAS unsigned short*)(lds + H_QT + (ts + 1) * 272 + kcol * 2) = (unsigned short)(qp >> 16);
                *(LAS unsigned short*)(lds + H_KT + ts * 272 + kcol * 2) = (unsigned short)ktp[i >> 1]; *(LAS unsigned short*)(lds + H_KT + (ts + 1) * 272 + kcol * 2) = (unsigned short)(ktp[i >> 1] >> 16); }
        }
        *(LAS u32x4*)(lds + H_KTT + kcol * 144 + seg * 32) = (u32x4){ktp[0], ktp[1], ktp[2], ktp[3]};
        *(LAS u32x4*)(lds + H_KTT + kcol * 144 + seg * 32 + 16) = (u32x4){ktp[4], ktp[5], ktp[6], ktp[7]};
        *(LAS u32x4*)(lds + H_VT + kcol * 144 + seg * 32) = (u32x4){vtp[0], vtp[1], vtp[2], vtp[3]};
        *(LAS u32x4*)(lds + H_VT + kcol * 144 + seg * 32 + 16) = (u32x4){vtp[4], vtp[5], vtp[6], vtp[7]};
        if (seg == 3) ((LAS float*)(lds + H_DEC))[kcol] = eb_last;
        { const int cn = (c + 1 < c_end) ? c + 1 : c; HG_LOAD(cn); }
        __syncthreads();
        const f32x4 dec = *(const LAS f32x4*)(lds + H_DEC + (16 * w + 4 * quad) * 4);
        dprod = dprod * dec;
        if (!full) {
#pragma unroll
            for (int ss = 0; ss < 2; ++ss) { const bf16x8 ka = *(const LAS bf16x8*)(lds + H_KTT + (16 * w + r16) * 144 + (32 * ss + 8 * quad) * 2);
#pragma unroll
                for (int vt = 0; vt < 8; ++vt) { const bf16x8 vb = *(const LAS bf16x8*)(lds + H_VT + (16 * vt + r16) * 144 + (32 * ss + 8 * quad) * 2); S[vt] = MFMA16(ka, vb, S[vt]); } }
#pragma unroll
            for (int vt = 0; vt < 8; ++vt) S[vt] = S[vt] * dec;
        } else {
        const int nt_ = tid >> 3, njj = tid & 7; const int tg = 64 * c + nt_;
        const size_t goff = ((size_t)(tg < TP ? b * TP + tg : MTOT + nt_)) * D + colbase + 16 * njj;
        const u32x4 g0 = __builtin_nontemporal_load((const u32x4*)(GB + goff)), g1 = __builtin_nontemporal_load((const u32x4*)(GB + goff + 8));
        bf16x8 qa[4];
#pragma unroll
        for (int ks = 0; ks < 4; ++ks) qa[ks] = *(const LAS bf16x8*)(lds + H_QT + (16 * tt + r16) * 272 + (32 * ks + 8 * quad) * 2);
        f32x4 O[4];
#pragma unroll
        for (int j = 0; j < 4; ++j) { O[j] = (f32x4){0.f, 0.f, 0.f, 0.f}; const int vt = 4 * vh + j;
#pragma unroll
            for (int ks = 0; ks < 4; ++ks) { const bf16x8 sb = *(const LAS bf16x8*)(lds + H_S0T + (16 * vt + r16) * 272 + (32 * ks + 8 * quad) * 2); O[j] = MFMA16(qa[ks], sb, O[j]); } }
#pragma unroll
        for (int j = 0; j < 2; ++j) { const int st = 2 * vh + j; f32x4 a = (f32x4){0.f, 0.f, 0.f, 0.f};
            if (st <= tt) {
#pragma unroll
                for (int ks = 0; ks < 4; ++ks) { const bf16x8 kb = *(const LAS bf16x8*)(lds + H_KT + (16 * st + r16) * 272 + (32 * ks + 8 * quad) * 2); a = MFMA16(qa[ks], kb, a); } }
#pragma unroll
            for (int r = 0; r < 4; ++r) { const int tl = 16 * tt + 4 * quad + r, sl = 16 * st + r16; const float val = (sl <= tl) ? a[r] : 0.f;
                *(LAS unsigned short*)(lds + H_AM + tl * 144 + sl * 2) = f2bf(val); } }
        __syncthreads();
#pragma unroll
        for (int ss = 0; ss < 2; ++ss) { const bf16x8 aa = *(const LAS bf16x8*)(lds + H_AM + (16 * tt + r16) * 144 + (32 * ss + 8 * quad) * 2);
#pragma unroll
            for (int j = 0; j < 4; ++j) { const int vt = 4 * vh + j; const bf16x8 vb = *(const LAS bf16x8*)(lds + H_VT + (16 * vt + r16) * 144 + (32 * ss + 8 * quad) * 2); O[j] = MFMA16(aa, vb, O[j]); } }
#pragma unroll
        for (int ss = 0; ss < 2; ++ss) { const bf16x8 ka = *(const LAS bf16x8*)(lds + H_KTT + (16 * w + r16) * 144 + (32 * ss + 8 * quad) * 2);
#pragma unroll
            for (int vt = 0; vt < 8; ++vt) { const bf16x8 vb = *(const LAS bf16x8*)(lds + H_VT + (16 * vt + r16) * 144 + (32 * ss + 8 * quad) * 2); S[vt] = MFMA16(ka, vb, S[vt]); } }
#pragma unroll
        for (int vt = 0; vt < 8; ++vt) { S[vt] = S[vt] * dec;
            *(LAS u32x2*)(lds + H_S0T + (16 * vt + r16) * 272 + (16 * w + 4 * quad) * 2) = (u32x2){pk2(S[vt].x, S[vt].y), pk2(S[vt].z, S[vt].w)}; }
#pragma unroll
        for (int j = 0; j < 4; ++j) { const int vt = 4 * vh + j;
#pragma unroll
            for (int r = 0; r < 4; ++r) ((LAS float*)lds)[(16 * tt + 4 * quad + r) * 132 + 16 * vt + r16] = O[j][r]; }
        __syncthreads();
        { const int t = nt_, jj = njj;
          f32x4 o4[4]; float ss = 0.f;
#pragma unroll
          for (int i = 0; i < 4; ++i) { o4[i] = *(const LAS f32x4*)(lds + (t * 132 + 16 * jj + 4 * i) * 4); ss += (o4[i].x * o4[i].x + o4[i].y * o4[i].y) + (o4[i].z * o4[i].z + o4[i].w * o4[i].w); }
          ss += __shfl_xor(ss, 1); ss += __shfl_xor(ss, 2); ss += __shfl_xor(ss, 4);
          const float rstd = rsqrtf(ss * (1.0f / 128.0f) + RMS_EPS);
          { const size_t off = goff;
              const unsigned gw_[8] = {g0.x, g0.y, g0.z, g0.w, g1.x, g1.y, g1.z, g1.w};
              const float* nw = p.norm_w + colbase + 16 * jj;
              unsigned ow[8];
#pragma unroll
              for (int i = 0; i < 4; ++i) { const f32x4 n4 = *(const f32x4*)(nw + 4 * i);
                  const float y0 = o4[i].x * rstd * n4.x * bf2f((unsigned short)(gw_[2 * i] & 0xffffu)), y1 = o4[i].y * rstd * n4.y * bf2f((unsigned short)(gw_[2 * i] >> 16));
                  const float y2 = o4[i].z * rstd * n4.z * bf2f((unsigned short)(gw_[2 * i + 1] & 0xffffu)), y3 = o4[i].w * rstd * n4.w * bf2f((unsigned short)(gw_[2 * i + 1] >> 16));
                  ow[2 * i] = pk2(y0, y1); ow[2 * i + 1] = pk2(y2, y3); }
              *(u32x4*)(OB + off) = (u32x4){ow[0], ow[1], ow[2], ow[3]}; *(u32x4*)(OB + off + 8) = (u32x4){ow[4], ow[5], ow[6], ow[7]}; }
        }
        }
    }
#undef HG_LOAD
    if (!full || sg == 3) {
        float* so = full ? p.out + OUT_SP + ((size_t)(b * 16 + h)) * 16384 : HU + (size_t)item * 16384;
#pragma unroll
        for (int vt = 0; vt < 8; ++vt)
#pragma unroll
            for (int r = 0; r < 4; ++r) { float* d_ = so + (16 * w + 4 * quad + r) * 128 + 16 * vt + r16; if (full) __builtin_nontemporal_store(S[vt][r], d_); else *d_ = S[vt][r]; }
        if (!full && r16 == 0) *(f32x4*)(HD + item * 128 + 16 * w + 4 * quad) = dprod;
    }
    __syncthreads();
}

constexpr int SS_Q = 0, SS_K = 4096, SS_V = 8192, SS_E8 = 12288, SS_A = 12800, SS_B = 13056, SS_QR = 17152, SS_PART = 25600;
struct SampRaw { float lf[2]; unsigned short q[2], v[2]; f32x4 s0[8]; };
__device__ __forceinline__ void hgrn_sample_load(const Params& p, int it, SampRaw& r) {
    int tid_l = threadIdx.x; asm volatile("" : "+v"(tid_l)); const int tid = tid_l, b = it >> 4, h = it & 15;
    const bf16_t* QB = (const bf16_t*)(p.ws + WS_QB); const float* LF = (const float*)(p.ws + WS_LF); const bf16_t* VB = (const bf16_t*)(p.ws + WS_VB);
    const size_t rbase = ((size_t)(MPR + b * 8)) * D + h * 128;
#pragma unroll
    for (int j = 0; j < 2; ++j) { const int rem = tid + 512 * j, t = rem >> 7, k = rem & 127; const size_t o = rbase + (size_t)t * D + k; r.lf[j] = __builtin_nontemporal_load(LF + o); r.q[j] = __builtin_nontemporal_load(QB + o); r.v[j] = __builtin_nontemporal_load(VB + o); }
    { const int v4 = tid & 31, kg = tid >> 5; const float* S0 = p.state + ((size_t)(b * 16 + h)) * 16384;
#pragma unroll
      for (int i = 0; i < 8; ++i) r.s0[i] = __builtin_nontemporal_load((const f32x4*)(S0 + (8 * kg + i) * 128 + 4 * v4)); }
}
__device__ __forceinline__ void hgrn_sample_item(const Params& p, LAS unsigned char* lds, int it, int it_next, SampRaw& raw) {
    int tid_l = threadIdx.x; asm volatile("" : "+v"(tid_l)); const int tid = tid_l, lane = tid & 63;
    const int b = it >> 4, h = it & 15;
    const bf16_t* GB = (const bf16_t*)(p.ws + WS_GB); bf16_t* OB = (bf16_t*)(p.ws + WS_OB);
    const size_t rbase = ((size_t)(MPR + b * 8)) * D + h * 128;
    LAS float* SQ = (LAS float*)(lds + SS_Q); LAS float* SK = (LAS float*)(lds + SS_K); LAS float* SV = (LAS float*)(lds + SS_V); LAS float* SE8 = (LAS float*)(lds + SS_E8);
    LAS float* SA = (LAS float*)(lds + SS_A); LAS float* SB = (LAS float*)(lds + SS_B); LAS float* SQR = (LAS float*)(lds + SS_QR);
    LAS float* PART = (LAS float*)(lds + SS_PART);
    const int v4 = tid & 31, kg = tid >> 5;
    const float* S0 = p.state + ((size_t)(b * 16 + h)) * 16384; float* S1 = p.out + OUT_SS + ((size_t)(b * 16 + h)) * 16384;
    f32x4 s0[8];
#pragma unroll
    for (int i = 0; i < 8; ++i) s0[i] = raw.s0[i];
#pragma unroll
    for (int j = 0; j < 2; ++j) { const int rem = tid + 512 * j; SB[rem] = raw.lf[j]; SQR[rem] = bf2f(raw.q[j]); SV[rem] = bf2f(raw.v[j]); }
    __syncthreads();
    if (it_next < 2048) hgrn_sample_load(p, it_next, raw);
    if (tid < 128) { const int k = tid; float lfv[8], bt[8]; float run = 1.f;
#pragma unroll
        for (int t = 0; t < 8; ++t) { lfv[t] = SB[t * 128 + k]; run *= lfv[t]; bt[t] = run; }
#pragma unroll
        for (int t = 0; t < 8; ++t) { SQ[k * 8 + t] = SQR[t * 128 + k] * bt[t]; SK[k * 8 + t] = (1.0f - lfv[t]) * __builtin_amdgcn_rcpf(bt[t]); }
        SE8[k] = run;
    }
    __syncthreads();
    { const int pair = tid >> 3, ks = tid & 7, t = pair >> 3, s = pair & 7; float a = 0.f;
#pragma unroll
        for (int i = 0; i < 16; ++i) a += SQ[(ks + 8 * i) * 8 + t] * SK[(ks + 8 * i) * 8 + s];
        a += __shfl_xor(a, 1); a += __shfl_xor(a, 2); a += __shfl_xor(a, 4);
        if (ks == 0) SA[pair] = (s <= t) ? a : 0.f; }
    {
        f32x4 vv[8], o[8];
#pragma unroll
        for (int s = 0; s < 8; ++s) { vv[s] = *(const LAS f32x4*)(SV + s * 128 + 4 * v4); o[s] = (f32x4){0.f, 0.f, 0.f, 0.f}; }
#pragma unroll
        for (int i = 0; i < 8; ++i) { const int k = 8 * kg + i;
            const f32x4 qa = *(const LAS f32x4*)(SQ + k * 8), qb = *(const LAS f32x4*)(SQ + k * 8 + 4), ka = *(const LAS f32x4*)(SK + k * 8), kb = *(const LAS f32x4*)(SK + k * 8 + 4);
            const float q8[8] = {qa.x, qa.y, qa.z, qa.w, qb.x, qb.y, qb.z, qb.w}, k8[8] = {ka.x, ka.y, ka.z, ka.w, kb.x, kb.y, kb.z, kb.w};
            f32x4 sn = s0[i];
#pragma unroll
            for (int t = 0; t < 8; ++t) { o[t] = o[t] + s0[i] * q8[t]; sn = sn + vv[t] * k8[t]; }
            __builtin_nontemporal_store(sn * SE8[k], (f32x4*)(S1 + k * 128 + 4 * v4)); }
#pragma unroll
        for (int t = 0; t < 8; ++t) *(LAS f32x4*)(PART + (kg * 8 + t) * 128 + 4 * v4) = o[t];
    }
    __syncthreads();
    { const int t = tid >> 6, vp = lane; f32x2v o2 = (f32x2v){0.f, 0.f};
#pragma unroll
        for (int g = 0; g < 16; ++g) o2 = o2 + *(const LAS f32x2v*)(PART + (g * 8 + t) * 128 + 2 * vp);
#pragma unroll
        for (int s = 0; s < 8; ++s) o2 = o2 + *(const LAS f32x2v*)(SV + s * 128 + 2 * vp) * SA[t * 8 + s];
        float ss = o2.x * o2.x + o2.y * o2.y;
#pragma unroll
        for (int m = 1; m < 64; m <<= 1) ss += __shfl_xor(ss, m);
        const float rstd = rsqrtf(ss * (1.0f / 128.0f) + RMS_EPS);
        const size_t off = rbase + (size_t)t * D + 2 * vp;
        const unsigned g = __builtin_nontemporal_load((const unsigned*)(GB + off)); const f32x2v nw = *(const f32x2v*)(p.norm_w + h * 128 + 2 * vp);
        *(unsigned*)(OB + off) = pk2(o2.x * rstd * nw.x * bf2f((unsigned short)(g & 0xffffu)), o2.y * rstd * nw.y * bf2f((unsigned short)(g >> 16))); }
    __syncthreads();
}

__device__ __forceinline__ void phase_hgrn(const Params& p, LAS unsigned char* lds, const XcdBarrier& xb) {
    const int G = gridDim.x, blk = blockIdx.x;
    const bool early = (G == 256) && ((blk & 3) == 3); constexpr int NEARLY = 64 * 6;
    const int s_lo = (G == 256) ? NEARLY : 0;
    const bool swap = (G == 256) && (((blk >> 2) & 1) != 0);
    for (int stage = 0; stage < 2; ++stage) {
        for (int k = 0; k < 2; ++k) {
            const bool do_chain = (stage == 0) ? (k == 0) : ((k == 0) != swap);
            if (do_chain) { for (int it = blk; it < 256; it += G) hgrn_chain(p, lds, it, stage); }
            else {
                int it, step, end;
                if (stage == 0) { it = early ? (blk >> 2) : 4096; step = 64; end = NEARLY; } else { it = s_lo + blk; step = G; end = 2048; }
                SampRaw raw; if (it < end) hgrn_sample_load(p, it, raw);
                for (; it < end; it += step) hgrn_sample_item(p, lds, it, (it + step < end) ? it + step : 4096, raw);
            }
        }
        if (stage == 0) xcd_barrier(xb);
    }
}

constexpr int A_KS = 0, A_VT = 23040;
constexpr int ATT_PROMPT_ITEMS = NBP * 4 * 65, ATT_ITEMS = ATT_PROMPT_ITEMS + NBS * 4;
struct AttPre { u32x4 r[3][4]; };
__device__ __forceinline__ void attn_load(const Params& p, int it, AttPre& pre) {
    const int tid = threadIdx.x;
    const bf16_t* K1 = (const bf16_t*)(p.ws + WS_K1); const bf16_t* V1 = (const bf16_t*)(p.ws + WS_V1);
    const bool samp = it >= ATT_PROMPT_ITEMS;
    int b, kvh, t0 = 0;
    if (!samp) { b = it / 260; const int rem = it - b * 260; kvh = rem / 65; t0 = 32 * (rem - kvh * 65); } else { const int j = it - ATT_PROMPT_ITEMS; b = j >> 2; kvh = j & 3; }
#pragma unroll
    for (int u = 0; u < 3; ++u) { const int idx = tid + 512 * u;
        const int kA = idx >> 3, cA = idx & 7;
        const int cB = idx / 160, kB = idx - 160 * cB;
        const u32x4 z = (u32x4){0u, 0u, 0u, 0u}; pre.r[u][0] = z; pre.r[u][1] = z; pre.r[u][2] = z; pre.r[u][3] = z;
        if (idx < 1280) {
            if (!samp) { const int pA = t0 - 128 + kA, pB = t0 - 128 + kB;
                if (pA >= 0 && pA < TP) pre.r[u][0] = *(const u32x4*)(K1 + ((size_t)(b * TP + pA)) * 256 + kvh * 64 + 8 * cA);
                if (pB >= 0 && pB < TP) pre.r[u][1] = *(const u32x4*)(V1 + ((size_t)(b * TP + pB)) * 256 + kvh * 64 + 8 * cB); }
            else {
                if (kA < 128) { const size_t o = (((size_t)b * 128 + kA) * 4 + kvh) * 64 + 8 * cA; pre.r[u][0] = *(const u32x4*)(p.cache_k + o); pre.r[u][1] = *(const u32x4*)(p.cache_k + o + 4); }
                else if (kA < 136) pre.r[u][0] = *(const u32x4*)(K1 + ((size_t)(MPR + b * 8 + kA - 128)) * 256 + kvh * 64 + 8 * cA);
                if (kB < 128) { const size_t o = (((size_t)b * 128 + kB) * 4 + kvh) * 64 + 8 * cB; pre.r[u][2] = *(const u32x4*)(p.cache_v + o); pre.r[u][3] = *(const u32x4*)(p.cache_v + o + 4); }
                else if (kB < 136) pre.r[u][2] = *(const u32x4*)(V1 + ((size_t)(MPR + b * 8 + kB - 128)) * 256 + kvh * 64 + 8 * cB);
            }
        } }
}
__device__ __forceinline__ void attn_stage(LAS unsigned char* base, int itp, const AttPre& pre) {
    const int tid = threadIdx.x; const bool samp = itp >= ATT_PROMPT_ITEMS;
#pragma unroll
    for (int u = 0; u < 3; ++u) { const int idx = tid + 512 * u;
        const int kA = idx >> 3, cA = idx & 7, cB = idx / 160, kB = idx - 160 * cB;
        if (idx < 1280) {
            u32x4 kv = pre.r[u][0], vv = samp ? pre.r[u][2] : pre.r[u][1];
            if (samp && kA < 128) { const f32x4 a = __builtin_bit_cast(f32x4, pre.r[u][0]), bq = __builtin_bit_cast(f32x4, pre.r[u][1]); kv = (u32x4){pk2(a.x, a.y), pk2(a.z, a.w), pk2(bq.x, bq.y), pk2(bq.z, bq.w)}; }
            if (samp && kB < 128) { const f32x4 c = __builtin_bit_cast(f32x4, pre.r[u][2]), d = __builtin_bit_cast(f32x4, pre.r[u][3]); vv = (u32x4){pk2(c.x, c.y), pk2(c.z, c.w), pk2(d.x, d.y), pk2(d.z, d.w)}; }
            *(LAS u32x4*)(base + A_KS + kA * 144 + cA * 16) = kv;
            const unsigned vw[4] = {vv.x, vv.y, vv.z, vv.w};
#pragma unroll
            for (int j = 0; j < 4; ++j) { *(LAS unsigned short*)(base + A_VT + (8 * cB + 2 * j) * 336 + kB * 2) = (unsigned short)(vw[j] & 0xffffu);
                *(LAS unsigned short*)(base + A_VT + (8 * cB + 2 * j + 1) * 336 + kB * 2) = (unsigned short)(vw[j] >> 16); }
        } }
}
constexpr int ATT_BUF = 44544;
__device__ __forceinline__ void attn_item(const Params& p, LAS unsigned char* lds_all, int it, int it_n1, int it_n2, int cur, AttPre& pre) {
    int tid_l = threadIdx.x; asm volatile("" : "+v"(tid_l)); const int tid = tid_l, w = tid >> 6, lane = tid & 63, r16 = lane & 15, quad = lane >> 4;
    LAS unsigned char* lds = lds_all + cur * ATT_BUF; LAS unsigned char* ldsn = lds_all + (cur ^ 1) * ATT_BUF;
    const bf16_t* Q1 = (const bf16_t*)(p.ws + WS_QB);
    const bf16_t* GB = (const bf16_t*)(p.ws + WS_GB); bf16_t* OB = (bf16_t*)(p.ws + WS_OB);
    const bool samp = it >= ATT_PROMPT_ITEMS;
    int b, kvh, t0 = 0;
    if (!samp) { b = it / 260; const int rem = it - b * 260; kvh = rem / 65; t0 = 32 * (rem - kvh * 65); } else { const int j = it - ATT_PROMPT_ITEMS; b = j >> 2; kvh = j & 3; }
    const int hq = kvh * 8 + w;
    bf16x8 qf[2][2]; bool qok[2]; size_t qrow[2];
#pragma unroll
    for (int tt = 0; tt < 2; ++tt) { const int i = 16 * tt + r16;
        if (!samp) { const int t = t0 + i; qok[tt] = t < TP; qrow[tt] = (size_t)(b * TP + (qok[tt] ? t : 0)); } else { qok[tt] = i < 8; qrow[tt] = (size_t)(MPR + b * 8 + (qok[tt] ? i : 0)); }
#pragma unroll
        for (int ds = 0; ds < 2; ++ds) { bf16x8 q = __builtin_nontemporal_load((const bf16x8*)(Q1 + qrow[tt] * D + hq * 64 + 32 * ds + 8 * quad)); if (!qok[tt]) q = (bf16x8){0, 0, 0, 0, 0, 0, 0, 0}; qf[tt][ds] = q; } }
    u32x4 gw[4]; size_t orow[4]; bool ook[4];
#pragma unroll
    for (int k = 0; k < 4; ++k) { const int i = 8 * k + (lane >> 3);
        if (!samp) { const int t = t0 + i; ook[k] = t < TP; orow[k] = (size_t)(b * TP + (ook[k] ? t : 0)); } else { ook[k] = i < 8; orow[k] = (size_t)(MPR + b * 8 + (ook[k] ? i : 0)); }
        gw[k] = __builtin_nontemporal_load((const u32x4*)(GB + orow[k] * D + hq * 64 + 8 * (lane & 7))); }
    __syncthreads();
    f32x4 st[10][2];
#pragma unroll
    for (int kt = 0; kt < 10; ++kt) { st[kt][0] = (f32x4){0.f, 0.f, 0.f, 0.f}; st[kt][1] = (f32x4){0.f, 0.f, 0.f, 0.f};
#pragma unroll
        for (int ds = 0; ds < 2; ++ds) { const bf16x8 ka = *(const LAS bf16x8*)(lds + A_KS + (16 * kt + r16) * 144 + (32 * ds + 8 * quad) * 2);
            st[kt][0] = MFMA16(ka, qf[0][ds], st[kt][0]); if (!samp) st[kt][1] = MFMA16(ka, qf[1][ds], st[kt][1]); } }
    const float sink = p.sinks[hq] * 1.44269504089f;
    const int kminv = samp ? 0 : (128 - t0 > 0 ? 128 - t0 : 0);
    const bool midfree = kminv <= 32;
    const int ntt = samp ? 1 : 2;
    bf16x8 pb[5][2]; float inv[2] = {0.f, 0.f};
#pragma unroll
    for (int tt = 0; tt < 2; ++tt) if (tt < ntt) { const int i = 16 * tt + r16; const int lo = (i + 1 > kminv) ? i + 1 : kminv, hi = i + 128;
        float m = -INFINITY;
#pragma unroll
        for (int kt = 0; kt < 10; ++kt) {
            if (kt >= 2 && kt < 8 && midfree) {
#pragma unroll
                for (int r = 0; r < 4; ++r) m = fmaxf(m, st[kt][tt][r]);
            } else {
#pragma unroll
                for (int r = 0; r < 4; ++r) { const int kp = 16 * kt + 4 * quad + r; const float s = (kp >= lo && kp <= hi) ? st[kt][tt][r] : -INFINITY; st[kt][tt][r] = s; m = fmaxf(m, s); }
            } }
        m = fmaxf(m, __shfl_xor(m, 16)); m = fmaxf(m, __shfl_xor(m, 32)); m = fmaxf(m, sink);
        float sum = 0.f;
#pragma unroll
        for (int kt = 0; kt < 10; ++kt)
#pragma unroll
            for (int r = 0; r < 4; ++r) { const float e = __builtin_amdgcn_exp2f(st[kt][tt][r] - m); st[kt][tt][r] = e; sum += e; }
        sum += __shfl_xor(sum, 16); sum += __shfl_xor(sum, 32); sum += __builtin_amdgcn_exp2f(sink - m);
        inv[tt] = 1.0f / sum;
#pragma unroll
        for (int ks = 0; ks < 5; ++ks) { const f32x4 a = st[2 * ks][tt], c = st[2 * ks + 1][tt];
            const u32x4 pw = (u32x4){pk2(a.x, a.y), pk2(a.z, a.w), pk2(c.x, c.y), pk2(c.z, c.w)}; pb[ks][tt] = __builtin_bit_cast(bf16x8, pw); }
    }
    if (it_n1 < ATT_ITEMS) attn_stage(ldsn, it_n1, pre);
    if (it_n2 < ATT_ITEMS) attn_load(p, it_n2, pre);
    f32x4 o[4][2];
#pragma unroll
    for (int dt = 0; dt < 4; ++dt) { o[dt][0] = (f32x4){0.f, 0.f, 0.f, 0.f}; o[dt][1] = (f32x4){0.f, 0.f, 0.f, 0.f}; }
#pragma unroll
    for (int ks = 0; ks < 5; ++ks)
#pragma unroll
        for (int dt = 0; dt < 4; ++dt) { const u32x2 l8 = *(const LAS u32x2*)(lds + A_VT + (16 * dt + r16) * 336 + (32 * ks + 4 * quad) * 2), h8 = *(const LAS u32x2*)(lds + A_VT + (16 * dt + r16) * 336 + (32 * ks + 16 + 4 * quad) * 2);
            const bf16x8 va = __builtin_bit_cast(bf16x8, (u32x4){l8.x, l8.y, h8.x, h8.y});
            o[dt][0] = MFMA16(va, pb[ks][0], o[dt][0]); if (ntt > 1) o[dt][1] = MFMA16(va, pb[ks][1], o[dt][1]); }
    LAS unsigned char* os = lds_all + 2 * ATT_BUF + w * 4608;
#pragma unroll
    for (int tt = 0; tt < 2; ++tt) if (tt < ntt) {
#pragma unroll
        for (int dt = 0; dt < 4; ++dt) { const f32x4 x = o[dt][tt] * inv[tt];
            *(LAS u32x2*)(os + (16 * tt + r16) * 144 + (16 * dt + 4 * quad) * 2) = (u32x2){pk2(x.x, x.y), pk2(x.z, x.w)}; } }
    LDS_WAIT();
#pragma unroll
    for (int k = 0; k < 4; ++k) if (k < 2 * ntt) { const int i = 8 * k + (lane >> 3);
        const u32x4 ov = *(const LAS u32x4*)(os + i * 144 + (lane & 7) * 16);
        const unsigned ow_[4] = {ov.x, ov.y, ov.z, ov.w}, gg[4] = {gw[k].x, gw[k].y, gw[k].z, gw[k].w}; unsigned rr[4];
#pragma unroll
        for (int j = 0; j < 4; ++j) rr[j] = pk2(__uint_as_float(ow_[j] << 16) * __uint_as_float(gg[j] << 16), __uint_as_float(ow_[j] & 0xffff0000u) * __uint_as_float(gg[j] & 0xffff0000u));
        if (ook[k]) *(u32x4*)(OB + orow[k] * D + hq * 64 + 8 * (lane & 7)) = (u32x4){rr[0], rr[1], rr[2], rr[3]}; }
    LDS_WAIT();
}
__device__ __forceinline__ int att_item_of(int blk, int r, int G) {
    if (G != 256) return blk + r * G;
    if (r < 6) return blk + 256 * r;
    return (r == 6 && blk >= 16 && blk < 32) ? 1536 + (blk - 16) : ATT_ITEMS;
}

__global__ void __launch_bounds__(512, 2) fwd_megakernel(Params p) {
    extern __shared__ __attribute__((aligned(16))) unsigned char shm[];
    LAS unsigned char* lds = (LAS unsigned char*)shm;
    const int G = gridDim.x;
    if (threadIdx.x < 4) ((LAS unsigned*)(lds + 131072))[threadIdx.x] = 0u;
    __syncthreads();
    const XcdBarrier xb = xcd_barrier_post((unsigned*)(p.ws + WS_BAR), (volatile LAS unsigned*)(lds + 131072));
    bf16_t* XB = (bf16_t*)(p.ws + WS_XB); bf16_t* OB = (bf16_t*)(p.ws + WS_OB); bf16_t* QB = (bf16_t*)(p.ws + WS_QB); bf16_t* VB = (bf16_t*)(p.ws + WS_VB); bf16_t* GB = (bf16_t*)(p.ws + WS_GB);
    float* ZB = (float*)(p.ws + WS_ZB);
    phase0(p, lds);
    xcd_barrier(xb);
    { pg8::Gemm g{XB, (const bf16_t*)(p.ws + WS_WT0), MPAD, 8192, 2048}; pg8::StaticOrder S; S.init(MPAD, 8192, G, blockIdx.x);
      EpiHgrnIn E{p.ws, (float*)(p.ws + WS_LF), (const float*)(p.ws + WS_LB)};
      pg8::gemm_phase<EpiHgrnIn, pg8::StaticOrder, false>(lds, g, S, E, nullptr);
      const int heavy = (37 * 32) % G; const int li = heavy ? (int)blockIdx.x - heavy : (int)blockIdx.x;
      if (li >= 0) phase0_rest(p, lds, li, heavy ? G - heavy : G); }
    xcd_barrier(xb);
    phase_hgrn(p, lds, xb);
    xcd_barrier(xb);
    { pg8::Gemm g{OB, (const bf16_t*)(p.ws + WS_WTO0), MPAD, 2048, 2048}; OrderOut S; S.init(G, blockIdx.x);
      EpiY E{VB, (float*)(p.ws + WS_LF)};
      pg8::gemm_phase<EpiY, OrderOut, false>(lds, g, S, E, nullptr); }
    xcd_barrier(xb);
    phase_ln<1>(p, 0);
    xcd_barrier(xb);
    { pg8::Gemm g{XB, (const bf16_t*)(p.ws + WS_WT1), MPAD, 4608, 2048}; pg8::StaticOrder S; S.init(MPAD, 4608, G, blockIdx.x);
      EpiSwaIn E{QB, (bf16_t*)(p.ws + WS_K1), (bf16_t*)(p.ws + WS_V1), GB, p.out};
      pg8::gemm_phase<EpiSwaIn, pg8::StaticOrder, false>(lds, g, S, E, nullptr);
      const int heavy = (37 * 18) % G; const int li = heavy ? (int)blockIdx.x - heavy : (int)blockIdx.x;
      if (li >= 0) phase_cache_shift(p, li, heavy ? G - heavy : G); }
    xcd_barrier(xb);
    { AttPre pre; int it = att_item_of(blockIdx.x, 0, G), n1 = att_item_of(blockIdx.x, 1, G);
      if (it < ATT_ITEMS) { attn_load(p, it, pre); attn_stage(lds, it, pre); }
      if (n1 < ATT_ITEMS) attn_load(p, n1, pre);
      for (int r = 0; it < ATT_ITEMS; ++r) { const int n2 = (n1 < ATT_ITEMS) ? att_item_of(blockIdx.x, r + 2, G) : ATT_ITEMS; attn_item(p, lds, it, n1, n2, r & 1, pre); it = n1; n1 = n2; } }
    xcd_barrier(xb);
    { pg8::Gemm g{OB, (const bf16_t*)(p.ws + WS_WTO1), MPAD, 2048, 2048}; OrderOut S; S.init(G, blockIdx.x);
      EpiY E{VB, (float*)(p.ws + WS_LF)};
      pg8::gemm_phase<EpiY, OrderOut, false>(lds, g, S, E, nullptr); }
    xcd_barrier(xb);
    for (int rep = 0; rep < REP_LN; ++rep) phase_ln<2>(p, 1);
}

extern "C" void kernel_launch(void* const* d_in, const int* in_sizes, int n_in, void* d_out, int out_size, void* d_ws, size_t ws_size, hipStream_t stream) {
    static int grid_blocks = 0;
    if (!grid_blocks) {
        int dev = 0, cus = 0, per_cu = 0;
        hipGetDevice(&dev);
        hipDeviceGetAttribute(&cus, hipDeviceAttributeMultiprocessorCount, dev);
        hipFuncSetAttribute((const void*)fwd_megakernel, hipFuncAttributeMaxDynamicSharedMemorySize, LDS_BYTES);
        hipOccupancyMaxActiveBlocksPerMultiprocessor(&per_cu, (const void*)fwd_megakernel, 512, LDS_BYTES);
        if (per_cu < 1) { fprintf(stderr, "kernel_launch: occupancy query reports %d blocks/CU\n", per_cu); per_cu = 1; }
        grid_blocks = cus;
    }
    if (ws_size < WS_END) { fprintf(stderr, "kernel_launch: workspace too small (%zu < %zu)\n", ws_size, (size_t)WS_END); return; }
    Params p{};
    p.x_prompt = (const float*)d_in[0]; p.x_sample = (const float*)d_in[1]; p.state = (const float*)d_in[2]; p.cache_k = (const float*)d_in[3]; p.cache_v = (const float*)d_in[4];
    p.meta = (const float*)d_in[5]; p.w_in0 = (const float*)d_in[6]; p.lb_logits = (const float*)d_in[7]; p.norm_w = (const float*)d_in[8]; p.w_out0 = (const float*)d_in[9];
    p.w_in1 = (const float*)d_in[10]; p.sinks = (const float*)d_in[11]; p.w_out1 = (const float*)d_in[12]; p.ln_g = (const float*)d_in[13]; p.ln_b = (const float*)d_in[14];
    p.out = (float*)d_out; p.ws = (unsigned char*)d_ws;
    if (hipMemsetAsync((char*)d_ws + WS_BAR, 0, 16384, stream) != hipSuccess) { fprintf(stderr, "kernel_launch: memset of the barrier words failed\n"); return; }
    void* args[] = {&p};
    hipError_t e = hipLaunchCooperativeKernel((const void*)fwd_megakernel, dim3(grid_blocks), dim3(512), args, LDS_BYTES, stream);
    if (e != hipSuccess) fprintf(stderr, "cooperative launch failed: %s (grid %d)\n", hipGetErrorString(e), grid_blocks);
}
```

```cpp
#include <hip/hip_runtime.h>
#include <hip/hip_cooperative_groups.h>
#include <cstdio>
#include <cstdint>
namespace pg8 {
#define PG8_LAS __attribute__((address_space(3)))
typedef unsigned short bf16_t;
typedef short bf16x8 __attribute__((ext_vector_type(8)));
typedef float f32x4 __attribute__((ext_vector_type(4)));
typedef unsigned u32x4 __attribute__((ext_vector_type(4)));
constexpr int BM = 256, BK = 64, HALF = 128, HTB = HALF * BK * 2  , STAGE_BYTES = 8 * HTB, NXCD = 8, WGM = 8;

__host__ __device__ __forceinline__ int lds_byte(int r, int c) { const int st = (r >> 4) * 2 + (c >> 5), rr = r & 15, cc = c & 31, ob = rr * 64 + cc * 2; return st * 1024 + (ob ^ (((ob >> 9) & 1) << 5)); }
__host__ __device__ __forceinline__ void stage_rc(int b, int& R, int& C) { const int st = b / 1024, sb = b % 1024, swz = sb ^ (((sb >> 9) & 1) << 5); R = (st >> 1) * 16 + swz / 64; C = (st & 1) * 32 + (swz % 64) / 2; }
__host__ __device__ __forceinline__ int perm32(int rho) { const int n = rho >> 4, i = rho & 15; return 8 * (i >> 2) + 4 * n + (i & 3); }

struct Unit { int pm, pn, kt0, nkt; };
struct Gemm { const bf16_t* A; const bf16_t* Bt; int M, N, K; };

struct StaticOrder {
    int reps = 1;
    int nM, nN, nwg, G, c, nkt, nfull, sk;
    __host__ __device__ void init(int M, int N, int G_, int c_, int K = 2048, int split = 0) { nM = M / BM; nN = N / BM; nwg = nM * nN; G = G_; c = c_; nkt = K / BK; nfull = nwg; sk = 1;
        if (split) { const int R = nwg / G, rem = nwg - R * G; if (rem > 0 && rem * 4 <= G && (nkt % 8) == 0) { nfull = R * G; sk = 4; } } }
    __host__ __device__ bool next(int i, Unit& u) const {
        if (reps > 1) { const int R = (nwg + G - 1) / G; if (i >= R * reps) return false; i = i % R; }
        long L = (long)i * G + c; u.kt0 = 0; u.nkt = nkt;
        if (L >= nfull && sk > 1) { if (L >= nfull + G) return false; const int j = (int)(L - nfull); L = nfull + j / sk; u.nkt = nkt / sk; u.kt0 = (j % sk) * u.nkt; }
        if (L >= nwg) return false;
        int wgid = (int)L; { const int q = nwg / NXCD, r = nwg % NXCD, xcd = wgid % NXCD, off = wgid / NXCD; wgid = (xcd < r ? xcd * (q + 1) : r * (q + 1) + (xcd - r) * q) + off; }
        const int nig = WGM * nN, gid = wgid / nig, fm = gid * WGM, gsz = (nM - fm) < WGM ? (nM - fm) : WGM;
        u.pm = fm + ((wgid % nig) % gsz); u.pn = (wgid % nig) / gsz; return true;
    }
    __device__ __forceinline__ void a_ready(const Unit&) const {}
    __device__ __forceinline__ void done(const Unit&) const {}
};
__device__ __forceinline__ unsigned cvt_pk_bf16(float lo, float hi) { unsigned r; asm volatile("v_cvt_pk_bf16_f32 %0, %1, %2" : "=v"(r) : "v"(lo), "v"(hi)); return r; }
template <class Epi, class Sched, bool STAMP = false>
__device__ __forceinline__ void gemm_phase(PG8_LAS unsigned char* lds, const Gemm g, const Sched& S, const Epi& E, unsigned long long* stamps) {
    int tid_l = threadIdx.x; asm volatile("" : "+v"(tid_l));
    const int tid = tid_l, wid = __builtin_amdgcn_readfirstlane(tid >> 6), lane = tid & 63, wr = wid >> 2, wc = wid & 3, fr = lane & 15, fq = lane >> 4;
    const int K = g.K;
    int ts_lo = 0, ts_hi = 0, nts = 0; const unsigned long long rt_entry = STAMP ? (unsigned long long)wall_clock64() : 0ull;
#define PG8_STAMP() do { if (STAMP && wid == 0 && nts < 64) { const unsigned long long _c = (unsigned long long)clock64(); \
        ts_lo = (lane == nts) ? (int)(unsigned)_c : ts_lo; ts_hi = (lane == nts) ? (int)(unsigned)(_c >> 32) : ts_hi; ++nts; } } while (0)
    PG8_STAMP();
    unsigned voffA[2], voffB[2];
#pragma unroll
    for (int i = 0; i < 2; ++i) { int R, C; stage_rc(tid * 16 + i * 8192, R, C); const int Rb = Epi::PERM ? ((R & ~31) + perm32(R & 31)) : R;
        voffA[i] = (unsigned)(R * K + C) * 2u; voffB[i] = (unsigned)(Rb * K + C) * 2u; }
    const size_t kstep = (size_t)(BK * 2);
    const size_t hstep = (size_t)HALF * K * 2;
    const size_t tstep = 2 * hstep;
    const unsigned ldsw = (unsigned)wid * 1024u;
    const int aoff = lds_byte(wr * 64 + fr, fq * 8), boff = lds_byte(wc * 32 + fr, fq * 8);
#define PG8_SA(b, h) (((b) * 2 + (h)) * HTB)
#define PG8_SB(b, h) ((4 + (b) * 2 + (h)) * HTB)
#define PG8_STAGE(bufoff, gbase, voff) do { _Pragma("unroll") for (int _i = 0; _i < 2; ++_i) \
        __builtin_amdgcn_global_load_lds((const unsigned*)((const char*)(gbase) + (voff)[_i]), (PG8_LAS unsigned*)(lds + (bufoff) + ldsw + _i * 8192), 16, 0, 0); } while (0)
#define PG8_LDA(dst, b, h) do { _Pragma("unroll") for (int m = 0; m < 4; ++m) _Pragma("unroll") for (int k = 0; k < 2; ++k) dst[m][k] = *(const PG8_LAS bf16x8*)(lds + PG8_SA(b, h) + aoff + m * 2048 + k * 1024); } while (0)
#define PG8_LDB(dst, b, h) do { _Pragma("unroll") for (int n = 0; n < 2; ++n) _Pragma("unroll") for (int k = 0; k < 2; ++k) dst[n][k] = *(const PG8_LAS bf16x8*)(lds + PG8_SB(b, h) + boff + n * 2048 + k * 1024); } while (0)
#define PG8_MMA(ai, bj, At, Bt) do { __builtin_amdgcn_s_setprio(1); _Pragma("unroll") for (int m = 0; m < 4; ++m) _Pragma("unroll") for (int n = 0; n < 2; ++n) _Pragma("unroll") for (int k = 0; k < 2; ++k) \
        acc[ai][bj][m][n] = __builtin_amdgcn_mfma_f32_16x16x32_bf16(Bt[n][k], At[m][k], acc[ai][bj][m][n], 0, 0, 0); __builtin_amdgcn_s_setprio(0); } while (0)
#define PG8_WAIT_V(n) asm volatile("s_waitcnt vmcnt(" #n ")" ::: "memory")
#define PG8_WAIT_L(n) asm volatile("s_waitcnt lgkmcnt(" #n ")" ::: "memory")
#define PG8_BAR __builtin_amdgcn_s_barrier()
#define PG8_SCHED __builtin_amdgcn_sched_barrier(0)
    Unit cur, nxt; int ui = 0;
    if (!S.next(0, cur)) return;
    f32x4 acc[2][2][4][2];
#pragma unroll
    for (int a = 0; a < 2; ++a)
#pragma unroll
        for (int b = 0; b < 2; ++b)
#pragma unroll
            for (int m = 0; m < 4; ++m)
#pragma unroll
                for (int n = 0; n < 2; ++n) acc[a][b][m][n] = (f32x4){0.f, 0.f, 0.f, 0.f};
    bf16x8 At[4][2], B0[2][2], B1[2][2];
    const char* cA = (const char*)g.A + (size_t)cur.pm * tstep + (size_t)cur.kt0 * kstep; const char* cB = (const char*)g.Bt + (size_t)cur.pn * tstep + (size_t)cur.kt0 * kstep;
    int nt = cur.nkt;
    S.a_ready(cur);
    PG8_STAGE(PG8_SB(0, 0), cB, voffB); PG8_STAGE(PG8_SB(0, 1), cB + hstep, voffB); PG8_STAGE(PG8_SA(0, 0), cA, voffA); PG8_STAGE(PG8_SA(0, 1), cA + hstep, voffA);
    if (wr == 1) PG8_BAR;
    PG8_WAIT_V(2); PG8_BAR;
    PG8_STAGE(PG8_SB(1, 0), cB + kstep, voffB); PG8_STAGE(PG8_SA(1, 0), cA + kstep, voffA); PG8_STAGE(PG8_SB(1, 1), cB + hstep + kstep, voffB);
    PG8_WAIT_V(6); PG8_BAR;
    PG8_STAMP();
    for (;;) {
        const bool has_next = S.next(ui + 1, nxt);
        const char* nA = has_next ? (const char*)g.A + (size_t)nxt.pm * tstep + (size_t)nxt.kt0 * kstep : cA; const char* nB = has_next ? (const char*)g.Bt + (size_t)nxt.pn * tstep + (size_t)nxt.kt0 * kstep : cB;
        for (int t = 0; t < nt; t += 2) {
            const bool last = (t == nt - 2);
            const char* a1 = cA + (size_t)(t + 1) * kstep;
            const char* a2 = last ? nA : cA + (size_t)(t + 2) * kstep; const char* b2 = last ? nB : cB + (size_t)(t + 2) * kstep;
            const char* a3 = a2 + kstep; const char* b3 = b2 + kstep;
            if (last && has_next) S.a_ready(nxt);
            PG8_LDB(B0, 0, 0); PG8_LDB(B1, 0, 1); PG8_SCHED; PG8_LDA(At, 0, 0); PG8_STAGE(PG8_SA(1, 1), a1 + hstep, voffA);
            PG8_WAIT_V(8); PG8_WAIT_L(0); PG8_BAR; PG8_MMA(0, 0, At, B0); PG8_MMA(0, 1, At, B1); PG8_BAR; PG8_SCHED;
            PG8_LDA(At, 0, 1); PG8_STAGE(PG8_SB(0, 0), b2, voffB); PG8_STAGE(PG8_SB(0, 1), b2 + hstep, voffB); PG8_STAGE(PG8_SA(0, 0), a2, voffA);
            PG8_WAIT_V(8); PG8_WAIT_L(0); PG8_BAR; PG8_MMA(1, 0, At, B0); PG8_MMA(1, 1, At, B1); PG8_BAR; PG8_SCHED;
            PG8_LDB(B0, 1, 0); PG8_LDB(B1, 1, 1); PG8_SCHED; PG8_LDA(At, 1, 0); PG8_STAGE(PG8_SA(0, 1), a2 + hstep, voffA);
            PG8_WAIT_V(8); PG8_WAIT_L(0); PG8_BAR; PG8_MMA(0, 0, At, B0); PG8_MMA(0, 1, At, B1); PG8_BAR; PG8_SCHED;
            PG8_LDA(At, 1, 1); PG8_STAGE(PG8_SB(1, 0), b3, voffB); PG8_STAGE(PG8_SB(1, 1), b3 + hstep, voffB); PG8_STAGE(PG8_SA(1, 0), a3, voffA);
            PG8_WAIT_V(8); PG8_WAIT_L(0); PG8_BAR; PG8_MMA(1, 0, At, B0); PG8_MMA(1, 1, At, B1); PG8_BAR; PG8_SCHED;
        }
        PG8_STAMP();
        if (wr == 0) PG8_BAR;
        if constexpr (!Epi::AFTER_DRAIN) { E(acc, cur, wr, wc, fr, fq); S.done(cur); }
        PG8_STAMP();
        if (!has_next) break;
#pragma unroll
        for (int a = 0; a < 2; ++a)
#pragma unroll
            for (int b = 0; b < 2; ++b)
#pragma unroll
                for (int m = 0; m < 4; ++m)
#pragma unroll
                    for (int n = 0; n < 2; ++n) acc[a][b][m][n] = (f32x4){0.f, 0.f, 0.f, 0.f};
        cur = nxt; cA = nA; cB = nB; ++ui; nt = cur.nkt;
        if (wr == 1) PG8_BAR;
    }
    PG8_WAIT_V(0);
    PG8_BAR;
    if constexpr (Epi::AFTER_DRAIN) { E.fused(acc, cur, wr, wc, fr, fq, lds, wid, lane); S.done(cur); }
    PG8_STAMP();
    if (STAMP && wid == 0) { stamps[lane] = lane < nts ? (((unsigned long long)(unsigned)ts_hi << 32) | (unsigned)ts_lo) : 0ull;
        if (lane == 62) stamps[62] = rt_entry; if (lane == 63) stamps[63] = (unsigned long long)wall_clock64(); }
#undef PG8_STAMP
#undef PG8_SA
#undef PG8_SB
#undef PG8_STAGE
#undef PG8_LDA
#undef PG8_LDB
#undef PG8_MMA
#undef PG8_WAIT_V
#undef PG8_WAIT_L
#undef PG8_BAR
#undef PG8_SCHED
}
}
#define LAS __attribute__((address_space(3)))
#include <vector>

#define XB_TMO      128
#define XB_XCNT(j)  (256  + 64 * (j))
#define XB_XSUB(j)  (1280 + 64 * (j))
#define XB_XGEN(j)  (2304 + 64 * (j))
#define XB_TOP      3328
#define XB_TOPGEN   3392
#define XCD_BAR_WORDS 3456
#define XB_SPIN_CAP (1u << 18)

__device__ __forceinline__ unsigned xb_ld(unsigned* p)              { return __hip_atomic_load(p, __ATOMIC_RELAXED, __HIP_MEMORY_SCOPE_AGENT); }
__device__ __forceinline__ unsigned xb_add(unsigned* p, unsigned v) { return __hip_atomic_fetch_add(p, v, __ATOMIC_RELAXED, __HIP_MEMORY_SCOPE_AGENT); }
__device__ __forceinline__ unsigned xb_xcc_id() { return (unsigned)__builtin_amdgcn_s_getreg((3 << 11) | 20) & 0xFu; }
#define XB_SPIN(cond, bar) do { unsigned _sp = 0; while (cond) { __builtin_amdgcn_s_sleep(1); \
    if ((++_sp & 255u) == 0u) { if (xb_ld(&(bar)[XB_TMO])) break; if (_sp > XB_SPIN_CAP) { atomicAdd(&(bar)[XB_TMO], 1u); break; } } } } while (0)

struct XcdBarrier {
    unsigned* bar; unsigned x;
    volatile LAS unsigned* st;
};

__device__ __forceinline__ XcdBarrier xcd_barrier_post(unsigned* bar, volatile LAS unsigned* st) {
    XcdBarrier b; b.bar = bar; b.x = xb_xcc_id(); b.st = st;
    if (threadIdx.x == 0) (void)xb_add(&bar[XB_XCNT(b.x)], 1u);
    return b;
}
__device__ __forceinline__ void xcd_barrier_complete(unsigned* bar, unsigned x, unsigned& nloc, unsigned& nx) {
    const unsigned G = gridDim.x * gridDim.y * gridDim.z;
    unsigned sum, cnt, mine, sp = 0u;
    for (;;) {
        sum = 0u; cnt = 0u; mine = 0u;
#pragma unroll
        for (unsigned j = 0; j < 16; ++j) { const unsigned c = xb_ld(&bar[XB_XCNT(j)]); sum += c; cnt += (c > 0u) ? 1u : 0u; mine = (j == x) ? c : mine; }
        if (sum == G) break;
        __builtin_amdgcn_s_sleep(1);
        if ((++sp & 255u) == 0u) { if (xb_ld(&bar[XB_TMO])) break; if (sp > XB_SPIN_CAP) { atomicAdd(&bar[XB_TMO], 1u); break; } }
    }
    nloc = mine > 0u ? mine : 1u; nx = cnt > 0u ? cnt : 1u;
}

__device__ __forceinline__ void xcd_barrier(const XcdBarrier& b) {
    asm volatile("s_waitcnt vmcnt(0)" ::: "memory");
    __syncthreads();
    if (threadIdx.x == 0) {
        unsigned* bar = b.bar;
        __builtin_amdgcn_s_waitcnt(0);
        unsigned nloc = b.st[0], nx = b.st[1];
        if (nloc == 0u) { xcd_barrier_complete(bar, b.x, nloc, nx); b.st[0] = nloc; b.st[1] = nx; }
        const unsigned old = xb_add(&bar[XB_XSUB(b.x)], 1u);
        const unsigned gen = old / nloc;
        if (old + 1u == (gen + 1u) * nloc) {
            __builtin_amdgcn_fence(__ATOMIC_RELEASE, "agent");
            asm volatile("s_waitcnt vmcnt(0)" ::: "memory");
            const unsigned og = xb_add(&bar[XB_TOP], 1u);
            const unsigned tg = og / nx;
            if (og + 1u == (tg + 1u) * nx) xb_add(&bar[XB_TOPGEN], 1u);
            else XB_SPIN(xb_ld(&bar[XB_TOPGEN]) == tg, bar);
            __builtin_amdgcn_fence(__ATOMIC_ACQUIRE, "agent");
            xb_add(&bar[XB_XGEN(b.x)], 1u);
            asm volatile("s_waitcnt vmcnt(0)" ::: "memory");
        } else {
            XB_SPIN(xb_ld(&bar[XB_XGEN(b.x)]) == gen, bar);
            __builtin_amdgcn_fence(__ATOMIC_ACQUIRE, "agent");
            asm volatile("s_waitcnt vmcnt(0)" ::: "memory");
        }
    }
    __syncthreads();
}
namespace cg = cooperative_groups;
using pg8::bf16_t; using pg8::bf16x8; using pg8::f32x4; using pg8::u32x4;

typedef unsigned u32x2 __attribute__((ext_vector_type(2)));
typedef float f32x2v __attribute__((ext_vector_type(2)));

constexpr int D = 2048, TP = 2064, NBP = 4, MPR = NBP * TP, NBS = 128, TSM = 8, MSM = NBS * TSM, MTOT = MPR + MSM, MPAD = 9472;
constexpr float ALPHA = 1.41421356237309515f;
#ifndef REP_P0
#define REP_P0 1
#endif
#ifndef REP_HGRN
#define REP_HGRN 1
#endif
#ifndef REP_ATT
#define REP_ATT 1
#endif
#ifndef REP_LN
#define REP_LN 1
#endif
#ifndef REP_G1
#define REP_G1 1
#endif
#ifndef REP_G2
#define REP_G2 1
#endif
constexpr float LN_EPS = 1e-5f, RMS_EPS = 1e-6f;
constexpr int LDS_BYTES = 131072 + 64;
constexpr size_t OUT_YP = 0, OUT_YS = 16777216, OUT_SP = 18874368, OUT_SS = 19922944, OUT_KP = 53477376, OUT_VP = 53608448, OUT_KS = 53739520, OUT_VS = 57933824;
constexpr size_t SZ_BF = (size_t)MPAD * D * 2, SZ_F32 = (size_t)MPAD * D * 4;
constexpr size_t WS_WT0 = 0, WS_WTO0 = WS_WT0 + 33554432, WS_WT1 = WS_WTO0 + 8388608, WS_WTO1 = WS_WT1 + 18874368, WS_XB = WS_WTO1 + 8388608,
                 WS_QB = WS_XB + SZ_BF, WS_VB = WS_QB + SZ_BF, WS_GB = WS_VB + SZ_BF, WS_OB = WS_GB + SZ_BF, WS_LF = WS_OB + SZ_BF, WS_ZB = WS_LF + SZ_F32,
                 WS_K1 = WS_ZB + SZ_F32, WS_V1 = WS_K1 + 4849664, WS_LB = WS_V1 + 4849664, WS_BAR = WS_LB + 8192, WS_HU = WS_BAR + 16384, WS_HD = WS_HU + 256 * 65536, WS_END = WS_HD + 256 * 512;

struct Params {
    const float *x_prompt, *x_sample, *state, *cache_k, *cache_v, *meta, *w_in0, *lb_logits, *norm_w, *w_out0, *w_in1, *sinks, *w_out1, *ln_g, *ln_b;
    float* out; unsigned char* ws;
};

__device__ __forceinline__ float bf2f(unsigned short b) { return __uint_as_float(((unsigned)b) << 16); }
__device__ __forceinline__ unsigned short f2bf(float f) { unsigned u = __float_as_uint(f); u += 0x7FFFu + ((u >> 16) & 1u); return (unsigned short)(u >> 16); }
__device__ __forceinline__ unsigned pk2(float lo, float hi) { return pg8::cvt_pk_bf16(lo, hi); }
__device__ __forceinline__ float sigmoidf_(float x) { return __builtin_amdgcn_rcpf(1.0f + __builtin_amdgcn_exp2f(x * -1.44269504089f)); }
__device__ __forceinline__ float siluf_(float x) { return x * __builtin_amdgcn_rcpf(1.0f + __builtin_amdgcn_exp2f(x * -1.44269504089f)); }
#define LDS_WAIT() asm volatile("s_waitcnt lgkmcnt(0)" ::: "memory")

__device__ __forceinline__ const float* xrow_ptr(const Params& p, int row) {
    if (row < MPR) { const int b = row / TP, t = row - b * TP; return t < 16 ? p.meta + (size_t)t * D : p.x_prompt + ((size_t)b * 2048 + (t - 16)) * D; }
    return p.x_sample + (size_t)(row - MPR) * D;
}

__device__ __forceinline__ void p0_transpose_item(const float* __restrict__ W, int K, int N, bf16_t* __restrict__ WT, LAS float* scr, int item, int lane) {
    const int nblk = N / 32, kb = item / nblk, nb = item % nblk, k0 = 64 * kb, n0 = 32 * nb;
    f32x4 wv[8];
#pragma unroll
    for (int i = 0; i < 8; ++i) wv[i] = __builtin_nontemporal_load((const f32x4*)(W + (size_t)(k0 + 8 * i + (lane >> 3)) * N + n0 + 4 * (lane & 7)));
#pragma unroll
    for (int i = 0; i < 8; ++i) { LAS float* d_ = scr + (8 * i + (lane >> 3)) * 33 + 4 * (lane & 7); d_[0] = wv[i].x; d_[1] = wv[i].y; d_[2] = wv[i].z; d_[3] = wv[i].w; }
    LDS_WAIT();
    const int c = lane & 7;
#pragma unroll
    for (int j = 0; j < 4; ++j) { const int n = (lane >> 3) + 8 * j; const LAS float* s = scr + (8 * c) * 33 + n;
        u32x4 o; o.x = pk2(s[0 * 33], s[1 * 33]); o.y = pk2(s[2 * 33], s[3 * 33]); o.z = pk2(s[4 * 33], s[5 * 33]); o.w = pk2(s[6 * 33], s[7 * 33]);
        *(u32x4*)(WT + (size_t)(n0 + n) * K + k0 + 8 * c) = o; }
    LDS_WAIT();
}

__device__ __forceinline__ void phase0(const Params& p, LAS unsigned char* lds) {
    int tid_l = threadIdx.x; asm volatile("" : "+v"(tid_l)); const int tid = tid_l, wave = tid >> 6, lane = tid & 63;
    const int NGW = gridDim.x * 8, gw = wave * gridDim.x + blockIdx.x;
    LAS float* scr = (LAS float*)(lds + wave * 8448);
    constexpr int I0 = 32 * 256;
    bf16_t* WT0 = (bf16_t*)(p.ws + WS_WT0);
    for (int it = gw; it < I0; it += NGW) p0_transpose_item(p.w_in0, 2048, 8192, WT0, scr, it, lane);
    bf16_t* XB = (bf16_t*)(p.ws + WS_XB);
    for (int m = gw; m < MTOT; m += NGW) {
        const f32x4* src = (const f32x4*)xrow_ptr(p, m) + lane; u32x2* dst = (u32x2*)(XB + (size_t)m * D) + lane;
#pragma unroll
        for (int j = 0; j < 8; ++j) { const f32x4 v = __builtin_nontemporal_load(src + 64 * j); u32x2 o; o.x = pk2(v.x, v.y); o.y = pk2(v.z, v.w); dst[64 * j] = o; }
    }
    const int gt = blockIdx.x * 512 + tid, NGT = gridDim.x * 512;
    float* LB = (float*)(p.ws + WS_LB);
    for (int c = gt; c < D; c += NGT) { const float a = p.lb_logits[c], b = p.lb_logits[D + c], cc = p.lb_logits[2 * D + c]; const float m = fmaxf(a, fmaxf(b, cc));
        const float ea = __expf(a - m), eb = __expf(b - m), ec = __expf(cc - m); LB[c] = ea / (ea + eb + ec); }
}
__device__ __forceinline__ void phase0_rest(const Params& p, LAS unsigned char* lds, int li, int nl) {
    int tid_l = threadIdx.x; asm volatile("" : "+v"(tid_l)); const int tid = tid_l, wave = tid >> 6, lane = tid & 63;
    const int gw = li * 8 + wave, NGW = nl * 8;
    LAS float* scr = (LAS float*)(lds + wave * 8448);
    constexpr int I1 = 32 * 64, I2 = 32 * 144, I3 = 32 * 64;
    bf16_t* WTO0 = (bf16_t*)(p.ws + WS_WTO0); bf16_t* WT1 = (bf16_t*)(p.ws + WS_WT1); bf16_t* WTO1 = (bf16_t*)(p.ws + WS_WTO1);
    for (int it = gw; it < I1 + I2 + I3; it += NGW) {
        int r = it;
        if (r < I1) { p0_transpose_item(p.w_out0, 2048, 2048, WTO0, scr, r, lane); continue; } r -= I1;
        if (r < I2) { p0_transpose_item(p.w_in1, 2048, 4608, WT1, scr, r, lane); continue; } r -= I2;
        p0_transpose_item(p.w_out1, 2048, 2048, WTO1, scr, r, lane);
    }
}
__device__ __forceinline__ void phase_cache_shift(const Params& p, int li, int nl) {
    const int gt = li * 512 + threadIdx.x, NGT = nl * 512;
    const f32x4* ck = (const f32x4*)p.cache_k; const f32x4* cv = (const f32x4*)p.cache_v; f32x4* ok = (f32x4*)(p.out + OUT_KS); f32x4* ov = (f32x4*)(p.out + OUT_VS);
    constexpr int PER_B = 120 * 64;
    for (int i0 = gt; i0 < NBS * PER_B; i0 += 4 * NGT) { f32x4 a[4], c[4]; size_t o[4]; bool ok_[4];
#pragma unroll
        for (int u = 0; u < 4; ++u) { const int i = i0 + u * NGT; ok_[u] = i < NBS * PER_B; const int ii = ok_[u] ? i : 0; const int b = ii / PER_B, r = ii - b * PER_B; o[u] = (size_t)b * 8192 + r;
            a[u] = __builtin_nontemporal_load(ck + o[u] + 512); c[u] = __builtin_nontemporal_load(cv + o[u] + 512); }
#pragma unroll
        for (int u = 0; u < 4; ++u) if (ok_[u]) { __builtin_nontemporal_store(a[u], ok + o[u]); __builtin_nontemporal_store(c[u], ov + o[u]); } }
}

struct EpiHgrnIn {
    static constexpr bool PERM = true, AFTER_DRAIN = false;
    unsigned char* ws; float* LF; const float* LB;
    __device__ __forceinline__ void operator()(const f32x4 (&acc)[2][2][4][2], const pg8::Unit& u, int wr, int wc, int fr, int fq) const {
        const int sec = u.pn >> 3, colt = (u.pn & 7) * 256;
        const size_t secoff = sec == 0 ? WS_QB : (sec == 2 ? WS_VB : WS_GB);
        bf16_t* dst = (bf16_t*)(ws + secoff);
        const int row0 = u.pm * 256 + wr * 64 + fr, col0 = colt + wc * 32 + 8 * fq;
        float lb[2][8];
        if (sec == 1) {
#pragma unroll
            for (int bj = 0; bj < 2; ++bj) { const f32x4 a = *(const f32x4*)(LB + col0 + bj * 128), b = *(const f32x4*)(LB + col0 + bj * 128 + 4);
                lb[bj][0] = a.x; lb[bj][1] = a.y; lb[bj][2] = a.z; lb[bj][3] = a.w; lb[bj][4] = b.x; lb[bj][5] = b.y; lb[bj][6] = b.z; lb[bj][7] = b.w; }
        }
#pragma unroll
        for (int ai = 0; ai < 2; ++ai)
#pragma unroll
            for (int m = 0; m < 4; ++m) {
                const int row = row0 + ai * 128 + m * 16; if (row >= MTOT) continue;
#pragma unroll
                for (int bj = 0; bj < 2; ++bj) {
                    const size_t off = (size_t)row * D + col0 + bj * 128;
                    const f32x4 v0 = acc[ai][bj][m][0], v1 = acc[ai][bj][m][1];
                    float x[8] = {v0.x, v0.y, v0.z, v0.w, v1.x, v1.y, v1.z, v1.w};
                    if (sec == 1) {
#pragma unroll
                        for (int j = 0; j < 8; ++j) { const float l = lb[bj][j]; x[j] = l + (1.0f - l) * sigmoidf_(x[j]); }
                        *(f32x4*)(LF + off) = (f32x4){x[0], x[1], x[2], x[3]}; *(f32x4*)(LF + off + 4) = (f32x4){x[4], x[5], x[6], x[7]};
                    } else {
                        if (sec == 3) {
#pragma unroll
                            for (int j = 0; j < 8; ++j) x[j] = siluf_(x[j]);
                        }
                        u32x4 w; w.x = pk2(x[0], x[1]); w.y = pk2(x[2], x[3]); w.z = pk2(x[4], x[5]); w.w = pk2(x[6], x[7]);
                        *(u32x4*)(dst + off) = w;
                    }
                }
            }
    }
};
struct EpiSwaIn {
    static constexpr bool PERM = true, AFTER_DRAIN = false;
    bf16_t* Q; bf16_t* K1; bf16_t* V1; bf16_t* G; float* out;
    __device__ __forceinline__ void operator()(const f32x4 (&acc)[2][2][4][2], const pg8::Unit& u, int wr, int wc, int fr, int fq) const {
        const int pn = u.pn;
        const int row0 = u.pm * 256 + wr * 64 + fr, cw = wc * 32 + 8 * fq;
#pragma unroll
        for (int ai = 0; ai < 2; ++ai)
#pragma unroll
            for (int m = 0; m < 4; ++m) {
                const int row = row0 + ai * 128 + m * 16; if (row >= MTOT) continue;
#pragma unroll
                for (int bj = 0; bj < 2; ++bj) {
                    const f32x4 v0 = acc[ai][bj][m][0], v1 = acc[ai][bj][m][1];
                    float x[8] = {v0.x, v0.y, v0.z, v0.w, v1.x, v1.y, v1.z, v1.w};
                    const int c = cw + bj * 128;
                    if (pn < 8) {
                        constexpr float QS = 0.125f * 1.44269504089f;
                        u32x4 w; w.x = pk2(x[0] * QS, x[1] * QS); w.y = pk2(x[2] * QS, x[3] * QS); w.z = pk2(x[4] * QS, x[5] * QS); w.w = pk2(x[6] * QS, x[7] * QS);
                        *(u32x4*)(Q + (size_t)row * D + pn * 256 + c) = w;
                    } else if (pn >= 10) {
#pragma unroll
                        for (int j = 0; j < 8; ++j) x[j] = siluf_(x[j]);
                        u32x4 w; w.x = pk2(x[0], x[1]); w.y = pk2(x[2], x[3]); w.z = pk2(x[4], x[5]); w.w = pk2(x[6], x[7]);
                        *(u32x4*)(G + (size_t)row * D + (pn - 10) * 256 + c) = w;
                    } else {
                        u32x4 w; w.x = pk2(x[0], x[1]); w.y = pk2(x[2], x[3]); w.z = pk2(x[4], x[5]); w.w = pk2(x[6], x[7]);
                        bf16_t* dst = pn == 8 ? K1 : V1;
                        *(u32x4*)(dst + (size_t)row * 256 + c) = w;
                        float* co = nullptr;
                        if (row < MPR) { const int b = row / TP, t = row - b * TP; if (t >= TP - 128) co = out + (pn == 8 ? OUT_KP : OUT_VP) + ((size_t)b * 128 + (t - (TP - 128))) * 256 + c; }
                        else { const int r = row - MPR, b = r >> 3, t = r & 7; co = out + (pn == 8 ? OUT_KS : OUT_VS) + ((size_t)b * 128 + 120 + t) * 256 + c; }
                        if (co) { __builtin_nontemporal_store(v0, (f32x4*)co); __builtin_nontemporal_store(v1, (f32x4*)(co + 4)); }
                    }
                }
            }
    }
};
constexpr int SPLIT_ROW0 = 8192, SLAB_ROWS = MTOT - 8192;
struct OrderOut {
    pg8::StaticOrder S32; int G, c;
    __device__ void init(int G_, int c_) { S32.init(SPLIT_ROW0, 2048, G_, c_, 2048, 0); G = G_; c = c_; }
    __device__ bool next(int i, pg8::Unit& u) const {
        if (S32.next(i, u)) return true;
        const int R = (256 + G - 1) / G; if (i < R) return false;
        const long j = (long)(i - R) * G + c; if (j >= 160) return false;
        const int un = (int)(j >> 2); u.pm = 32 + (un >> 3); u.pn = un & 7; u.nkt = 8; u.kt0 = 8 * (int)(j & 3); return true;
    }
    __device__ __forceinline__ void a_ready(const pg8::Unit&) const {}
    __device__ __forceinline__ void done(const pg8::Unit&) const {}
};
struct EpiY {
    static constexpr bool PERM = true, AFTER_DRAIN = false;
    bf16_t* Y; float* slab;
    __device__ __forceinline__ void operator()(const f32x4 (&acc)[2][2][4][2], const pg8::Unit& u, int wr, int wc, int fr, int fq) const {
        const int row0 = u.pm * 256 + wr * 64 + fr, col0 = u.pn * 256 + wc * 32 + 8 * fq;
        const bool whole = u.nkt == 32;
        float* sbase = slab + ((size_t)(u.kt0 >> 3) * SLAB_ROWS - SPLIT_ROW0) * D;
#pragma unroll
        for (int ai = 0; ai < 2; ++ai)
#pragma unroll
            for (int m = 0; m < 4; ++m) {
                const int row = row0 + ai * 128 + m * 16; if (row >= MTOT) continue;
#pragma unroll
                for (int bj = 0; bj < 2; ++bj) { const f32x4 v0 = acc[ai][bj][m][0], v1 = acc[ai][bj][m][1]; const size_t off = (size_t)row * D + col0 + bj * 128;
                    if (whole) { u32x4 w; w.x = pk2(v0.x, v0.y); w.y = pk2(v0.z, v0.w); w.z = pk2(v1.x, v1.y); w.w = pk2(v1.z, v1.w); *(u32x4*)(Y + off) = w; }
                    else { *(f32x4*)(sbase + off) = v0; *(f32x4*)(sbase + off + 4) = v1; } }
            }
    }
};

template <int MODE> __device__ __forceinline__ void phase_ln(const Params& p, int layer) {
    int tid_l = threadIdx.x; asm volatile("" : "+v"(tid_l)); const int tid = tid_l, wave = tid >> 6, lane = tid & 63;
    const int NGW = gridDim.x * 8, gw = wave * gridDim.x + blockIdx.x;
    float* ZB = (float*)(p.ws + WS_ZB); bf16_t* XB = (bf16_t*)(p.ws + WS_XB); const bf16_t* YB = (const bf16_t*)(p.ws + WS_VB); const float* SL = (const float*)(p.ws + WS_LF);
    const f32x4* gp = (const f32x4*)(p.ln_g + (size_t)layer * D) + lane; const f32x4* bp = (const f32x4*)(p.ln_b + (size_t)layer * D) + lane;
    f32x4 nv[8]; u32x2 ny[8];
#define LN_LOAD(m_) do { const u32x2* y_ = (const u32x2*)(YB + (size_t)(m_) * D) + lane; \
        if (MODE == 1) { const f32x4* x_ = (const f32x4*)xrow_ptr(p, (m_)) + lane; _Pragma("unroll") for (int j = 0; j < 8; ++j) nv[j] = __builtin_nontemporal_load(x_ + 64 * j); } \
        else { const u32x2* x_ = (const u32x2*)(XB + (size_t)(m_) * D) + lane; _Pragma("unroll") for (int j = 0; j < 8; ++j) { const u32x2 w_ = x_[64 * j]; nv[j] = (f32x4){bf2f((unsigned short)(w_.x & 0xffffu)), bf2f((unsigned short)(w_.x >> 16)), bf2f((unsigned short)(w_.y & 0xffffu)), bf2f((unsigned short)(w_.y >> 16))}; } } \
        if ((m_) < SPLIT_ROW0) { _Pragma("unroll") for (int j = 0; j < 8; ++j) ny[j] = __builtin_nontemporal_load(y_ + 64 * j); } } while (0)
    if (gw < MTOT) LN_LOAD(gw);
    for (int m = gw; m < MTOT; m += NGW) {
        f32x4 v[8]; float s = 0.f;
        if (m < SPLIT_ROW0) {
#pragma unroll
            for (int j = 0; j < 8; ++j) { const f32x4 y = (f32x4){bf2f((unsigned short)(ny[j].x & 0xffffu)), bf2f((unsigned short)(ny[j].x >> 16)), bf2f((unsigned short)(ny[j].y & 0xffffu)), bf2f((unsigned short)(ny[j].y >> 16))}; v[j] = nv[j] * ALPHA + y; }
        } else {
#pragma unroll
            for (int j = 0; j < 8; ++j) v[j] = nv[j] * ALPHA;
            const f32x4* sl = (const f32x4*)(SL + (size_t)(m - SPLIT_ROW0) * D) + lane;
#pragma unroll
            for (int pc = 0; pc < 4; ++pc)
#pragma unroll
                for (int j = 0; j < 8; ++j) v[j] = v[j] + __builtin_nontemporal_load(sl + (size_t)pc * SLAB_ROWS * (D / 4) + 64 * j);
        }
        if (m + NGW < MTOT) LN_LOAD(m + NGW);
#pragma unroll
        for (int j = 0; j < 8; ++j) s += (v[j].x + v[j].y) + (v[j].z + v[j].w);
#pragma unroll
        for (int o = 1; o < 64; o <<= 1) s += __shfl_xor(s, o);
        const float mean = s * (1.0f / D); float s2 = 0.f;
#pragma unroll
        for (int j = 0; j < 8; ++j) { v[j] = v[j] - mean; s2 += (v[j].x * v[j].x + v[j].y * v[j].y) + (v[j].z * v[j].z + v[j].w * v[j].w); }
#pragma unroll
        for (int o = 1; o < 64; o <<= 1) s2 += __shfl_xor(s2, o);
        const float rstd = rsqrtf(s2 * (1.0f / D) + LN_EPS);
        if (MODE == 1) {
            u32x2* xb = (u32x2*)(XB + (size_t)m * D) + lane;
#pragma unroll
            for (int j = 0; j < 8; ++j) { const f32x4 y = v[j] * rstd * gp[64 * j] + bp[64 * j]; u32x2 o; o.x = pk2(y.x, y.y); o.y = pk2(y.z, y.w); xb[64 * j] = o; }
        } else {
            float* dst = nullptr;
            if (m < MPR) { const int b = m / TP, t = m - b * TP; if (t >= 16) dst = p.out + OUT_YP + ((size_t)b * 2048 + (t - 16)) * D; }
            else dst = p.out + OUT_YS + (size_t)(m - MPR) * D;
            if (dst) { f32x4* d4 = (f32x4*)dst + lane;
#pragma unroll
                for (int j = 0; j < 8; ++j) __builtin_nontemporal_store(v[j] * rstd * gp[64 * j] + bp[64 * j], d4 + 64 * j); }
        }
    }
#undef LN_LOAD
}

constexpr int H_QT = 0, H_KT = 17408, H_KTT = 34816, H_VT = 53248, H_AM = 71680, H_S0T = 80896, H_DEC = 115712, H_SEG = 116224;
#define MFMA16(a, b, c) __builtin_amdgcn_mfma_f32_16x16x32_bf16((a), (b), (c), 0, 0, 0)

__device__ __forceinline__ void hgrn_chain(const Params& p, LAS unsigned char* lds, int item, int pass) {
    const int ci = item >> 2, sg = item & 3;
    const int c_begin = sg == 0 ? 0 : 1 + 8 * sg, c_end = 9 + 8 * sg;
    const bool full = pass != 0;
    if (!full && sg == 3) return;
    int tid_l = threadIdx.x; asm volatile("" : "+v"(tid_l)); const int tid = tid_l, w = tid >> 6, lane = tid & 63, r16 = lane & 15, quad = lane >> 4;
    const int kcol = tid & 127, seg = tid >> 7;
    const int b = ci >> 4, h = ci & 15;
    const bf16_t* QB = (const bf16_t*)(p.ws + WS_QB); const float* LF = (const float*)(p.ws + WS_LF); const bf16_t* VB = (const bf16_t*)(p.ws + WS_VB);
    const bf16_t* GB = (const bf16_t*)(p.ws + WS_GB); bf16_t* OB = (bf16_t*)(p.ws + WS_OB);
    const int colbase = h * 128;
    const int tt = w >> 1, vh = w & 1;
    f32x4 S[8];
#pragma unroll
    for (int i = 0; i < 8; ++i) S[i] = (f32x4){0.f, 0.f, 0.f, 0.f};
    f32x4 dprod = (f32x4){1.f, 1.f, 1.f, 1.f};
    float* HU = (float*)(p.ws + WS_HU); float* HD = (float*)(p.ws + WS_HD);
    if (full) {
        for (int j = 0; j < sg; ++j) { const float* U = HU + (size_t)(ci * 4 + j) * 16384; const f32x4 dj = *(const f32x4*)(HD + (ci * 4 + j) * 128 + 16 * w + 4 * quad);
#pragma unroll
            for (int vt = 0; vt < 8; ++vt)
#pragma unroll
                for (int r = 0; r < 4; ++r) S[vt][r] = dj[r] * S[vt][r] + U[(16 * w + 4 * quad + r) * 128 + 16 * vt + r16]; }
#pragma unroll
        for (int vt = 0; vt < 8; ++vt) *(LAS u32x2*)(lds + H_S0T + (16 * vt + r16) * 272 + (16 * w + 4 * quad) * 2) = (u32x2){pk2(S[vt].x, S[vt].y), pk2(S[vt].z, S[vt].w)};
    }
    float lf[16]; unsigned short qr[16], vr[16];
#define HG_LOAD(c_) do { const int t0_ = 64 * (c_); _Pragma("unroll") for (int i = 0; i < 16; ++i) { const int t_ = t0_ + 16 * seg + i; const bool ok_ = t_ < TP; \
        const size_t off_ = ((size_t)(b * TP + (ok_ ? t_ : 0))) * D + colbase + kcol; \
        float l_; unsigned short q_ = 0, v_; if (full) { l_ = __builtin_nontemporal_load(LF + off_); q_ = __builtin_nontemporal_load(QB + off_); v_ = __builtin_nontemporal_load(VB + off_); } else { l_ = LF[off_]; v_ = VB[off_]; } \
        lf[i] = ok_ ? l_ : 1.f; qr[i] = ok_ ? q_ : (unsigned short)0; vr[i] = ok_ ? v_ : (unsigned short)0; } } while (0)
    HG_LOAD(c_begin);
    for (int c = c_begin; c < c_end; ++c) {
        float bl[16]; float run = 1.f;
#pragma unroll
        for (int i = 0; i < 16; ++i) { run *= lf[i]; bl[i] = run; }
        ((LAS float*)(lds + H_SEG))[seg * 128 + kcol] = run;
        __syncthreads();
        float pre = 1.f;
        for (int s = 0; s < seg; ++s) pre *= ((LAS float*)(lds + H_SEG))[s * 128 + kcol];
        unsigned ktp[8], vtp[8]; float eb_last = 1.f;
#pragma unroll
        for (int i = 0; i < 16; i += 2) {
            float kt2[2], qt2[2];
#pragma unroll
            for (int e = 0; e < 2; ++e) { const float eb = pre * bl[i + e], enb = __builtin_amdgcn_rcpf(eb); const float q = bf2f(qr[i + e]); const float kk = 1.0f - lf[i + e];
                qt2[e] = q * eb; kt2[e] = kk * enb; eb_last = eb; }
            ktp[i >> 1] = pk2(kt2[0], kt2[1]); vtp[i >> 1] = (unsigned)vr[i] | ((unsigned)vr[i + 1] << 16);
            if (full) { const unsigned qp = pk2(qt2[0], qt2[1]); const int ts = 16 * seg + i;
                *(LAS unsigned short*)(lds + H_QT + ts * 272 + kcol * 2) = (unsigned short)qp; *(LAS unsigned short*)(lds + H_QT + (ts + 1) * 272 + kcol * 2) = (unsigned short)(qp >> 16);
                *(LAS unsigned short*)(lds + H_KT + ts * 272 + kcol * 2) = (unsigned short)ktp[i >> 1]; *(LAS unsigned short*)(lds + H_KT + (ts + 1) * 272 + kcol * 2) = (unsigned short)(ktp[i >> 1] >> 16); }
        }
        *(LAS u32x4*)(lds + H_KTT + kcol * 144 + seg * 32) = (u32x4){ktp[0], ktp[1], ktp[2], ktp[3]};
        *(LAS u32x4*)(lds + H_KTT + kcol * 144 + seg * 32 + 16) = (u32x4){ktp[4], ktp[5], ktp[6], ktp[7]};
        *(LAS u32x4*)(lds + H_VT + kcol * 144 + seg * 32) = (u32x4){vtp[0], vtp[1], vtp[2], vtp[3]};
        *(LAS u32x4*)(lds + H_VT + kcol * 144 + seg * 32 + 16) = (u32x4){vtp[4], vtp[5], vtp[6], vtp[7]};
        if (seg == 3) ((LAS float*)(lds + H_DEC))[kcol] = eb_last;
        { const int cn = (c + 1 < c_end) ? c + 1 : c; HG_LOAD(cn); }
        __syncthreads();
        const f32x4 dec = *(const LAS f32x4*)(lds + H_DEC + (16 * w + 4 * quad) * 4);
        dprod = dprod * dec;
        if (!full) {
#pragma unroll
            for (int ss = 0; ss < 2; ++ss) { const bf16x8 ka = *(const LAS bf16x8*)(lds + H_KTT + (16 * w + r16) * 144 + (32 * ss + 8 * quad) * 2);
#pragma unroll
                for (int vt = 0; vt < 8; ++vt) { const bf16x8 vb = *(const LAS bf16x8*)(lds + H_VT + (16 * vt + r16) * 144 + (32 * ss + 8 * quad) * 2); S[vt] = MFMA16(ka, vb, S[vt]); } }
#pragma unroll
            for (int vt = 0; vt < 8; ++vt) S[vt] = S[vt] * dec;
        } else {
        const int nt_ = tid >> 3, njj = tid & 7; const int tg = 64 * c + nt_;
        const size_t goff = ((size_t)(tg < TP ? b * TP + tg : MTOT + nt_)) * D + colbase + 16 * njj;
        const u32x4 g0 = __builtin_nontemporal_load((const u32x4*)(GB + goff)), g1 = __builtin_nontemporal_load((const u32x4*)(GB + goff + 8));
        bf16x8 qa[4];
#pragma unroll
        for (int ks = 0; ks < 4; ++ks) qa[ks] = *(const LAS bf16x8*)(lds + H_QT + (16 * tt + r16) * 272 + (32 * ks + 8 * quad) * 2);
        f32x4 O[4];
#pragma unroll
        for (int j = 0; j < 4; ++j) { O[j] = (f32x4){0.f, 0.f, 0.f, 0.f}; const int vt = 4 * vh + j;
#pragma unroll
            for (int ks = 0; ks < 4; ++ks) { const bf16x8 sb = *(const LAS bf16x8*)(lds + H_S0T + (16 * vt + r16) * 272 + (32 * ks + 8 * quad) * 2); O[j] = MFMA16(qa[ks], sb, O[j]); } }
#pragma unroll
        for (int j = 0; j < 2; ++j) { const int st = 2 * vh + j; f32x4 a = (f32x4){0.f, 0.f, 0.f, 0.f};
            if (st <= tt) {
#pragma unroll
                for (int ks = 0; ks < 4; ++ks) { const bf16x8 kb = *(const LAS bf16x8*)(lds + H_KT + (16 * st + r16) * 272 + (32 * ks + 8 * quad) * 2); a = MFMA16(qa[ks], kb, a); } }
#pragma unroll
            for (int r = 0; r < 4; ++r) { const int tl = 16 * tt + 4 * quad + r, sl = 16 * st + r16; const float val = (sl <= tl) ? a[r] : 0.f;
                *(LAS unsigned short*)(lds + H_AM + tl * 144 + sl * 2) = f2bf(val); } }
        __syncthreads();
#pragma unroll
        for (int ss = 0; ss < 2; ++ss) { const bf16x8 aa = *(const LAS bf16x8*)(lds + H_AM + (16 * tt + r16) * 144 + (32 * ss + 8 * quad) * 2);
#pragma unroll
            for (int j = 0; j < 4; ++j) { const int vt = 4 * vh + j; const bf16x8 vb = *(const LAS bf16x8*)(lds + H_VT + (16 * vt + r16) * 144 + (32 * ss + 8 * quad) * 2); O[j] = MFMA16(aa, vb, O[j]); } }
#pragma unroll
        for (int ss = 0; ss < 2; ++ss) { const bf16x8 ka = *(const LAS bf16x8*)(lds + H_KTT + (16 * w + r16) * 144 + (32 * ss + 8 * quad) * 2);
#pragma unroll
            for (int vt = 0; vt < 8; ++vt) { const bf16x8 vb = *(const LAS bf16x8*)(lds + H_VT + (16 * vt + r16) * 144 + (32 * ss + 8 * quad) * 2); S[vt] = MFMA16(ka, vb, S[vt]); } }
#pragma unroll
        for (int vt = 0; vt < 8; ++vt) { S[vt] = S[vt] * dec;
            *(LAS u32x2*)(lds + H_S0T + (16 * vt + r16) * 272 + (16 * w + 4 * quad) * 2) = (u32x2){pk2(S[vt].x, S[vt].y), pk2(S[vt].z, S[vt].w)}; }
#pragma unroll
        for (int j = 0; j < 4; ++j) { const int vt = 4 * vh + j;
#pragma unroll
            for (int r = 0; r < 4; ++r) ((LAS float*)lds)[(16 * tt + 4 * quad + r) * 132 + 16 * vt + r16] = O[j][r]; }
        __syncthreads();
        { const int t = nt_, jj = njj;
          f32x4 o4[4]; float ss = 0.f;
#pragma unroll
          for (int i = 0; i < 4; ++i) { o4[i] = *(const LAS f32x4*)(lds + (t * 132 + 16 * jj + 4 * i) * 4); ss += (o4[i].x * o4[i].x + o4[i].y * o4[i].y) + (o4[i].z * o4[i].z + o4[i].w * o4[i].w); }
          ss += __shfl_xor(ss, 1); ss += __shfl_xor(ss, 2); ss += __shfl_xor(ss, 4);
          const float rstd = rsqrtf(ss * (1.0f / 128.0f) + RMS_EPS);
          { const size_t off = goff;
              const unsigned gw_[8] = {g0.x, g0.y, g0.z, g0.w, g1.x, g1.y, g1.z, g1.w};
              const float* nw = p.norm_w + colbase + 16 * jj;
              unsigned ow[8];
#pragma unroll
              for (int i = 0; i < 4; ++i) { const f32x4 n4 = *(const f32x4*)(nw + 4 * i);
                  const float y0 = o4[i].x * rstd * n4.x * bf2f((unsigned short)(gw_[2 * i] & 0xffffu)), y1 = o4[i].y * rstd * n4.y * bf2f((unsigned short)(gw_[2 * i] >> 16));
                  const float y2 = o4[i].z * rstd * n4.z * bf2f((unsigned short)(gw_[2 * i + 1] & 0xffffu)), y3 = o4[i].w * rstd * n4.w * bf2f((unsigned short)(gw_[2 * i + 1] >> 16));
                  ow[2 * i] = pk2(y0, y1); ow[2 * i + 1] = pk2(y2, y3); }
              *(u32x4*)(OB + off) = (u32x4){ow[0], ow[1], ow[2], ow[3]}; *(u32x4*)(OB + off + 8) = (u32x4){ow[4], ow[5], ow[6], ow[7]}; }
        }
        }
    }
#undef HG_LOAD
    if (!full || sg == 3) {
        float* so = full ? p.out + OUT_SP + ((size_t)(b * 16 + h)) * 16384 : HU + (size_t)item * 16384;
#pragma unroll
        for (int vt = 0; vt < 8; ++vt)
#pragma unroll
            for (int r = 0; r < 4; ++r) { float* d_ = so + (16 * w + 4 * quad + r) * 128 + 16 * vt + r16; if (full) __builtin_nontemporal_store(S[vt][r], d_); else *d_ = S[vt][r]; }
        if (!full && r16 == 0) *(f32x4*)(HD + item * 128 + 16 * w + 4 * quad) = dprod;
    }
    __syncthreads();
}

constexpr int SS_Q = 0, SS_K = 4096, SS_V = 8192, SS_E8 = 12288, SS_A = 12800, SS_B = 13056, SS_QR = 17152, SS_PART = 25600;
struct SampRaw { float lf[2]; unsigned short q[2], v[2]; f32x4 s0[8]; };
__device__ __forceinline__ void hgrn_sample_load(const Params& p, int it, SampRaw& r) {
    int tid_l = threadIdx.x; asm volatile("" : "+v"(tid_l)); const int tid = tid_l, b = it >> 4, h = it & 15;
    const bf16_t* QB = (const bf16_t*)(p.ws + WS_QB); const float* LF = (const float*)(p.ws + WS_LF); const bf16_t* VB = (const bf16_t*)(p.ws + WS_VB);
    const size_t rbase = ((size_t)(MPR + b * 8)) * D + h * 128;
#pragma unroll
    for (int j = 0; j < 2; ++j) { const int rem = tid + 512 * j, t = rem >> 7, k = rem & 127; const size_t o = rbase + (size_t)t * D + k; r.lf[j] = __builtin_nontemporal_load(LF + o); r.q[j] = __builtin_nontemporal_load(QB + o); r.v[j] = __builtin_nontemporal_load(VB + o); }
    { const int v4 = tid & 31, kg = tid >> 5; const float* S0 = p.state + ((size_t)(b * 16 + h)) * 16384;
#pragma unroll
      for (int i = 0; i < 8; ++i) r.s0[i] = __builtin_nontemporal_load((const f32x4*)(S0 + (8 * kg + i) * 128 + 4 * v4)); }
}
__device__ __forceinline__ void hgrn_sample_item(const Params& p, LAS unsigned char* lds, int it, int it_next, SampRaw& raw) {
    int tid_l = threadIdx.x; asm volatile("" : "+v"(tid_l)); const int tid = tid_l, lane = tid & 63;
    const int b = it >> 4, h = it & 15;
    const bf16_t* GB = (const bf16_t*)(p.ws + WS_GB); bf16_t* OB = (bf16_t*)(p.ws + WS_OB);
    const size_t rbase = ((size_t)(MPR + b * 8)) * D + h * 128;
    LAS float* SQ = (LAS float*)(lds + SS_Q); LAS float* SK = (LAS float*)(lds + SS_K); LAS float* SV = (LAS float*)(lds + SS_V); LAS float* SE8 = (LAS float*)(lds + SS_E8);
    LAS float* SA = (LAS float*)(lds + SS_A); LAS float* SB = (LAS float*)(lds + SS_B); LAS float* SQR = (LAS float*)(lds + SS_QR);
    LAS float* PART = (LAS float*)(lds + SS_PART);
    const int v4 = tid & 31, kg = tid >> 5;
    const float* S0 = p.state + ((size_t)(b * 16 + h)) * 16384; float* S1 = p.out + OUT_SS + ((size_t)(b * 16 + h)) * 16384;
    f32x4 s0[8];
#pragma unroll
    for (int i = 0; i < 8; ++i) s0[i] = raw.s0[i];
#pragma unroll
    for (int j = 0; j < 2; ++j) { const int rem = tid + 512 * j; SB[rem] = raw.lf[j]; SQR[rem] = bf2f(raw.q[j]); SV[rem] = bf2f(raw.v[j]); }
    __syncthreads();
    if (it_next < 2048) hgrn_sample_load(p, it_next, raw);
    if (tid < 128) { const int k = tid; float lfv[8], bt[8]; float run = 1.f;
#pragma unroll
        for (int t = 0; t < 8; ++t) { lfv[t] = SB[t * 128 + k]; run *= lfv[t]; bt[t] = run; }
#pragma unroll
        for (int t = 0; t < 8; ++t) { SQ[k * 8 + t] = SQR[t * 128 + k] * bt[t]; SK[k * 8 + t] = (1.0f - lfv[t]) * __builtin_amdgcn_rcpf(bt[t]); }
        SE8[k] = run;
    }
    __syncthreads();
    { const int pair = tid >> 3, ks = tid & 7, t = pair >> 3, s = pair & 7; float a = 0.f;
#pragma unroll
        for (int i = 0; i < 16; ++i) a += SQ[(ks + 8 * i) * 8 + t] * SK[(ks + 8 * i) * 8 + s];
        a += __shfl_xor(a, 1); a += __shfl_xor(a, 2); a += __shfl_xor(a, 4);
        if (ks == 0) SA[pair] = (s <= t) ? a : 0.f; }
    {
        f32x4 vv[8], o[8];
#pragma unroll
        for (int s = 0; s < 8; ++s) { vv[s] = *(const LAS f32x4*)(SV + s * 128 + 4 * v4); o[s] = (f32x4){0.f, 0.f, 0.f, 0.f}; }
#pragma unroll
        for (int i = 0; i < 8; ++i) { const int k = 8 * kg + i;
            const f32x4 qa = *(const LAS f32x4*)(SQ + k * 8), qb = *(const LAS f32x4*)(SQ + k * 8 + 4), ka = *(const LAS f32x4*)(SK + k * 8), kb = *(const LAS f32x4*)(SK + k * 8 + 4);
            const float q8[8] = {qa.x, qa.y, qa.z, qa.w, qb.x, qb.y, qb.z, qb.w}, k8[8] = {ka.x, ka.y, ka.z, ka.w, kb.x, kb.y, kb.z, kb.w};
            f32x4 sn = s0[i];
#pragma unroll
            for (int t = 0; t < 8; ++t) { o[t] = o[t] + s0[i] * q8[t]; sn = sn + vv[t] * k8[t]; }
            __builtin_nontemporal_store(sn * SE8[k], (f32x4*)(S1 + k * 128 + 4 * v4)); }
#pragma unroll
        for (int t = 0; t < 8; ++t) *(LAS f32x4*)(PART + (kg * 8 + t) * 128 + 4 * v4) = o[t];
    }
    __syncthreads();
    { const int t = tid >> 6, vp = lane; f32x2v o2 = (f32x2v){0.f, 0.f};
#pragma unroll
        for (int g = 0; g < 16; ++g) o2 = o2 + *(const LAS f32x2v*)(PART + (g * 8 + t) * 128 + 2 * vp);
#pragma unroll
        for (int s = 0; s < 8; ++s) o2 = o2 + *(const LAS f32x2v*)(SV + s * 128 + 2 * vp) * SA[t * 8 + s];
        float ss = o2.x * o2.x + o2.y * o2.y;
#pragma unroll
        for (int m = 1; m < 64; m <<= 1) ss += __shfl_xor(ss, m);
        const float rstd = rsqrtf(ss * (1.0f / 128.0f) + RMS_EPS);
        const size_t off = rbase + (size_t)t * D + 2 * vp;
        const unsigned g = __builtin_nontemporal_load((const unsigned*)(GB + off)); const f32x2v nw = *(const f32x2v*)(p.norm_w + h * 128 + 2 * vp);
        *(unsigned*)(OB + off) = pk2(o2.x * rstd * nw.x * bf2f((unsigned short)(g & 0xffffu)), o2.y * rstd * nw.y * bf2f((unsigned short)(g >> 16))); }
    __syncthreads();
}

__device__ __forceinline__ void phase_hgrn(const Params& p, LAS unsigned char* lds, const XcdBarrier& xb) {
    const int G = gridDim.x, blk = blockIdx.x;
    const bool early = (G == 256) && ((blk & 3) == 3); constexpr int NEARLY = 64 * 6;
    const int s_lo = (G == 256) ? NEARLY : 0;
    const bool swap = (G == 256) && (((blk >> 2) & 1) != 0);
    for (int stage = 0; stage < 2; ++stage) {
        for (int k = 0; k < 2; ++k) {
            const bool do_chain = (stage == 0) ? (k == 0) : ((k == 0) != swap);
            if (do_chain) { for (int it = blk; it < 256; it += G) hgrn_chain(p, lds, it, stage); }
            else {
                int it, step, end;
                if (stage == 0) { it = early ? (blk >> 2) : 4096; step = 64; end = NEARLY; } else { it = s_lo + blk; step = G; end = 2048; }
                SampRaw raw; if (it < end) hgrn_sample_load(p, it, raw);
                for (; it < end; it += step) hgrn_sample_item(p, lds, it, (it + step < end) ? it + step : 4096, raw);
            }
        }
        if (stage == 0) xcd_barrier(xb);
    }
}

constexpr int A_KS = 0, A_VT = 23040;
constexpr int ATT_PROMPT_ITEMS = NBP * 4 * 65, ATT_ITEMS = ATT_PROMPT_ITEMS + NBS * 4;
struct AttPre { u32x4 r[3][4]; };
__device__ __forceinline__ void attn_load(const Params& p, int it, AttPre& pre) {
    const int tid = threadIdx.x;
    const bf16_t* K1 = (const bf16_t*)(p.ws + WS_K1); const bf16_t* V1 = (const bf16_t*)(p.ws + WS_V1);
    const bool samp = it >= ATT_PROMPT_ITEMS;
    int b, kvh, t0 = 0;
    if (!samp) { b = it / 260; const int rem = it - b * 260; kvh = rem / 65; t0 = 32 * (rem - kvh * 65); } else { const int j = it - ATT_PROMPT_ITEMS; b = j >> 2; kvh = j & 3; }
#pragma unroll
    for (int u = 0; u < 3; ++u) { const int idx = tid + 512 * u;
        const int kA = idx >> 3, cA = idx & 7;
        const int cB = idx / 160, kB = idx - 160 * cB;
        const u32x4 z = (u32x4){0u, 0u, 0u, 0u}; pre.r[u][0] = z; pre.r[u][1] = z; pre.r[u][2] = z; pre.r[u][3] = z;
        if (idx < 1280) {
            if (!samp) { const int pA = t0 - 128 + kA, pB = t0 - 128 + kB;
                if (pA >= 0 && pA < TP) pre.r[u][0] = *(const u32x4*)(K1 + ((size_t)(b * TP + pA)) * 256 + kvh * 64 + 8 * cA);
                if (pB >= 0 && pB < TP) pre.r[u][1] = *(const u32x4*)(V1 + ((size_t)(b * TP + pB)) * 256 + kvh * 64 + 8 * cB); }
            else {
                if (kA < 128) { const size_t o = (((size_t)b * 128 + kA) * 4 + kvh) * 64 + 8 * cA; pre.r[u][0] = *(const u32x4*)(p.cache_k + o); pre.r[u][1] = *(const u32x4*)(p.cache_k + o + 4); }
                else if (kA < 136) pre.r[u][0] = *(const u32x4*)(K1 + ((size_t)(MPR + b * 8 + kA - 128)) * 256 + kvh * 64 + 8 * cA);
                if (kB < 128) { const size_t o = (((size_t)b * 128 + kB) * 4 + kvh) * 64 + 8 * cB; pre.r[u][2] = *(const u32x4*)(p.cache_v + o); pre.r[u][3] = *(const u32x4*)(p.cache_v + o + 4); }
                else if (kB < 136) pre.r[u][2] = *(const u32x4*)(V1 + ((size_t)(MPR + b * 8 + kB - 128)) * 256 + kvh * 64 + 8 * cB);
            }
        } }
}
__device__ __forceinline__ void attn_stage(LAS unsigned char* base, int itp, const AttPre& pre) {
    const int tid = threadIdx.x; const bool samp = itp >= ATT_PROMPT_ITEMS;
#pragma unroll
    for (int u = 0; u < 3; ++u) { const int idx = tid + 512 * u;
        const int kA = idx >> 3, cA = idx & 7, cB = idx / 160, kB = idx - 160 * cB;
        if (idx < 1280) {
            u32x4 kv = pre.r[u][0], vv = samp ? pre.r[u][2] : pre.r[u][1];
            if (samp && kA < 128) { const f32x4 a = __builtin_bit_cast(f32x4, pre.r[u][0]), bq = __builtin_bit_cast(f32x4, pre.r[u][1]); kv = (u32x4){pk2(a.x, a.y), pk2(a.z, a.w), pk2(bq.x, bq.y), pk2(bq.z, bq.w)}; }
            if (samp && kB < 128) { const f32x4 c = __builtin_bit_cast(f32x4, pre.r[u][2]), d = __builtin_bit_cast(f32x4, pre.r[u][3]); vv = (u32x4){pk2(c.x, c.y), pk2(c.z, c.w), pk2(d.x, d.y), pk2(d.z, d.w)}; }
            *(LAS u32x4*)(base + A_KS + kA * 144 + cA * 16) = kv;
            const unsigned vw[4] = {vv.x, vv.y, vv.z, vv.w};
#pragma unroll
            for (int j = 0; j < 4; ++j) { *(LAS unsigned short*)(base + A_VT + (8 * cB + 2 * j) * 336 + kB * 2) = (unsigned short)(vw[j] & 0xffffu);
                *(LAS unsigned short*)(base + A_VT + (8 * cB + 2 * j + 1) * 336 + kB * 2) = (unsigned short)(vw[j] >> 16); }
        } }
}
constexpr int ATT_BUF = 44544;
__device__ __forceinline__ void attn_item(const Params& p, LAS unsigned char* lds_all, int it, int it_n1, int it_n2, int cur, AttPre& pre) {
    int tid_l = threadIdx.x; asm volatile("" : "+v"(tid_l)); const int tid = tid_l, w = tid >> 6, lane = tid & 63, r16 = lane & 15, quad = lane >> 4;
    LAS unsigned char* lds = lds_all + cur * ATT_BUF; LAS unsigned char* ldsn = lds_all + (cur ^ 1) * ATT_BUF;
    const bf16_t* Q1 = (const bf16_t*)(p.ws + WS_QB);
    const bf16_t* GB = (const bf16_t*)(p.ws + WS_GB); bf16_t* OB = (bf16_t*)(p.ws + WS_OB);
    const bool samp = it >= ATT_PROMPT_ITEMS;
    int b, kvh, t0 = 0;
    if (!samp) { b = it / 260; const int rem = it - b * 260; kvh = rem / 65; t0 = 32 * (rem - kvh * 65); } else { const int j = it - ATT_PROMPT_ITEMS; b = j >> 2; kvh = j & 3; }
    const int hq = kvh * 8 + w;
    bf16x8 qf[2][2]; bool qok[2]; size_t qrow[2];
#pragma unroll
    for (int tt = 0; tt < 2; ++tt) { const int i = 16 * tt + r16;
        if (!samp) { const int t = t0 + i; qok[tt] = t < TP; qrow[tt] = (size_t)(b * TP + (qok[tt] ? t : 0)); } else { qok[tt] = i < 8; qrow[tt] = (size_t)(MPR + b * 8 + (qok[tt] ? i : 0)); }
#pragma unroll
        for (int ds = 0; ds < 2; ++ds) { bf16x8 q = __builtin_nontemporal_load((const bf16x8*)(Q1 + qrow[tt] * D + hq * 64 + 32 * ds + 8 * quad)); if (!qok[tt]) q = (bf16x8){0, 0, 0, 0, 0, 0, 0, 0}; qf[tt][ds] = q; } }
    u32x4 gw[4]; size_t orow[4]; bool ook[4];
#pragma unroll
    for (int k = 0; k < 4; ++k) { const int i = 8 * k + (lane >> 3);
        if (!samp) { const int t = t0 + i; ook[k] = t < TP; orow[k] = (size_t)(b * TP + (ook[k] ? t : 0)); } else { ook[k] = i < 8; orow[k] = (size_t)(MPR + b * 8 + (ook[k] ? i : 0)); }
        gw[k] = __builtin_nontemporal_load((const u32x4*)(GB + orow[k] * D + hq * 64 + 8 * (lane & 7))); }
    __syncthreads();
    f32x4 st[10][2];
#pragma unroll
    for (int kt = 0; kt < 10; ++kt) { st[kt][0] = (f32x4){0.f, 0.f, 0.f, 0.f}; st[kt][1] = (f32x4){0.f, 0.f, 0.f, 0.f};
#pragma unroll
        for (int ds = 0; ds < 2; ++ds) { const bf16x8 ka = *(const LAS bf16x8*)(lds + A_KS + (16 * kt + r16) * 144 + (32 * ds + 8 * quad) * 2);
            st[kt][0] = MFMA16(ka, qf[0][ds], st[kt][0]); if (!samp) st[kt][1] = MFMA16(ka, qf[1][ds], st[kt][1]); } }
    const float sink = p.sinks[hq] * 1.44269504089f;
    const int kminv = samp ? 0 : (128 - t0 > 0 ? 128 - t0 : 0);
    const bool midfree = kminv <= 32;
    const int ntt = samp ? 1 : 2;
    bf16x8 pb[5][2]; float inv[2] = {0.f, 0.f};
#pragma unroll
    for (int tt = 0; tt < 2; ++tt) if (tt < ntt) { const int i = 16 * tt + r16; const int lo = (i + 1 > kminv) ? i + 1 : kminv, hi = i + 128;
        float m = -INFINITY;
#pragma unroll
        for (int kt = 0; kt < 10; ++kt) {
            if (kt >= 2 && kt < 8 && midfree) {
#pragma unroll
                for (int r = 0; r < 4; ++r) m = fmaxf(m, st[kt][tt][r]);
            } else {
#pragma unroll
                for (int r = 0; r < 4; ++r) { const int kp = 16 * kt + 4 * quad + r; const float s = (kp >= lo && kp <= hi) ? st[kt][tt][r] : -INFINITY; st[kt][tt][r] = s; m = fmaxf(m, s); }
            } }
        m = fmaxf(m, __shfl_xor(m, 16)); m = fmaxf(m, __shfl_xor(m, 32)); m = fmaxf(m, sink);
        float sum = 0.f;
#pragma unroll
        for (int kt = 0; kt < 10; ++kt)
#pragma unroll
            for (int r = 0; r < 4; ++r) { const float e = __builtin_amdgcn_exp2f(st[kt][tt][r] - m); st[kt][tt][r] = e; sum += e; }
        sum += __shfl_xor(sum, 16); sum += __shfl_xor(sum, 32); sum += __builtin_amdgcn_exp2f(sink - m);
        inv[tt] = __builtin_amdgcn_rcpf(sum);
#pragma unroll
        for (int ks = 0; ks < 5; ++ks) { const f32x4 a = st[2 * ks][tt], c = st[2 * ks + 1][tt];
            const u32x4 pw = (u32x4){pk2(a.x, a.y), pk2(a.z, a.w), pk2(c.x, c.y), pk2(c.z, c.w)}; pb[ks][tt] = __builtin_bit_cast(bf16x8, pw); }
    }
    if (it_n1 < ATT_ITEMS) attn_stage(ldsn, it_n1, pre);
    if (it_n2 < ATT_ITEMS) attn_load(p, it_n2, pre);
    f32x4 o[4][2];
#pragma unroll
    for (int dt = 0; dt < 4; ++dt) { o[dt][0] = (f32x4){0.f, 0.f, 0.f, 0.f}; o[dt][1] = (f32x4){0.f, 0.f, 0.f, 0.f}; }
#pragma unroll
    for (int ks = 0; ks < 5; ++ks)
#pragma unroll
        for (int dt = 0; dt < 4; ++dt) { const u32x2 l8 = *(const LAS u32x2*)(lds + A_VT + (16 * dt + r16) * 336 + (32 * ks + 4 * quad) * 2), h8 = *(const LAS u32x2*)(lds + A_VT + (16 * dt + r16) * 336 + (32 * ks + 16 + 4 * quad) * 2);
            const bf16x8 va = __builtin_bit_cast(bf16x8, (u32x4){l8.x, l8.y, h8.x, h8.y});
            o[dt][0] = MFMA16(va, pb[ks][0], o[dt][0]); if (ntt > 1) o[dt][1] = MFMA16(va, pb[ks][1], o[dt][1]); }
    LAS unsigned char* os = lds_all + 2 * ATT_BUF + w * 4608;
#pragma unroll
    for (int tt = 0; tt < 2; ++tt) if (tt < ntt) {
#pragma unroll
        for (int dt = 0; dt < 4; ++dt) { const f32x4 x = o[dt][tt] * inv[tt];
            *(LAS u32x2*)(os + (16 * tt + r16) * 144 + (16 * dt + 4 * quad) * 2) = (u32x2){pk2(x.x, x.y), pk2(x.z, x.w)}; } }
    LDS_WAIT();
#pragma unroll
    for (int k = 0; k < 4; ++k) if (k < 2 * ntt) { const int i = 8 * k + (lane >> 3);
        const u32x4 ov = *(const LAS u32x4*)(os + i * 144 + (lane & 7) * 16);
        const unsigned ow_[4] = {ov.x, ov.y, ov.z, ov.w}, gg[4] = {gw[k].x, gw[k].y, gw[k].z, gw[k].w}; unsigned rr[4];
#pragma unroll
        for (int j = 0; j < 4; ++j) rr[j] = pk2(__uint_as_float(ow_[j] << 16) * __uint_as_float(gg[j] << 16), __uint_as_float(ow_[j] & 0xffff0000u) * __uint_as_float(gg[j] & 0xffff0000u));
        if (ook[k]) *(u32x4*)(OB + orow[k] * D + hq * 64 + 8 * (lane & 7)) = (u32x4){rr[0], rr[1], rr[2], rr[3]}; }
    LDS_WAIT();
}
__device__ __forceinline__ int att_item_of(int blk, int r, int G) {
    if (G != 256) return blk + r * G;
    if (r < 6) return blk + 256 * r;
    return (r == 6 && blk >= 16 && blk < 32) ? 1536 + (blk - 16) : ATT_ITEMS;
}

__global__ void __launch_bounds__(512, 2) fwd_megakernel(Params p) {
    extern __shared__ __attribute__((aligned(16))) unsigned char shm[];
    LAS unsigned char* lds = (LAS unsigned char*)shm;
    const int G = gridDim.x;
    if (threadIdx.x < 4) ((LAS unsigned*)(lds + 131072))[threadIdx.x] = 0u;
    __syncthreads();
    const XcdBarrier xb = xcd_barrier_post((unsigned*)(p.ws + WS_BAR), (volatile LAS unsigned*)(lds + 131072));
    bf16_t* XB = (bf16_t*)(p.ws + WS_XB); bf16_t* OB = (bf16_t*)(p.ws + WS_OB); bf16_t* QB = (bf16_t*)(p.ws + WS_QB); bf16_t* VB = (bf16_t*)(p.ws + WS_VB); bf16_t* GB = (bf16_t*)(p.ws + WS_GB);
    float* ZB = (float*)(p.ws + WS_ZB);
    phase0(p, lds);
    xcd_barrier(xb);
    { pg8::Gemm g{XB, (const bf16_t*)(p.ws + WS_WT0), MPAD, 8192, 2048}; pg8::StaticOrder S; S.init(MPAD, 8192, G, blockIdx.x);
      EpiHgrnIn E{p.ws, (float*)(p.ws + WS_LF), (const float*)(p.ws + WS_LB)};
      pg8::gemm_phase<EpiHgrnIn, pg8::StaticOrder, false>(lds, g, S, E, nullptr);
      const int heavy = (37 * 32) % G; const int li = heavy ? (int)blockIdx.x - heavy : (int)blockIdx.x;
      if (li >= 0) phase0_rest(p, lds, li, heavy ? G - heavy : G); }
    xcd_barrier(xb);
    phase_hgrn(p, lds, xb);
    xcd_barrier(xb);
    { pg8::Gemm g{OB, (const bf16_t*)(p.ws + WS_WTO0), MPAD, 2048, 2048}; OrderOut S; S.init(G, blockIdx.x);
      EpiY E{VB, (float*)(p.ws + WS_LF)};
      pg8::gemm_phase<EpiY, OrderOut, false>(lds, g, S, E, nullptr); }
    xcd_barrier(xb);
    phase_ln<1>(p, 0);
    xcd_barrier(xb);
    { pg8::Gemm g{XB, (const bf16_t*)(p.ws + WS_WT1), MPAD, 4608, 2048}; pg8::StaticOrder S; S.init(MPAD, 4608, G, blockIdx.x);
      EpiSwaIn E{QB, (bf16_t*)(p.ws + WS_K1), (bf16_t*)(p.ws + WS_V1), GB, p.out};
      pg8::gemm_phase<EpiSwaIn, pg8::StaticOrder, false>(lds, g, S, E, nullptr);
      const int heavy = (37 * 18) % G; const int li = heavy ? (int)blockIdx.x - heavy : (int)blockIdx.x;
      if (li >= 0) phase_cache_shift(p, li, heavy ? G - heavy : G); }
    xcd_barrier(xb);
    { AttPre pre; int it = att_item_of(blockIdx.x, 0, G), n1 = att_item_of(blockIdx.x, 1, G);
      if (it < ATT_ITEMS) { attn_load(p, it, pre); attn_stage(lds, it, pre); }
      if (n1 < ATT_ITEMS) attn_load(p, n1, pre);
      for (int r = 0; it < ATT_ITEMS; ++r) { const int n2 = (n1 < ATT_ITEMS) ? att_item_of(blockIdx.x, r + 2, G) : ATT_ITEMS; attn_item(p, lds, it, n1, n2, r & 1, pre); it = n1; n1 = n2; } }
    xcd_barrier(xb);
    { pg8::Gemm g{OB, (const bf16_t*)(p.ws + WS_WTO1), MPAD, 2048, 2048}; OrderOut S; S.init(G, blockIdx.x);
      EpiY E{VB, (float*)(p.ws + WS_LF)};
      pg8::gemm_phase<EpiY, OrderOut, false>(lds, g, S, E, nullptr); }
    xcd_barrier(xb);
    for (int rep = 0; rep < REP_LN; ++rep) phase_ln<2>(p, 1);
}

extern "C" void kernel_launch(void* const* d_in, const int* in_sizes, int n_in, void* d_out, int out_size, void* d_ws, size_t ws_size, hipStream_t stream) {
    static int grid_blocks = 0;
    if (!grid_blocks) {
        int dev = 0, cus = 0, per_cu = 0;
        hipGetDevice(&dev);
        hipDeviceGetAttribute(&cus, hipDeviceAttributeMultiprocessorCount, dev);
        hipFuncSetAttribute((const void*)fwd_megakernel, hipFuncAttributeMaxDynamicSharedMemorySize, LDS_BYTES);
        hipOccupancyMaxActiveBlocksPerMultiprocessor(&per_cu, (const void*)fwd_megakernel, 512, LDS_BYTES);
        if (per_cu < 1) { fprintf(stderr, "kernel_launch: occupancy query reports %d blocks/CU\n", per_cu); per_cu = 1; }
        grid_blocks = cus;
    }
    if (ws_size < WS_END) { fprintf(stderr, "kernel_launch: workspace too small (%zu < %zu)\n", ws_size, (size_t)WS_END); return; }
    Params p{};
    p.x_prompt = (const float*)d_in[0]; p.x_sample = (const float*)d_in[1]; p.state = (const float*)d_in[2]; p.cache_k = (const float*)d_in[3]; p.cache_v = (const float*)d_in[4];
    p.meta = (const float*)d_in[5]; p.w_in0 = (const float*)d_in[6]; p.lb_logits = (const float*)d_in[7]; p.norm_w = (const float*)d_in[8]; p.w_out0 = (const float*)d_in[9];
    p.w_in1 = (const float*)d_in[10]; p.sinks = (const float*)d_in[11]; p.w_out1 = (const float*)d_in[12]; p.ln_g = (const float*)d_in[13]; p.ln_b = (const float*)d_in[14];
    p.out = (float*)d_out; p.ws = (unsigned char*)d_ws;
    if (hipMemsetAsync((char*)d_ws + WS_BAR, 0, 16384, stream) != hipSuccess) { fprintf(stderr, "kernel_launch: memset of the barrier words failed\n"); return; }
    void* args[] = {&p};
    hipError_t e = hipLaunchCooperativeKernel((const void*)fwd_megakernel, dim3(grid_blocks), dim3(512), args, LDS_BYTES, stream);
    if (e != hipSuccess) fprintf(stderr, "cooperative launch failed: %s (grid %d)\n", hipGetErrorString(e), grid_blocks);
}
```

```cpp
#include <hip/hip_runtime.h>
#include <hip/hip_cooperative_groups.h>
#include <cstdio>
#include <cstdint>
namespace pg8 {
#define PG8_LAS __attribute__((address_space(3)))
typedef unsigned short bf16_t;
typedef short bf16x8 __attribute__((ext_vector_type(8)));
typedef float f32x4 __attribute__((ext_vector_type(4)));
typedef unsigned u32x4 __attribute__((ext_vector_type(4)));
constexpr int BM = 256, BK = 64, HALF = 128, HTB = HALF * BK * 2  , STAGE_BYTES = 8 * HTB, NXCD = 8, WGM = 8;

__host__ __device__ __forceinline__ int lds_byte(int r, int c) { const int st = (r >> 4) * 2 + (c >> 5), rr = r & 15, cc = c & 31, ob = rr * 64 + cc * 2; return st * 1024 + (ob ^ (((ob >> 9) & 1) << 5)); }
__host__ __device__ __forceinline__ void stage_rc(int b, int& R, int& C) { const int st = b / 1024, sb = b % 1024, swz = sb ^ (((sb >> 9) & 1) << 5); R = (st >> 1) * 16 + swz / 64; C = (st & 1) * 32 + (swz % 64) / 2; }
__host__ __device__ __forceinline__ int perm32(int rho) { const int n = rho >> 4, i = rho & 15; return 8 * (i >> 2) + 4 * n + (i & 3); }

struct Unit { int pm, pn, kt0, nkt; };
struct Gemm { const bf16_t* A; const bf16_t* Bt; int M, N, K; };

struct StaticOrder {
    int reps = 1;
    int nM, nN, nwg, G, c, nkt, nfull, sk;
    __host__ __device__ void init(int M, int N, int G_, int c_, int K = 2048, int split = 0) { nM = M / BM; nN = N / BM; nwg = nM * nN; G = G_; c = c_; nkt = K / BK; nfull = nwg; sk = 1;
        if (split) { const int R = nwg / G, rem = nwg - R * G; if (rem > 0 && rem * 4 <= G && (nkt % 8) == 0) { nfull = R * G; sk = 4; } } }
    __host__ __device__ bool next(int i, Unit& u) const {
        if (reps > 1) { const int R = (nwg + G - 1) / G; if (i >= R * reps) return false; i = i % R; }
        long L = (long)i * G + c; u.kt0 = 0; u.nkt = nkt;
        if (L >= nfull && sk > 1) { if (L >= nfull + G) return false; const int j = (int)(L - nfull); L = nfull + j / sk; u.nkt = nkt / sk; u.kt0 = (j % sk) * u.nkt; }
        if (L >= nwg) return false;
        int wgid = (int)L; { const int q = nwg / NXCD, r = nwg % NXCD, xcd = wgid % NXCD, off = wgid / NXCD; wgid = (xcd < r ? xcd * (q + 1) : r * (q + 1) + (xcd - r) * q) + off; }
        const int nig = WGM * nN, gid = wgid / nig, fm = gid * WGM, gsz = (nM - fm) < WGM ? (nM - fm) : WGM;
        u.pm = fm + ((wgid % nig) % gsz); u.pn = (wgid % nig) / gsz; return true;
    }
    __device__ __forceinline__ void a_ready(const Unit&) const {}
    __device__ __forceinline__ void done(const Unit&) const {}
};
__device__ __forceinline__ unsigned cvt_pk_bf16(float lo, float hi) { unsigned r; asm volatile("v_cvt_pk_bf16_f32 %0, %1, %2" : "=v"(r) : "v"(lo), "v"(hi)); return r; }
template <class Epi, class Sched, bool STAMP = false>
__device__ __forceinline__ void gemm_phase(PG8_LAS unsigned char* lds, const Gemm g, const Sched& S, const Epi& E, unsigned long long* stamps) {
    int tid_l = threadIdx.x; asm volatile("" : "+v"(tid_l));
    const int tid = tid_l, wid = __builtin_amdgcn_readfirstlane(tid >> 6), lane = tid & 63, wr = wid >> 2, wc = wid & 3, fr = lane & 15, fq = lane >> 4;
    const int K = g.K;
    int ts_lo = 0, ts_hi = 0, nts = 0; const unsigned long long rt_entry = STAMP ? (unsigned long long)wall_clock64() : 0ull;
#define PG8_STAMP() do { if (STAMP && wid == 0 && nts < 64) { const unsigned long long _c = (unsigned long long)clock64(); \
        ts_lo = (lane == nts) ? (int)(unsigned)_c : ts_lo; ts_hi = (lane == nts) ? (int)(unsigned)(_c >> 32) : ts_hi; ++nts; } } while (0)
    PG8_STAMP();
    unsigned voffA[2], voffB[2];
#pragma unroll
    for (int i = 0; i < 2; ++i) { int R, C; stage_rc(tid * 16 + i * 8192, R, C); const int Rb = Epi::PERM ? ((R & ~31) + perm32(R & 31)) : R;
        voffA[i] = (unsigned)(R * K + C) * 2u; voffB[i] = (unsigned)(Rb * K + C) * 2u; }
    const size_t kstep = (size_t)(BK * 2);
    const size_t hstep = (size_t)HALF * K * 2;
    const size_t tstep = 2 * hstep;
    const unsigned ldsw = (unsigned)wid * 1024u;
    const int aoff = lds_byte(wr * 64 + fr, fq * 8), boff = lds_byte(wc * 32 + fr, fq * 8);
#define PG8_SA(b, h) (((b) * 2 + (h)) * HTB)
#define PG8_SB(b, h) ((4 + (b) * 2 + (h)) * HTB)
#define PG8_STAGE(bufoff, gbase, voff) do { _Pragma("unroll") for (int _i = 0; _i < 2; ++_i) \
        __builtin_amdgcn_global_load_lds((const unsigned*)((const char*)(gbase) + (voff)[_i]), (PG8_LAS unsigned*)(lds + (bufoff) + ldsw + _i * 8192), 16, 0, 0); } while (0)
#define PG8_LDA(dst, b, h) do { _Pragma("unroll") for (int m = 0; m < 4; ++m) _Pragma("unroll") for (int k = 0; k < 2; ++k) dst[m][k] = *(const PG8_LAS bf16x8*)(lds + PG8_SA(b, h) + aoff + m * 2048 + k * 1024); } while (0)
#define PG8_LDB(dst, b, h) do { _Pragma("unroll") for (int n = 0; n < 2; ++n) _Pragma("unroll") for (int k = 0; k < 2; ++k) dst[n][k] = *(const PG8_LAS bf16x8*)(lds + PG8_SB(b, h) + boff + n * 2048 + k * 1024); } while (0)
#define PG8_MMA(ai, bj, At, Bt) do { __builtin_amdgcn_s_setprio(1); _Pragma("unroll") for (int m = 0; m < 4; ++m) _Pragma("unroll") for (int n = 0; n < 2; ++n) _Pragma("unroll") for (int k = 0; k < 2; ++k) \
        acc[ai][bj][m][n] = __builtin_amdgcn_mfma_f32_16x16x32_bf16(Bt[n][k], At[m][k], acc[ai][bj][m][n], 0, 0, 0); __builtin_amdgcn_s_setprio(0); } while (0)
#define PG8_WAIT_V(n) asm volatile("s_waitcnt vmcnt(" #n ")" ::: "memory")
#define PG8_WAIT_L(n) asm volatile("s_waitcnt lgkmcnt(" #n ")" ::: "memory")
#define PG8_BAR __builtin_amdgcn_s_barrier()
#define PG8_SCHED __builtin_amdgcn_sched_barrier(0)
    Unit cur, nxt; int ui = 0;
    if (!S.next(0, cur)) return;
    f32x4 acc[2][2][4][2];
#pragma unroll
    for (int a = 0; a < 2; ++a)
#pragma unroll
        for (int b = 0; b < 2; ++b)
#pragma unroll
            for (int m = 0; m < 4; ++m)
#pragma unroll
                for (int n = 0; n < 2; ++n) acc[a][b][m][n] = (f32x4){0.f, 0.f, 0.f, 0.f};
    bf16x8 At[4][2], B0[2][2], B1[2][2];
    const char* cA = (const char*)g.A + (size_t)cur.pm * tstep + (size_t)cur.kt0 * kstep; const char* cB = (const char*)g.Bt + (size_t)cur.pn * tstep + (size_t)cur.kt0 * kstep;
    int nt = cur.nkt;
    S.a_ready(cur);
    PG8_STAGE(PG8_SB(0, 0), cB, voffB); PG8_STAGE(PG8_SB(0, 1), cB + hstep, voffB); PG8_STAGE(PG8_SA(0, 0), cA, voffA); PG8_STAGE(PG8_SA(0, 1), cA + hstep, voffA);
    if (wr == 1) PG8_BAR;
    PG8_WAIT_V(2); PG8_BAR;
    PG8_STAGE(PG8_SB(1, 0), cB + kstep, voffB); PG8_STAGE(PG8_SA(1, 0), cA + kstep, voffA); PG8_STAGE(PG8_SB(1, 1), cB + hstep + kstep, voffB);
    PG8_WAIT_V(6); PG8_BAR;
    PG8_STAMP();
    for (;;) {
        const bool has_next = S.next(ui + 1, nxt);
        const char* nA = has_next ? (const char*)g.A + (size_t)nxt.pm * tstep + (size_t)nxt.kt0 * kstep : cA; const char* nB = has_next ? (const char*)g.Bt + (size_t)nxt.pn * tstep + (size_t)nxt.kt0 * kstep : cB;
        for (int t = 0; t < nt; t += 2) {
            const bool last = (t == nt - 2);
            const char* a1 = cA + (size_t)(t + 1) * kstep;
            const char* a2 = last ? nA : cA + (size_t)(t + 2) * kstep; const char* b2 = last ? nB : cB + (size_t)(t + 2) * kstep;
            const char* a3 = a2 + kstep; const char* b3 = b2 + kstep;
            if (last && has_next) S.a_ready(nxt);
            PG8_LDB(B0, 0, 0); PG8_LDB(B1, 0, 1); PG8_SCHED; PG8_LDA(At, 0, 0); PG8_STAGE(PG8_SA(1, 1), a1 + hstep, voffA);
            PG8_WAIT_V(8); PG8_WAIT_L(0); PG8_BAR; PG8_MMA(0, 0, At, B0); PG8_MMA(0, 1, At, B1); PG8_BAR; PG8_SCHED;
            PG8_LDA(At, 0, 1); PG8_STAGE(PG8_SB(0, 0), b2, voffB); PG8_STAGE(PG8_SB(0, 1), b2 + hstep, voffB); PG8_STAGE(PG8_SA(0, 0), a2, voffA);
            PG8_WAIT_V(8); PG8_WAIT_L(0); PG8_BAR; PG8_MMA(1, 0, At, B0); PG8_MMA(1, 1, At, B1); PG8_BAR; PG8_SCHED;
            PG8_LDB(B0, 1, 0); PG8_LDB(B1, 1, 1); PG8_SCHED; PG8_LDA(At, 1, 0); PG8_STAGE(PG8_SA(0, 1), a2 + hstep, voffA);
            PG8_WAIT_V(8); PG8_WAIT_L(0); PG8_BAR; PG8_MMA(0, 0, At, B0); PG8_MMA(0, 1, At, B1); PG8_BAR; PG8_SCHED;
            PG8_LDA(At, 1, 1); PG8_STAGE(PG8_SB(1, 0), b3, voffB); PG8_STAGE(PG8_SB(1, 1), b3 + hstep, voffB); PG8_STAGE(PG8_SA(1, 0), a3, voffA);
            PG8_WAIT_V(8); PG8_WAIT_L(0); PG8_BAR; PG8_MMA(1, 0, At, B0); PG8_MMA(1, 1, At, B1); PG8_BAR; PG8_SCHED;
        }
        PG8_STAMP();
        if (wr == 0) PG8_BAR;
        if constexpr (!Epi::AFTER_DRAIN) { E(acc, cur, wr, wc, fr, fq); S.done(cur); }
        PG8_STAMP();
        if (!has_next) break;
#pragma unroll
        for (int a = 0; a < 2; ++a)
#pragma unroll
            for (int b = 0; b < 2; ++b)
#pragma unroll
                for (int m = 0; m < 4; ++m)
#pragma unroll
                    for (int n = 0; n < 2; ++n) acc[a][b][m][n] = (f32x4){0.f, 0.f, 0.f, 0.f};
        cur = nxt; cA = nA; cB = nB; ++ui; nt = cur.nkt;
        if (wr == 1) PG8_BAR;
    }
    PG8_WAIT_V(0);
    PG8_BAR;
    if constexpr (Epi::AFTER_DRAIN) { E.fused(acc, cur, wr, wc, fr, fq, lds, wid, lane); S.done(cur); }
    PG8_STAMP();
    if (STAMP && wid == 0) { stamps[lane] = lane < nts ? (((unsigned long long)(unsigned)ts_hi << 32) | (unsigned)ts_lo) : 0ull;
        if (lane == 62) stamps[62] = rt_entry; if (lane == 63) stamps[63] = (unsigned long long)wall_clock64(); }
#undef PG8_STAMP
#undef PG8_SA
#undef PG8_SB
#undef PG8_STAGE
#undef PG8_LDA
#undef PG8_LDB
#undef PG8_MMA
#undef PG8_WAIT_V
#undef PG8_WAIT_L
#undef PG8_BAR
#undef PG8_SCHED
}
}
#define LAS __attribute__((address_space(3)))
#include <vector>

#define XB_TMO      128
#define XB_XCNT(j)  (256  + 64 * (j))
#define XB_XSUB(j)  (1280 + 64 * (j))
#define XB_XGEN(j)  (2304 + 64 * (j))
#define XB_TOP      3328
#define XB_TOPGEN   3392
#define XCD_BAR_WORDS 3456
#define XB_SPIN_CAP (1u << 18)

__device__ __forceinline__ unsigned xb_ld(unsigned* p)              { return __hip_atomic_load(p, __ATOMIC_RELAXED, __HIP_MEMORY_SCOPE_AGENT); }
__device__ __forceinline__ unsigned xb_add(unsigned* p, unsigned v) { return __hip_atomic_fetch_add(p, v, __ATOMIC_RELAXED, __HIP_MEMORY_SCOPE_AGENT); }
__device__ __forceinline__ unsigned xb_xcc_id() { return (unsigned)__builtin_amdgcn_s_getreg((3 << 11) | 20) & 0xFu; }
#define XB_SPIN(cond, bar) do { unsigned _sp = 0; while (cond) { __builtin_amdgcn_s_sleep(1); \
    if ((++_sp & 255u) == 0u) { if (xb_ld(&(bar)[XB_TMO])) break; if (_sp > XB_SPIN_CAP) { atomicAdd(&(bar)[XB_TMO], 1u); break; } } } } while (0)

struct XcdBarrier {
    unsigned* bar; unsigned x;
    volatile LAS unsigned* st;
};

__device__ __forceinline__ XcdBarrier xcd_barrier_post(unsigned* bar, volatile LAS unsigned* st) {
    XcdBarrier b; b.bar = bar; b.x = xb_xcc_id(); b.st = st;
    if (threadIdx.x == 0) (void)xb_add(&bar[XB_XCNT(b.x)], 1u);
    return b;
}
__device__ __forceinline__ void xcd_barrier_complete(unsigned* bar, unsigned x, unsigned& nloc, unsigned& nx) {
    const unsigned G = gridDim.x * gridDim.y * gridDim.z;
    unsigned sum, cnt, mine, sp = 0u;
    for (;;) {
        sum = 0u; cnt = 0u; mine = 0u;
#pragma unroll
        for (unsigned j = 0; j < 16; ++j) { const unsigned c = xb_ld(&bar[XB_XCNT(j)]); sum += c; cnt += (c > 0u) ? 1u : 0u; mine = (j == x) ? c : mine; }
        if (sum == G) break;
        __builtin_amdgcn_s_sleep(1);
        if ((++sp & 255u) == 0u) { if (xb_ld(&bar[XB_TMO])) break; if (sp > XB_SPIN_CAP) { atomicAdd(&bar[XB_TMO], 1u); break; } }
    }
    nloc = mine > 0u ? mine : 1u; nx = cnt > 0u ? cnt : 1u;
}

__device__ __forceinline__ void xcd_barrier(const XcdBarrier& b) {
    asm volatile("s_waitcnt vmcnt(0)" ::: "memory");
    __syncthreads();
    if (threadIdx.x == 0) {
        unsigned* bar = b.bar;
        __builtin_amdgcn_s_waitcnt(0);
        unsigned nloc = b.st[0], nx = b.st[1];
        if (nloc == 0u) { xcd_barrier_complete(bar, b.x, nloc, nx); b.st[0] = nloc; b.st[1] = nx; }
        const unsigned old = xb_add(&bar[XB_XSUB(b.x)], 1u);
        const unsigned gen = old / nloc;
        if (old + 1u == (gen + 1u) * nloc) {
            __builtin_amdgcn_fence(__ATOMIC_RELEASE, "agent");
            asm volatile("s_waitcnt vmcnt(0)" ::: "memory");
            const unsigned og = xb_add(&bar[XB_TOP], 1u);
            const unsigned tg = og / nx;
            if (og + 1u == (tg + 1u) * nx) xb_add(&bar[XB_TOPGEN], 1u);
            else XB_SPIN(xb_ld(&bar[XB_TOPGEN]) == tg, bar);
            __builtin_amdgcn_fence(__ATOMIC_ACQUIRE, "agent");
            xb_add(&bar[XB_XGEN(b.x)], 1u);
            asm volatile("s_waitcnt vmcnt(0)" ::: "memory");
        } else {
            XB_SPIN(xb_ld(&bar[XB_XGEN(b.x)]) == gen, bar);
            __builtin_amdgcn_fence(__ATOMIC_ACQUIRE, "agent");
            asm volatile("s_waitcnt vmcnt(0)" ::: "memory");
        }
    }
    __syncthreads();
}
namespace cg = cooperative_groups;
using pg8::bf16_t; using pg8::bf16x8; using pg8::f32x4; using pg8::u32x4;

typedef unsigned u32x2 __attribute__((ext_vector_type(2)));
typedef float f32x2v __attribute__((ext_vector_type(2)));

constexpr int D = 2048, TP = 2064, NBP = 4, MPR = NBP * TP, NBS = 128, TSM = 8, MSM = NBS * TSM, MTOT = MPR + MSM, MPAD = 9472;
constexpr float ALPHA = 1.41421356237309515f;
#ifndef REP_P0
#define REP_P0 1
#endif
#ifndef REP_HGRN
#define REP_HGRN 1
#endif
#ifndef REP_ATT
#define REP_ATT 1
#endif
#ifndef REP_LN
#define REP_LN 1
#endif
#ifndef REP_G1
#define REP_G1 1
#endif
#ifndef REP_G2
#define REP_G2 1
#endif
constexpr float LN_EPS = 1e-5f, RMS_EPS = 1e-6f;
constexpr int LDS_BYTES = 131072 + 64;
constexpr size_t OUT_YP = 0, OUT_YS = 16777216, OUT_SP = 18874368, OUT_SS = 19922944, OUT_KP = 53477376, OUT_VP = 53608448, OUT_KS = 53739520, OUT_VS = 57933824;
constexpr size_t SZ_BF = (size_t)MPAD * D * 2, SZ_F32 = (size_t)MPAD * D * 4;
constexpr size_t WS_WT0 = 0, WS_WTO0 = WS_WT0 + 33554432, WS_WT1 = WS_WTO0 + 8388608, WS_WTO1 = WS_WT1 + 18874368, WS_XB = WS_WTO1 + 8388608,
                 WS_QB = WS_XB + SZ_BF, WS_VB = WS_QB + SZ_BF, WS_GB = WS_VB + SZ_BF, WS_OB = WS_GB + SZ_BF, WS_LF = WS_OB + SZ_BF, WS_ZB = WS_LF + SZ_F32,
                 WS_K1 = WS_ZB + SZ_F32, WS_V1 = WS_K1 + 4849664, WS_LB = WS_V1 + 4849664, WS_BAR = WS_LB + 8192, WS_HU = WS_BAR + 16384, WS_HD = WS_HU + 256 * 65536, WS_END = WS_HD + 256 * 512;

struct Params {
    const float *x_prompt, *x_sample, *state, *cache_k, *cache_v, *meta, *w_in0, *lb_logits, *norm_w, *w_out0, *w_in1, *sinks, *w_out1, *ln_g, *ln_b;
    float* out; unsigned char* ws;
};

__device__ __forceinline__ float bf2f(unsigned short b) { return __uint_as_float(((unsigned)b) << 16); }
__device__ __forceinline__ unsigned short f2bf(float f) { unsigned u = __float_as_uint(f); u += 0x7FFFu + ((u >> 16) & 1u); return (unsigned short)(u >> 16); }
__device__ __forceinline__ unsigned pk2(float lo, float hi) { return pg8::cvt_pk_bf16(lo, hi); }
__device__ __forceinline__ float sigmoidf_(float x) { return __builtin_amdgcn_rcpf(1.0f + __builtin_amdgcn_exp2f(x * -1.44269504089f)); }
__device__ __forceinline__ float siluf_(float x) { return x * __builtin_amdgcn_rcpf(1.0f + __builtin_amdgcn_exp2f(x * -1.44269504089f)); }
#define LDS_WAIT() asm volatile("s_waitcnt lgkmcnt(0)" ::: "memory")

__device__ __forceinline__ const float* xrow_ptr(const Params& p, int row) {
    if (row < MPR) { const int b = row / TP, t = row - b * TP; return t < 16 ? p.meta + (size_t)t * D : p.x_prompt + ((size_t)b * 2048 + (t - 16)) * D; }
    return p.x_sample + (size_t)(row - MPR) * D;
}

__device__ __forceinline__ void p0_transpose_item(const float* __restrict__ W, int K, int N, bf16_t* __restrict__ WT, LAS float* scr, int item, int lane) {
    const int nblk = N / 32, kb = item / nblk, nb = item % nblk, k0 = 64 * kb, n0 = 32 * nb;
    f32x4 wv[8];
#pragma unroll
    for (int i = 0; i < 8; ++i) wv[i] = __builtin_nontemporal_load((const f32x4*)(W + (size_t)(k0 + 8 * i + (lane >> 3)) * N + n0 + 4 * (lane & 7)));
#pragma unroll
    for (int i = 0; i < 8; ++i) { LAS float* d_ = scr + (8 * i + (lane >> 3)) * 33 + 4 * (lane & 7); d_[0] = wv[i].x; d_[1] = wv[i].y; d_[2] = wv[i].z; d_[3] = wv[i].w; }
    LDS_WAIT();
    const int c = lane & 7;
#pragma unroll
    for (int j = 0; j < 4; ++j) { const int n = (lane >> 3) + 8 * j; const LAS float* s = scr + (8 * c) * 33 + n;
        u32x4 o; o.x = pk2(s[0 * 33], s[1 * 33]); o.y = pk2(s[2 * 33], s[3 * 33]); o.z = pk2(s[4 * 33], s[5 * 33]); o.w = pk2(s[6 * 33], s[7 * 33]);
        *(u32x4*)(WT + (size_t)(n0 + n) * K + k0 + 8 * c) = o; }
    LDS_WAIT();
}

__device__ __forceinline__ void phase0(const Params& p, LAS unsigned char* lds) {
    int tid_l = threadIdx.x; asm volatile("" : "+v"(tid_l)); const int tid = tid_l, wave = tid >> 6, lane = tid & 63;
    const int NGW = gridDim.x * 8, gw = wave * gridDim.x + blockIdx.x;
    LAS float* scr = (LAS float*)(lds + wave * 8448);
    constexpr int I0 = 32 * 256;
    bf16_t* WT0 = (bf16_t*)(p.ws + WS_WT0);
    for (int it = gw; it < I0; it += NGW) p0_transpose_item(p.w_in0, 2048, 8192, WT0, scr, it, lane);
    bf16_t* XB = (bf16_t*)(p.ws + WS_XB);
    for (int m = gw; m < MTOT; m += NGW) {
        const f32x4* src = (const f32x4*)xrow_ptr(p, m) + lane; u32x2* dst = (u32x2*)(XB + (size_t)m * D) + lane;
#pragma unroll
        for (int j = 0; j < 8; ++j) { const f32x4 v = __builtin_nontemporal_load(src + 64 * j); u32x2 o; o.x = pk2(v.x, v.y); o.y = pk2(v.z, v.w); dst[64 * j] = o; }
    }
    const int gt = blockIdx.x * 512 + tid, NGT = gridDim.x * 512;
    float* LB = (float*)(p.ws + WS_LB);
    for (int c = gt; c < D; c += NGT) { const float a = p.lb_logits[c], b = p.lb_logits[D + c], cc = p.lb_logits[2 * D + c]; const float m = fmaxf(a, fmaxf(b, cc));
        const float ea = __expf(a - m), eb = __expf(b - m), ec = __expf(cc - m); LB[c] = ea / (ea + eb + ec); }
}
__device__ __forceinline__ void phase0_rest(const Params& p, LAS unsigned char* lds, int li, int nl) {
    int tid_l = threadIdx.x; asm volatile("" : "+v"(tid_l)); const int tid = tid_l, wave = tid >> 6, lane = tid & 63;
    const int gw = li * 8 + wave, NGW = nl * 8;
    LAS float* scr = (LAS float*)(lds + wave * 8448);
    constexpr int I1 = 32 * 64, I2 = 32 * 144, I3 = 32 * 64;
    bf16_t* WTO0 = (bf16_t*)(p.ws + WS_WTO0); bf16_t* WT1 = (bf16_t*)(p.ws + WS_WT1); bf16_t* WTO1 = (bf16_t*)(p.ws + WS_WTO1);
    for (int it = gw; it < I1 + I2 + I3; it += NGW) {
        int r = it;
        if (r < I1) { p0_transpose_item(p.w_out0, 2048, 2048, WTO0, scr, r, lane); continue; } r -= I1;
        if (r < I2) { p0_transpose_item(p.w_in1, 2048, 4608, WT1, scr, r, lane); continue; } r -= I2;
        p0_transpose_item(p.w_out1, 2048, 2048, WTO1, scr, r, lane);
    }
}
__device__ __forceinline__ void phase_cache_shift(const Params& p, int li, int nl) {
    const int gt = li * 512 + threadIdx.x, NGT = nl * 512;
    const f32x4* ck = (const f32x4*)p.cache_k; const f32x4* cv = (const f32x4*)p.cache_v; f32x4* ok = (f32x4*)(p.out + OUT_KS); f32x4* ov = (f32x4*)(p.out + OUT_VS);
    constexpr int PER_B = 120 * 64;
    for (int i0 = gt; i0 < NBS * PER_B; i0 += 4 * NGT) { f32x4 a[4], c[4]; size_t o[4]; bool ok_[4];
#pragma unroll
        for (int u = 0; u < 4; ++u) { const int i = i0 + u * NGT; ok_[u] = i < NBS * PER_B; const int ii = ok_[u] ? i : 0; const int b = ii / PER_B, r = ii - b * PER_B; o[u] = (size_t)b * 8192 + r;
            a[u] = __builtin_nontemporal_load(ck + o[u] + 512); c[u] = __builtin_nontemporal_load(cv + o[u] + 512); }
#pragma unroll
        for (int u = 0; u < 4; ++u) if (ok_[u]) { __builtin_nontemporal_store(a[u], ok + o[u]); __builtin_nontemporal_store(c[u], ov + o[u]); } }
}

struct EpiHgrnIn {
    static constexpr bool PERM = true, AFTER_DRAIN = false;
    unsigned char* ws; float* LF; const float* LB;
    __device__ __forceinline__ void operator()(const f32x4 (&acc)[2][2][4][2], const pg8::Unit& u, int wr, int wc, int fr, int fq) const {
        const int sec = u.pn >> 3, colt = (u.pn & 7) * 256;
        const size_t secoff = sec == 0 ? WS_QB : (sec == 2 ? WS_VB : WS_GB);
        bf16_t* dst = (bf16_t*)(ws + secoff);
        const int row0 = u.pm * 256 + wr * 64 + fr, col0 = colt + wc * 32 + 8 * fq;
        float lb[2][8];
        if (sec == 1) {
#pragma unroll
            for (int bj = 0; bj < 2; ++bj) { const f32x4 a = *(const f32x4*)(LB + col0 + bj * 128), b = *(const f32x4*)(LB + col0 + bj * 128 + 4);
                lb[bj][0] = a.x; lb[bj][1] = a.y; lb[bj][2] = a.z; lb[bj][3] = a.w; lb[bj][4] = b.x; lb[bj][5] = b.y; lb[bj][6] = b.z; lb[bj][7] = b.w; }
        }
#pragma unroll
        for (int ai = 0; ai < 2; ++ai)
#pragma unroll
            for (int m = 0; m < 4; ++m) {
                const int row = row0 + ai * 128 + m * 16; if (row >= MTOT) continue;
#pragma unroll
                for (int bj = 0; bj < 2; ++bj) {
                    const size_t off = (size_t)row * D + col0 + bj * 128;
                    const f32x4 v0 = acc[ai][bj][m][0], v1 = acc[ai][bj][m][1];
                    float x[8] = {v0.x, v0.y, v0.z, v0.w, v1.x, v1.y, v1.z, v1.w};
                    if (sec == 1) {
#pragma unroll
                        for (int j = 0; j < 8; ++j) { const float l = lb[bj][j]; x[j] = l + (1.0f - l) * sigmoidf_(x[j]); }
                        *(f32x4*)(LF + off) = (f32x4){x[0], x[1], x[2], x[3]}; *(f32x4*)(LF + off + 4) = (f32x4){x[4], x[5], x[6], x[7]};
                    } else {
                        if (sec == 3) {
#pragma unroll
                            for (int j = 0; j < 8; ++j) x[j] = siluf_(x[j]);
                        }
                        u32x4 w; w.x = pk2(x[0], x[1]); w.y = pk2(x[2], x[3]); w.z = pk2(x[4], x[5]); w.w = pk2(x[6], x[7]);
                        *(u32x4*)(dst + off) = w;
                    }
                }
            }
    }
};
struct EpiSwaIn {
    static constexpr bool PERM = true, AFTER_DRAIN = false;
    bf16_t* Q; bf16_t* K1; bf16_t* V1; bf16_t* G; float* out;
    __device__ __forceinline__ void operator()(const f32x4 (&acc)[2][2][4][2], const pg8::Unit& u, int wr, int wc, int fr, int fq) const {
        const int pn = u.pn;
        const int row0 = u.pm * 256 + wr * 64 + fr, cw = wc * 32 + 8 * fq;
#pragma unroll
        for (int ai = 0; ai < 2; ++ai)
#pragma unroll
            for (int m = 0; m < 4; ++m) {
                const int row = row0 + ai * 128 + m * 16; if (row >= MTOT) continue;
#pragma unroll
                for (int bj = 0; bj < 2; ++bj) {
                    const f32x4 v0 = acc[ai][bj][m][0], v1 = acc[ai][bj][m][1];
                    float x[8] = {v0.x, v0.y, v0.z, v0.w, v1.x, v1.y, v1.z, v1.w};
                    const int c = cw + bj * 128;
                    if (pn < 8) {
                        constexpr float QS = 0.125f * 1.44269504089f;
                        u32x4 w; w.x = pk2(x[0] * QS, x[1] * QS); w.y = pk2(x[2] * QS, x[3] * QS); w.z = pk2(x[4] * QS, x[5] * QS); w.w = pk2(x[6] * QS, x[7] * QS);
                        *(u32x4*)(Q + (size_t)row * D + pn * 256 + c) = w;
                    } else if (pn >= 10) {
#pragma unroll
                        for (int j = 0; j < 8; ++j) x[j] = siluf_(x[j]);
                        u32x4 w; w.x = pk2(x[0], x[1]); w.y = pk2(x[2], x[3]); w.z = pk2(x[4], x[5]); w.w = pk2(x[6], x[7]);
                        *(u32x4*)(G + (size_t)row * D + (pn - 10) * 256 + c) = w;
                    } else {
                        u32x4 w; w.x = pk2(x[0], x[1]); w.y = pk2(x[2], x[3]); w.z = pk2(x[4], x[5]); w.w = pk2(x[6], x[7]);
                        bf16_t* dst = pn == 8 ? K1 : V1;
                        *(u32x4*)(dst + (size_t)row * 256 + c) = w;
                        float* co = nullptr;
                        if (row < MPR) { const int b = row / TP, t = row - b * TP; if (t >= TP - 128) co = out + (pn == 8 ? OUT_KP : OUT_VP) + ((size_t)b * 128 + (t - (TP - 128))) * 256 + c; }
                        else { const int r = row - MPR, b = r >> 3, t = r & 7; co = out + (pn == 8 ? OUT_KS : OUT_VS) + ((size_t)b * 128 + 120 + t) * 256 + c; }
                        if (co) { __builtin_nontemporal_store(v0, (f32x4*)co); __builtin_nontemporal_store(v1, (f32x4*)(co + 4)); }
                    }
                }
            }
    }
};
constexpr int SPLIT_ROW0 = 8192, SLAB_ROWS = MTOT - 8192;
struct OrderOut {
    pg8::StaticOrder S32; int G, c;
    __device__ void init(int G_, int c_) { S32.init(SPLIT_ROW0, 2048, G_, c_, 2048, 0); G = G_; c = c_; }
    __device__ bool next(int i, pg8::Unit& u) const {
        if (S32.next(i, u)) return true;
        const int R = (256 + G - 1) / G; if (i < R) return false;
        const long j = (long)(i - R) * G + c; if (j >= 160) return false;
        const int un = (int)(j >> 2); u.pm = 32 + (un >> 3); u.pn = un & 7; u.nkt = 8; u.kt0 = 8 * (int)(j & 3); return true;
    }
    __device__ __forceinline__ void a_ready(const pg8::Unit&) const {}
    __device__ __forceinline__ void done(const pg8::Unit&) const {}
};
struct EpiY {
    static constexpr bool PERM = true, AFTER_DRAIN = false;
    bf16_t* Y; float* slab;
    __device__ __forceinline__ void operator()(const f32x4 (&acc)[2][2][4][2], const pg8::Unit& u, int wr, int wc, int fr, int fq) const {
        const int row0 = u.pm * 256 + wr * 64 + fr, col0 = u.pn * 256 + wc * 32 + 8 * fq;
        const bool whole = u.nkt == 32;
        float* sbase = slab + ((size_t)(u.kt0 >> 3) * SLAB_ROWS - SPLIT_ROW0) * D;
#pragma unroll
        for (int ai = 0; ai < 2; ++ai)
#pragma unroll
            for (int m = 0; m < 4; ++m) {
                const int row = row0 + ai * 128 + m * 16; if (row >= MTOT) continue;
#pragma unroll
                for (int bj = 0; bj < 2; ++bj) { const f32x4 v0 = acc[ai][bj][m][0], v1 = acc[ai][bj][m][1]; const size_t off = (size_t)row * D + col0 + bj * 128;
                    if (whole) { u32x4 w; w.x = pk2(v0.x, v0.y); w.y = pk2(v0.z, v0.w); w.z = pk2(v1.x, v1.y); w.w = pk2(v1.z, v1.w); *(u32x4*)(Y + off) = w; }
                    else { *(f32x4*)(sbase + off) = v0; *(f32x4*)(sbase + off + 4) = v1; } }
            }
    }
};

template <int MODE> __device__ __forceinline__ void phase_ln(const Params& p, int layer) {
    int tid_l = threadIdx.x; asm volatile("" : "+v"(tid_l)); const int tid = tid_l, wave = tid >> 6, lane = tid & 63;
    const int NGW = gridDim.x * 8, gw = wave * gridDim.x + blockIdx.x;
    float* ZB = (float*)(p.ws + WS_ZB); bf16_t* XB = (bf16_t*)(p.ws + WS_XB); const bf16_t* YB = (const bf16_t*)(p.ws + WS_VB); const float* SL = (const float*)(p.ws + WS_LF);
    const f32x4* gp = (const f32x4*)(p.ln_g + (size_t)layer * D) + lane; const f32x4* bp = (const f32x4*)(p.ln_b + (size_t)layer * D) + lane;
    f32x4 nv[8]; u32x2 ny[8];
#define LN_LOAD(m_) do { const u32x2* y_ = (const u32x2*)(YB + (size_t)(m_) * D) + lane; \
        if (MODE == 1) { const f32x4* x_ = (const f32x4*)xrow_ptr(p, (m_)) + lane; _Pragma("unroll") for (int j = 0; j < 8; ++j) nv[j] = __builtin_nontemporal_load(x_ + 64 * j); } \
        else { const u32x2* x_ = (const u32x2*)(XB + (size_t)(m_) * D) + lane; _Pragma("unroll") for (int j = 0; j < 8; ++j) { const u32x2 w_ = x_[64 * j]; nv[j] = (f32x4){bf2f((unsigned short)(w_.x & 0xffffu)), bf2f((unsigned short)(w_.x >> 16)), bf2f((unsigned short)(w_.y & 0xffffu)), bf2f((unsigned short)(w_.y >> 16))}; } } \
        if ((m_) < SPLIT_ROW0) { _Pragma("unroll") for (int j = 0; j < 8; ++j) ny[j] = __builtin_nontemporal_load(y_ + 64 * j); } } while (0)
    if (gw < MTOT) LN_LOAD(gw);
    for (int m = gw; m < MTOT; m += NGW) {
        f32x4 v[8]; float s = 0.f;
        if (m < SPLIT_ROW0) {
#pragma unroll
            for (int j = 0; j < 8; ++j) { const f32x4 y = (f32x4){bf2f((unsigned short)(ny[j].x & 0xffffu)), bf2f((unsigned short)(ny[j].x >> 16)), bf2f((unsigned short)(ny[j].y & 0xffffu)), bf2f((unsigned short)(ny[j].y >> 16))}; v[j] = nv[j] * ALPHA + y; }
        } else {
#pragma unroll
            for (int j = 0; j < 8; ++j) v[j] = nv[j] * ALPHA;
            const f32x4* sl = (const f32x4*)(SL + (size_t)(m - SPLIT_ROW0) * D) + lane;
#pragma unroll
            for (int pc = 0; pc < 4; ++pc)
#pragma unroll
                for (int j = 0; j < 8; ++j) v[j] = v[j] + __builtin_nontemporal_load(sl + (size_t)pc * SLAB_ROWS * (D / 4) + 64 * j);
        }
        if (m + NGW < MTOT) LN_LOAD(m + NGW);
#pragma unroll
        for (int j = 0; j < 8; ++j) s += (v[j].x + v[j].y) + (v[j].z + v[j].w);
#pragma unroll
        for (int o = 1; o < 64; o <<= 1) s += __shfl_xor(s, o);
        const float mean = s * (1.0f / D); float s2 = 0.f;
#pragma unroll
        for (int j = 0; j < 8; ++j) { v[j] = v[j] - mean; s2 += (v[j].x * v[j].x + v[j].y * v[j].y) + (v[j].z * v[j].z + v[j].w * v[j].w); }
#pragma unroll
        for (int o = 1; o < 64; o <<= 1) s2 += __shfl_xor(s2, o);
        const float rstd = rsqrtf(s2 * (1.0f / D) + LN_EPS);
        if (MODE == 1) {
            u32x2* xb = (u32x2*)(XB + (size_t)m * D) + lane;
#pragma unroll
            for (int j = 0; j < 8; ++j) { const f32x4 y = v[j] * rstd * gp[64 * j] + bp[64 * j]; u32x2 o; o.x = pk2(y.x, y.y); o.y = pk2(y.z, y.w); xb[64 * j] = o; }
        } else {
            float* dst = nullptr;
            if (m < MPR) { const int b = m / TP, t = m - b * TP; if (t >= 16) dst = p.out + OUT_YP + ((size_t)b * 2048 + (t - 16)) * D; }
            else dst = p.out + OUT_YS + (size_t)(m - MPR) * D;
            if (dst) { f32x4* d4 = (f32x4*)dst + lane;
#pragma unroll
                for (int j = 0; j < 8; ++j) __builtin_nontemporal_store(v[j] * rstd * gp[64 * j] + bp[64 * j], d4 + 64 * j); }
        }
    }
#undef LN_LOAD
}

constexpr int H_QT = 0, H_KT = 17408, H_KTT = 34816, H_VT = 53248, H_AM = 71680, H_S0T = 80896, H_DEC = 115712, H_SEG = 116224;
#define MFMA16(a, b, c) __builtin_amdgcn_mfma_f32_16x16x32_bf16((a), (b), (c), 0, 0, 0)

__device__ __forceinline__ void hgrn_chain(const Params& p, LAS unsigned char* lds, int item, int pass) {
    const int ci = item >> 2, sg = item & 3;
    const int c_begin = sg == 0 ? 0 : 1 + 8 * sg, c_end = 9 + 8 * sg;
    const bool full = pass != 0;
    if (!full && sg == 3) return;
    int tid_l = threadIdx.x; asm volatile("" : "+v"(tid_l)); const int tid = tid_l, w = tid >> 6, lane = tid & 63, r16 = lane & 15, quad = lane >> 4;
    const int kcol = tid & 127, seg = tid >> 7;
    const int b = ci >> 4, h = ci & 15;
    const bf16_t* QB = (const bf16_t*)(p.ws + WS_QB); const float* LF = (const float*)(p.ws + WS_LF); const bf16_t* VB = (const bf16_t*)(p.ws + WS_VB);
    const bf16_t* GB = (const bf16_t*)(p.ws + WS_GB); bf16_t* OB = (bf16_t*)(p.ws + WS_OB);
    const int colbase = h * 128;
    const int tt = w >> 1, vh = w & 1;
    f32x4 S[8];
#pragma unroll
    for (int i = 0; i < 8; ++i) S[i] = (f32x4){0.f, 0.f, 0.f, 0.f};
    f32x4 dprod = (f32x4){1.f, 1.f, 1.f, 1.f};
    float* HU = (float*)(p.ws + WS_HU); float* HD = (float*)(p.ws + WS_HD);
    if (full) {
        for (int j = 0; j < sg; ++j) { const float* U = HU + (size_t)(ci * 4 + j) * 16384; const f32x4 dj = *(const f32x4*)(HD + (ci * 4 + j) * 128 + 16 * w + 4 * quad);
#pragma unroll
            for (int vt = 0; vt < 8; ++vt)
#pragma unroll
                for (int r = 0; r < 4; ++r) S[vt][r] = dj[r] * S[vt][r] + U[(16 * w + 4 * quad + r) * 128 + 16 * vt + r16]; }
#pragma unroll
        for (int vt = 0; vt < 8; ++vt) *(LAS u32x2*)(lds + H_S0T + (16 * vt + r16) * 272 + (16 * w + 4 * quad) * 2) = (u32x2){pk2(S[vt].x, S[vt].y), pk2(S[vt].z, S[vt].w)};
    }
    float lf[16]; unsigned short qr[16], vr[16];
#define HG_LOAD(c_) do { const int t0_ = 64 * (c_); _Pragma("unroll") for (int i = 0; i < 16; ++i) { const int t_ = t0_ + 16 * seg + i; const bool ok_ = t_ < TP; \
        const size_t off_ = ((size_t)(b * TP + (ok_ ? t_ : 0))) * D + colbase + kcol; \
        float l_; unsigned short q_ = 0, v_; if (full) { l_ = __builtin_nontemporal_load(LF + off_); q_ = __builtin_nontemporal_load(QB + off_); v_ = __builtin_nontemporal_load(VB + off_); } else { l_ = LF[off_]; v_ = VB[off_]; } \
        lf[i] = ok_ ? l_ : 1.f; qr[i] = ok_ ? q_ : (unsigned short)0; vr[i] = ok_ ? v_ : (unsigned short)0; } } while (0)
    HG_LOAD(c_begin);
    for (int c = c_begin; c < c_end; ++c) {
        float bl[16]; float run = 1.f;
#pragma unroll
        for (int i = 0; i < 16; ++i) { run *= lf[i]; bl[i] = run; }
        ((LAS float*)(lds + H_SEG))[seg * 128 + kcol] = run;
        __syncthreads();
        float pre = 1.f;
        for (int s = 0; s < seg; ++s) pre *= ((LAS float*)(lds + H_SEG))[s * 128 + kcol];
        unsigned ktp[8], vtp[8]; float eb_last = 1.f;
#pragma unroll
        for (int i = 0; i < 16; i += 2) {
            float kt2[2], qt2[2];
#pragma unroll
            for (int e = 0; e < 2; ++e) { const float eb = pre * bl[i + e], enb = __builtin_amdgcn_rcpf(eb); const float q = bf2f(qr[i + e]); const float kk = 1.0f - lf[i + e];
                qt2[e] = q * eb; kt2[e] = kk * enb; eb_last = eb; }
            ktp[i >> 1] = pk2(kt2[0], kt2[1]); vtp[i >> 1] = (unsigned)vr[i] | ((unsigned)vr[i + 1] << 16);
            if (full) { const unsigned qp = pk2(qt2[0], qt2[1]); const int ts = 16 * seg + i;
                *(LAS unsigned short*)(lds + H_QT + ts * 272 + kcol * 2) = (unsigned short)qp; *(LAS unsigned short*)(lds + H_QT + (ts + 1) * 272 + kcol * 2) = (unsigned short)(qp >> 16);
                *(LAS unsigned short*)(lds + H_KT + ts * 272 + kcol * 2) = (unsigned short)ktp[i >> 1]; *(LAS unsigned short*)(lds + H_KT + (ts + 1) * 272 + kcol * 2) = (unsigned short)(ktp[i >> 1] >> 16); }
        }
        *(LAS u32x4*)(lds + H_KTT + kcol * 144 + seg * 32) = (u32x4){ktp[0], ktp[1], ktp[2], ktp[3]};
        *(LAS u32x4*)(lds + H_KTT + kcol * 144 + seg * 32 + 16) = (u32x4){ktp[4], ktp[5], ktp[6], ktp[7]};
        *(LAS u32x4*)(lds + H_VT + kcol * 144 + seg * 32) = (u32x4){vtp[0], vtp[1], vtp[2], vtp[3]};
        *(LAS u32x4*)(lds + H_VT + kcol * 144 + seg * 32 + 16) = (u32x4){vtp[4], vtp[5], vtp[6], vtp[7]};
        if (seg == 3) ((LAS float*)(lds + H_DEC))[kcol] = eb_last;
        { const int cn = (c + 1 < c_end) ? c + 1 : c; HG_LOAD(cn); }
        __syncthreads();
        const f32x4 dec = *(const LAS f32x4*)(lds + H_DEC + (16 * w + 4 * quad) * 4);
        dprod = dprod * dec;
        if (!full) {
#pragma unroll
            for (int ss = 0; ss < 2; ++ss) { const bf16x8 ka = *(const LAS bf16x8*)(lds + H_KTT + (16 * w + r16) * 144 + (32 * ss + 8 * quad) * 2);
#pragma unroll
                for (int vt = 0; vt < 8; ++vt) { const bf16x8 vb = *(const LAS bf16x8*)(lds + H_VT + (16 * vt + r16) * 144 + (32 * ss + 8 * quad) * 2); S[vt] = MFMA16(ka, vb, S[vt]); } }
#pragma unroll
            for (int vt = 0; vt < 8; ++vt) S[vt] = S[vt] * dec;
        } else {
        const int nt_ = tid >> 3, njj = tid & 7; const int tg = 64 * c + nt_;
        const size_t goff = ((size_t)(tg < TP ? b * TP + tg : MTOT + nt_)) * D + colbase + 16 * njj;
        const u32x4 g0 = __builtin_nontemporal_load((const u32x4*)(GB + goff)), g1 = __builtin_nontemporal_load((const u32x4*)(GB + goff + 8));
        bf16x8 qa[4];
#pragma unroll
        for (int ks = 0; ks < 4; ++ks) qa[ks] = *(const LAS bf16x8*)(lds + H_QT + (16 * tt + r16) * 272 + (32 * ks + 8 * quad) * 2);
        f32x4 O[4];
#pragma unroll
        for (int j = 0; j < 4; ++j) { O[j] = (f32x4){0.f, 0.f, 0.f, 0.f}; const int vt = 4 * vh + j;
#pragma unroll
            for (int ks = 0; ks < 4; ++ks) { const bf16x8 sb = *(const LAS bf16x8*)(lds + H_S0T + (16 * vt + r16) * 272 + (32 * ks + 8 * quad) * 2); O[j] = MFMA16(qa[ks], sb, O[j]); } }
#pragma unroll
        for (int j = 0; j < 2; ++j) { const int st = 2 * vh + j; f32x4 a = (f32x4){0.f, 0.f, 0.f, 0.f};
            if (st <= tt) {
#pragma unroll
                for (int ks = 0; ks < 4; ++ks) { const bf16x8 kb = *(const LAS bf16x8*)(lds + H_KT + (16 * st + r16) * 272 + (32 * ks + 8 * quad) * 2); a = MFMA16(qa[ks], kb, a); } }
#pragma unroll
            for (int r = 0; r < 4; ++r) { const int tl = 16 * tt + 4 * quad + r, sl = 16 * st + r16; const float val = (sl <= tl) ? a[r] : 0.f;
                *(LAS unsigned short*)(lds + H_AM + tl * 144 + sl * 2) = f2bf(val); } }
        __syncthreads();
#pragma unroll
        for (int ss = 0; ss < 2; ++ss) { const bf16x8 aa = *(const LAS bf16x8*)(lds + H_AM + (16 * tt + r16) * 144 + (32 * ss + 8 * quad) * 2);
#pragma unroll
            for (int j = 0; j < 4; ++j) { const int vt = 4 * vh + j; const bf16x8 vb = *(const LAS bf16x8*)(lds + H_VT + (16 * vt + r16) * 144 + (32 * ss + 8 * quad) * 2); O[j] = MFMA16(aa, vb, O[j]); } }
#pragma unroll
        for (int ss = 0; ss < 2; ++ss) { const bf16x8 ka = *(const LAS bf16x8*)(lds + H_KTT + (16 * w + r16) * 144 + (32 * ss + 8 * quad) * 2);
#pragma unroll
            for (int vt = 0; vt < 8; ++vt) { const bf16x8 vb = *(const LAS bf16x8*)(lds + H_VT + (16 * vt + r16) * 144 + (32 * ss + 8 * quad) * 2); S[vt] = MFMA16(ka, vb, S[vt]); } }
#pragma unroll
        for (int vt = 0; vt < 8; ++vt) { S[vt] = S[vt] * dec;
            *(LAS u32x2*)(lds + H_S0T + (16 * vt + r16) * 272 + (16 * w + 4 * quad) * 2) = (u32x2){pk2(S[vt].x, S[vt].y), pk2(S[vt].z, S[vt].w)}; }
#pragma unroll
        for (int j = 0; j < 4; ++j) { const int vt = 4 * vh + j;
#pragma unroll
            for (int r = 0; r < 4; ++r) ((LAS float*)lds)[(16 * tt + 4 * quad + r) * 132 + 16 * vt + r16] = O[j][r]; }
        __syncthreads();
        { const int t = nt_, jj = njj;
          f32x4 o4[4]; float ss = 0.f;
#pragma unroll
          for (int i = 0; i < 4; ++i) { o4[i] = *(const LAS f32x4*)(lds + (t * 132 + 16 * jj + 4 * i) * 4); ss += (o4[i].x * o4[i].x + o4[i].y * o4[i].y) + (o4[i].z * o4[i].z + o4[i].w * o4[i].w); }
          ss += __shfl_xor(ss, 1); ss += __shfl_xor(ss, 2); ss += __shfl_xor(ss, 4);
          const float rstd = rsqrtf(ss * (1.0f / 128.0f) + RMS_EPS);
          { const size_t off = goff;
              const unsigned gw_[8] = {g0.x, g0.y, g0.z, g0.w, g1.x, g1.y, g1.z, g1.w};
              const float* nw = p.norm_w + colbase + 16 * jj;
              unsigned ow[8];
#pragma unroll
              for (int i = 0; i < 4; ++i) { const f32x4 n4 = *(const f32x4*)(nw + 4 * i);
                  const float y0 = o4[i].x * rstd * n4.x * bf2f((unsigned short)(gw_[2 * i] & 0xffffu)), y1 = o4[i].y * rstd * n4.y * bf2f((unsigned short)(gw_[2 * i] >> 16));
                  const float y2 = o4[i].z * rstd * n4.z * bf2f((unsigned short)(gw_[2 * i + 1] & 0xffffu)), y3 = o4[i].w * rstd * n4.w * bf2f((unsigned short)(gw_[2 * i + 1] >> 16));
                  ow[2 * i] = pk2(y0, y1); ow[2 * i + 1] = pk2(y2, y3); }
              *(u32x4*)(OB + off) = (u32x4){ow[0], ow[1], ow[2], ow[3]}; *(u32x4*)(OB + off + 8) = (u32x4){ow[4], ow[5], ow[6], ow[7]}; }
        }
        }
    }
#undef HG_LOAD
    if (!full || sg == 3) {
        float* so = full ? p.out + OUT_SP + ((size_t)(b * 16 + h)) * 16384 : HU + (size_t)item * 16384;
#pragma unroll
        for (int vt = 0; vt < 8; ++vt)
#pragma unroll
            for (int r = 0; r < 4; ++r) { float* d_ = so + (16 * w + 4 * quad + r) * 128 + 16 * vt + r16; if (full) __builtin_nontemporal_store(S[vt][r], d_); else *d_ = S[vt][r]; }
        if (!full && r16 == 0) *(f32x4*)(HD + item * 128 + 16 * w + 4 * quad) = dprod;
    }
    __syncthreads();
}

constexpr int SS_Q = 0, SS_K = 4096, SS_V = 8192, SS_E8 = 12288, SS_A = 12800, SS_B = 13056, SS_QR = 17152, SS_PART = 25600;
struct SampRaw { float lf[2]; unsigned short q[2], v[2]; f32x4 s0[8]; };
__device__ __forceinline__ void hgrn_sample_load(const Params& p, int it, SampRaw& r) {
    int tid_l = threadIdx.x; asm volatile("" : "+v"(tid_l)); const int tid = tid_l, b = it >> 4, h = it & 15;
    const bf16_t* QB = (const bf16_t*)(p.ws + WS_QB); const float* LF = (const float*)(p.ws + WS_LF); const bf16_t* VB = (const bf16_t*)(p.ws + WS_VB);
    const size_t rbase = ((size_t)(MPR + b * 8)) * D + h * 128;
#pragma unroll
    for (int j = 0; j < 2; ++j) { const int rem = tid + 512 * j, t = rem >> 7, k = rem & 127; const size_t o = rbase + (size_t)t * D + k; r.lf[j] = __builtin_nontemporal_load(LF + o); r.q[j] = __builtin_nontemporal_load(QB + o); r.v[j] = __builtin_nontemporal_load(VB + o); }
    { const int v4 = tid & 31, kg = tid >> 5; const float* S0 = p.state + ((size_t)(b * 16 + h)) * 16384;
#pragma unroll
      for (int i = 0; i < 8; ++i) r.s0[i] = __builtin_nontemporal_load((const f32x4*)(S0 + (8 * kg + i) * 128 + 4 * v4)); }
}
__device__ __forceinline__ void hgrn_sample_item(const Params& p, LAS unsigned char* lds, int it, int it_next, SampRaw& raw) {
    int tid_l = threadIdx.x; asm volatile("" : "+v"(tid_l)); const int tid = tid_l, lane = tid & 63;
    const int b = it >> 4, h = it & 15;
    const bf16_t* GB = (const bf16_t*)(p.ws + WS_GB); bf16_t* OB = (bf16_t*)(p.ws + WS_OB);
    const size_t rbase = ((size_t)(MPR + b * 8)) * D + h * 128;
    LAS float* SQ = (LAS float*)(lds + SS_Q); LAS float* SK = (LAS float*)(lds + SS_K); LAS float* SV = (LAS float*)(lds + SS_V); LAS float* SE8 = (LAS float*)(lds + SS_E8);
    LAS float* SA = (LAS float*)(lds + SS_A); LAS float* SB = (LAS float*)(lds + SS_B); LAS float* SQR = (LAS float*)(lds + SS_QR);
    LAS float* PART = (LAS float*)(lds + SS_PART);
    const int v4 = tid & 31, kg = tid >> 5;
    const float* S0 = p.state + ((size_t)(b * 16 + h)) * 16384; float* S1 = p.out + OUT_SS + ((size_t)(b * 16 + h)) * 16384;
    f32x4 s0[8];
#pragma unroll
    for (int i = 0; i < 8; ++i) s0[i] = raw.s0[i];
#pragma unroll
    for (int j = 0; j < 2; ++j) { const int rem = tid + 512 * j; SB[rem] = raw.lf[j]; SQR[rem] = bf2f(raw.q[j]); SV[rem] = bf2f(raw.v[j]); }
    __syncthreads();
    if (it_next < 2048) hgrn_sample_load(p, it_next, raw);
    if (tid < 128) { const int k = tid; float lfv[8], bt[8]; float run = 1.f;
#pragma unroll
        for (int t = 0; t < 8; ++t) { lfv[t] = SB[t * 128 + k]; run *= lfv[t]; bt[t] = run; }
#pragma unroll
        for (int t = 0; t < 8; ++t) { SQ[k * 8 + t] = SQR[t * 128 + k] * bt[t]; SK[k * 8 + t] = (1.0f - lfv[t]) * __builtin_amdgcn_rcpf(bt[t]); }
        SE8[k] = run;
    }
    __syncthreads();
    { const int pair = tid >> 3, ks = tid & 7, t = pair >> 3, s = pair & 7; float a = 0.f;
#pragma unroll
        for (int i = 0; i < 16; ++i) a += SQ[(ks + 8 * i) * 8 + t] * SK[(ks + 8 * i) * 8 + s];
        a += __shfl_xor(a, 1); a += __shfl_xor(a, 2); a += __shfl_xor(a, 4);
        if (ks == 0) SA[pair] = (s <= t) ? a : 0.f; }
    {
        f32x4 vv[8], o[8];
#pragma unroll
        for (int s = 0; s < 8; ++s) { vv[s] = *(const LAS f32x4*)(SV + s * 128 + 4 * v4); o[s] = (f32x4){0.f, 0.f, 0.f, 0.f}; }
#pragma unroll
        for (int i = 0; i < 8; ++i) { const int k = 8 * kg + i;
            const f32x4 qa = *(const LAS f32x4*)(SQ + k * 8), qb = *(const LAS f32x4*)(SQ + k * 8 + 4), ka = *(const LAS f32x4*)(SK + k * 8), kb = *(const LAS f32x4*)(SK + k * 8 + 4);
            const float q8[8] = {qa.x, qa.y, qa.z, qa.w, qb.x, qb.y, qb.z, qb.w}, k8[8] = {ka.x, ka.y, ka.z, ka.w, kb.x, kb.y, kb.z, kb.w};
            f32x4 sn = s0[i];
#pragma unroll
            for (int t = 0; t < 8; ++t) { o[t] = o[t] + s0[i] * q8[t]; sn = sn + vv[t] * k8[t]; }
            __builtin_nontemporal_store(sn * SE8[k], (f32x4*)(S1 + k * 128 + 4 * v4)); }
#pragma unroll
        for (int t = 0; t < 8; ++t) *(LAS f32x4*)(PART + (kg * 8 + t) * 128 + 4 * v4) = o[t];
    }
    __syncthreads();
    { const int t = tid >> 6, vp = lane; f32x2v o2 = (f32x2v){0.f, 0.f};
#pragma unroll
        for (int g = 0; g < 16; ++g) o2 = o2 + *(const LAS f32x2v*)(PART + (g * 8 + t) * 128 + 2 * vp);
#pragma unroll
        for (int s = 0; s < 8; ++s) o2 = o2 + *(const LAS f32x2v*)(SV + s * 128 + 2 * vp) * SA[t * 8 + s];
        float ss = o2.x * o2.x + o2.y * o2.y;
#pragma unroll
        for (int m = 1; m < 64; m <<= 1) ss += __shfl_xor(ss, m);
        const float rstd = rsqrtf(ss * (1.0f / 128.0f) + RMS_EPS);
        const size_t off = rbase + (size_t)t * D + 2 * vp;
        const unsigned g = __builtin_nontemporal_load((const unsigned*)(GB + off)); const f32x2v nw = *(const f32x2v*)(p.norm_w + h * 128 + 2 * vp);
        *(unsigned*)(OB + off) = pk2(o2.x * rstd * nw.x * bf2f((unsigned short)(g & 0xffffu)), o2.y * rstd * nw.y * bf2f((unsigned short)(g >> 16))); }
    __syncthreads();
}

__device__ __forceinline__ void phase_hgrn(const Params& p, LAS unsigned char* lds, const XcdBarrier& xb) {
    const int G = gridDim.x, blk = blockIdx.x;
    const bool early = (G == 256) && ((blk & 3) == 3); constexpr int NEARLY = 64 * 6;
    const int s_lo = (G == 256) ? NEARLY : 0;
    const bool swap = (G == 256) && (((blk >> 2) & 1) != 0);
    for (int stage = 0; stage < 2; ++stage) {
        for (int k = 0; k < 2; ++k) {
            const bool do_chain = (stage == 0) ? (k == 0) : ((k == 0) != swap);
            if (do_chain) { for (int it = blk; it < 256; it += G) hgrn_chain(p, lds, it, stage); }
            else {
                int it, step, end;
                if (stage == 0) { it = early ? (blk >> 2) : 4096; step = 64; end = NEARLY; } else { it = s_lo + blk; step = G; end = 2048; }
                SampRaw raw; if (it < end) hgrn_sample_load(p, it, raw);
                for (; it < end; it += step) hgrn_sample_item(p, lds, it, (it + step < end) ? it + step : 4096, raw);
            }
        }
        if (stage == 0) xcd_barrier(xb);
    }
}

constexpr int A_KS = 0, A_VT = 23040;
constexpr int ATT_PROMPT_ITEMS = NBP * 4 * 65, ATT_ITEMS = ATT_PROMPT_ITEMS + NBS * 4;
struct AttPre { u32x4 r[3][4]; };
__device__ __forceinline__ void attn_load(const Params& p, int it, AttPre& pre) {
    const int tid = threadIdx.x;
    const bf16_t* K1 = (const bf16_t*)(p.ws + WS_K1); const bf16_t* V1 = (const bf16_t*)(p.ws + WS_V1);
    const bool samp = it >= ATT_PROMPT_ITEMS;
    int b, kvh, t0 = 0;
    if (!samp) { b = it / 260; const int rem = it - b * 260; kvh = rem / 65; t0 = 32 * (rem - kvh * 65); } else { const int j = it - ATT_PROMPT_ITEMS; b = j >> 2; kvh = j & 3; }
#pragma unroll
    for (int u = 0; u < 3; ++u) { const int idx = tid + 512 * u;
        const int kA = idx >> 3, cA = idx & 7;
        const int cB = idx / 160, kB = idx - 160 * cB;
        const u32x4 z = (u32x4){0u, 0u, 0u, 0u}; pre.r[u][0] = z; pre.r[u][1] = z; pre.r[u][2] = z; pre.r[u][3] = z;
        if (idx < 1280) {
            if (!samp) { const int pA = t0 - 128 + kA, pB = t0 - 128 + kB;
                if (pA >= 0 && pA < TP) pre.r[u][0] = *(const u32x4*)(K1 + ((size_t)(b * TP + pA)) * 256 + kvh * 64 + 8 * cA);
                if (pB >= 0 && pB < TP) pre.r[u][1] = *(const u32x4*)(V1 + ((size_t)(b * TP + pB)) * 256 + kvh * 64 + 8 * cB); }
            else {
                if (kA < 128) { const size_t o = (((size_t)b * 128 + kA) * 4 + kvh) * 64 + 8 * cA; pre.r[u][0] = *(const u32x4*)(p.cache_k + o); pre.r[u][1] = *(const u32x4*)(p.cache_k + o + 4); }
                else if (kA < 136) pre.r[u][0] = *(const u32x4*)(K1 + ((size_t)(MPR + b * 8 + kA - 128)) * 256 + kvh * 64 + 8 * cA);
                if (kB < 128) { const size_t o = (((size_t)b * 128 + kB) * 4 + kvh) * 64 + 8 * cB; pre.r[u][2] = *(const u32x4*)(p.cache_v + o); pre.r[u][3] = *(const u32x4*)(p.cache_v + o + 4); }
                else if (kB < 136) pre.r[u][2] = *(const u32x4*)(V1 + ((size_t)(MPR + b * 8 + kB - 128)) * 256 + kvh * 64 + 8 * cB);
            }
        } }
}
__device__ __forceinline__ void attn_stage(LAS unsigned char* base, int itp, const AttPre& pre) {
    const int tid = threadIdx.x; const bool samp = itp >= ATT_PROMPT_ITEMS;
#pragma unroll
    for (int u = 0; u < 3; ++u) { const int idx = tid + 512 * u;
        const int kA = idx >> 3, cA = idx & 7, cB = idx / 160, kB = idx - 160 * cB;
        if (idx < 1280) {
            u32x4 kv = pre.r[u][0], vv = samp ? pre.r[u][2] : pre.r[u][1];
            if (samp && kA < 128) { const f32x4 a = __builtin_bit_cast(f32x4, pre.r[u][0]), bq = __builtin_bit_cast(f32x4, pre.r[u][1]); kv = (u32x4){pk2(a.x, a.y), pk2(a.z, a.w), pk2(bq.x, bq.y), pk2(bq.z, bq.w)}; }
            if (samp && kB < 128) { const f32x4 c = __builtin_bit_cast(f32x4, pre.r[u][2]), d = __builtin_bit_cast(f32x4, pre.r[u][3]); vv = (u32x4){pk2(c.x, c.y), pk2(c.z, c.w), pk2(d.x, d.y), pk2(d.z, d.w)}; }
            *(LAS u32x4*)(base + A_KS + kA * 144 + cA * 16) = kv;
            const unsigned vw[4] = {vv.x, vv.y, vv.z, vv.w};
#pragma unroll
            for (int j = 0; j < 4; ++j) { *(LAS unsigned short*)(base + A_VT + (8 * cB + 2 * j) * 336 + kB * 2) = (unsigned short)(vw[j] & 0xffffu);
                *(LAS unsigned short*)(base + A_VT + (8 * cB + 2 * j + 1) * 336 + kB * 2) = (unsigned short)(vw[j] >> 16); }
        } }
}
constexpr int ATT_BUF = 44544;
__device__ __forceinline__ void attn_item(const Params& p, LAS unsigned char* lds_all, int it, int it_n1, int it_n2, int cur, AttPre& pre) {
    int tid_l = threadIdx.x; asm volatile("" : "+v"(tid_l)); const int tid = tid_l, w = tid >> 6, lane = tid & 63, r16 = lane & 15, quad = lane >> 4;
    LAS unsigned char* lds = lds_all + cur * ATT_BUF; LAS unsigned char* ldsn = lds_all + (cur ^ 1) * ATT_BUF;
    const bf16_t* Q1 = (const bf16_t*)(p.ws + WS_QB);
    const bf16_t* GB = (const bf16_t*)(p.ws + WS_GB); bf16_t* OB = (bf16_t*)(p.ws + WS_OB);
    const bool samp = it >= ATT_PROMPT_ITEMS;
    int b, kvh, t0 = 0;
    if (!samp) { b = it / 260; const int rem = it - b * 260; kvh = rem / 65; t0 = 32 * (rem - kvh * 65); } else { const int j = it - ATT_PROMPT_ITEMS; b = j >> 2; kvh = j & 3; }
    const int hq = kvh * 8 + w;
    bf16x8 qf[2][2]; bool qok[2]; size_t qrow[2];
#pragma unroll
    for (int tt = 0; tt < 2; ++tt) { const int i = 16 * tt + r16;
        if (!samp) { const int t = t0 + i; qok[tt] = t < TP; qrow[tt] = (size_t)(b * TP + (qok[tt] ? t : 0)); } else { qok[tt] = i < 8; qrow[tt] = (size_t)(MPR + b * 8 + (qok[tt] ? i : 0)); }
#pragma unroll
        for (int ds = 0; ds < 2; ++ds) { bf16x8 q = __builtin_nontemporal_load((const bf16x8*)(Q1 + qrow[tt] * D + hq * 64 + 32 * ds + 8 * quad)); if (!qok[tt]) q = (bf16x8){0, 0, 0, 0, 0, 0, 0, 0}; qf[tt][ds] = q; } }
    u32x4 gw[4]; size_t orow[4]; bool ook[4];
#pragma unroll
    for (int k = 0; k < 4; ++k) { const int i = 8 * k + (lane >> 3);
        if (!samp) { const int t = t0 + i; ook[k] = t < TP; orow[k] = (size_t)(b * TP + (ook[k] ? t : 0)); } else { ook[k] = i < 8; orow[k] = (size_t)(MPR + b * 8 + (ook[k] ? i : 0)); }
        gw[k] = __builtin_nontemporal_load((const u32x4*)(GB + orow[k] * D + hq * 64 + 8 * (lane & 7))); }
    __syncthreads();
    f32x4 st[10][2];
#pragma unroll
    for (int kt = 0; kt < 10; ++kt) { st[kt][0] = (f32x4){0.f, 0.f, 0.f, 0.f}; st[kt][1] = (f32x4){0.f, 0.f, 0.f, 0.f};
#pragma unroll
        for (int ds = 0; ds < 2; ++ds) { const bf16x8 ka = *(const LAS bf16x8*)(lds + A_KS + (16 * kt + r16) * 144 + (32 * ds + 8 * quad) * 2);
            st[kt][0] = MFMA16(ka, qf[0][ds], st[kt][0]); if (!samp) st[kt][1] = MFMA16(ka, qf[1][ds], st[kt][1]); } }
    const float sink = p.sinks[hq] * 1.44269504089f;
    const int kminv = samp ? 0 : (128 - t0 > 0 ? 128 - t0 : 0);
    const bool midfree = kminv <= 32;
    const int ntt = samp ? 1 : 2;
    bf16x8 pb[5][2]; float inv[2] = {0.f, 0.f};
#pragma unroll
    for (int tt = 0; tt < 2; ++tt) if (tt < ntt) { const int i = 16 * tt + r16; const int lo = (i + 1 > kminv) ? i + 1 : kminv, hi = i + 128;
        float m = -INFINITY;
#pragma unroll
        for (int kt = 0; kt < 10; ++kt) {
            if (kt >= 2 && kt < 8 && midfree) {
#pragma unroll
                for (int r = 0; r < 4; ++r) m = fmaxf(m, st[kt][tt][r]);
            } else {
#pragma unroll
                for (int r = 0; r < 4; ++r) { const int kp = 16 * kt + 4 * quad + r; const float s = (kp >= lo && kp <= hi) ? st[kt][tt][r] : -INFINITY; st[kt][tt][r] = s; m = fmaxf(m, s); }
            } }
        m = fmaxf(m, __shfl_xor(m, 16)); m = fmaxf(m, __shfl_xor(m, 32)); m = fmaxf(m, sink);
        float sum = 0.f;
#pragma unroll
        for (int kt = 0; kt < 10; ++kt)
#pragma unroll
            for (int r = 0; r < 4; ++r) { const float e = __builtin_amdgcn_exp2f(st[kt][tt][r] - m); st[kt][tt][r] = e; sum += e; }
        sum += __shfl_xor(sum, 16); sum += __shfl_xor(sum, 32); sum += __builtin_amdgcn_exp2f(sink - m);
        inv[tt] = __builtin_amdgcn_rcpf(sum);
#pragma unroll
        for (int ks = 0; ks < 5; ++ks) { const f32x4 a = st[2 * ks][tt], c = st[2 * ks + 1][tt];
            const u32x4 pw = (u32x4){pk2(a.x, a.y), pk2(a.z, a.w), pk2(c.x, c.y), pk2(c.z, c.w)}; pb[ks][tt] = __builtin_bit_cast(bf16x8, pw); }
    }
    if (it_n1 < ATT_ITEMS) attn_stage(ldsn, it_n1, pre);
    if (it_n2 < ATT_ITEMS) attn_load(p, it_n2, pre);
    f32x4 o[4][2];
#pragma unroll
    for (int dt = 0; dt < 4; ++dt) { o[dt][0] = (f32x4){0.f, 0.f, 0.f, 0.f}; o[dt][1] = (f32x4){0.f, 0.f, 0.f, 0.f}; }
#pragma unroll
    for (int ks = 0; ks < 5; ++ks)
#pragma unroll
        for (int dt = 0; dt < 4; ++dt) { const u32x2 l8 = *(const LAS u32x2*)(lds + A_VT + (16 * dt + r16) * 336 + (32 * ks + 4 * quad) * 2), h8 = *(const LAS u32x2*)(lds + A_VT + (16 * dt + r16) * 336 + (32 * ks + 16 + 4 * quad) * 2);
            const bf16x8 va = __builtin_bit_cast(bf16x8, (u32x4){l8.x, l8.y, h8.x, h8.y});
            o[dt][0] = MFMA16(va, pb[ks][0], o[dt][0]); if (ntt > 1) o[dt][1] = MFMA16(va, pb[ks][1], o[dt][1]); }
    LAS unsigned char* os = lds_all + 2 * ATT_BUF + w * 4608;
#pragma unroll
    for (int tt = 0; tt < 2; ++tt) if (tt < ntt) {
#pragma unroll
        for (int dt = 0; dt < 4; ++dt) { const f32x4 x = o[dt][tt] * inv[tt];
            *(LAS u32x2*)(os + (16 * tt + r16) * 144 + (16 * dt + 4 * quad) * 2) = (u32x2){pk2(x.x, x.y), pk2(x.z, x.w)}; } }
    LDS_WAIT();
#pragma unroll
    for (int k = 0; k < 4; ++k) if (k < 2 * ntt) { const int i = 8 * k + (lane >> 3);
        const u32x4 ov = *(const LAS u32x4*)(os + i * 144 + (lane & 7) * 16);
        const unsigned ow_[4] = {ov.x, ov.y, ov.z, ov.w}, gg[4] = {gw[k].x, gw[k].y, gw[k].z, gw[k].w}; unsigned rr[4];
#pragma unroll
        for (int j = 0; j < 4; ++j) rr[j] = pk2(__uint_as_float(ow_[j] << 16) * __uint_as_float(gg[j] << 16), __uint_as_float(ow_[j] & 0xffff0000u) * __uint_as_float(gg[j] & 0xffff0000u));
        if (ook[k]) *(u32x4*)(OB + orow[k] * D + hq * 64 + 8 * (lane & 7)) = (u32x4){rr[0], rr[1], rr[2], rr[3]}; }
    LDS_WAIT();
}
__device__ __forceinline__ int att_item_of(int blk, int r, int G) {
    if (G != 256) return blk + r * G;
    const int x = blk & 7, j = blk >> 3;
    if (r < 6) return 256 * r + 32 * x + j;
    return (r == 6 && x == 1 && j < 16) ? 1536 + j : ATT_ITEMS;
}

__global__ void __launch_bounds__(512, 2) fwd_megakernel(Params p) {
    extern __shared__ __attribute__((aligned(16))) unsigned char shm[];
    LAS unsigned char* lds = (LAS unsigned char*)shm;
    const int G = gridDim.x;
    if (threadIdx.x < 4) ((LAS unsigned*)(lds + 131072))[threadIdx.x] = 0u;
    __syncthreads();
    const XcdBarrier xb = xcd_barrier_post((unsigned*)(p.ws + WS_BAR), (volatile LAS unsigned*)(lds + 131072));
    bf16_t* XB = (bf16_t*)(p.ws + WS_XB); bf16_t* OB = (bf16_t*)(p.ws + WS_OB); bf16_t* QB = (bf16_t*)(p.ws + WS_QB); bf16_t* VB = (bf16_t*)(p.ws + WS_VB); bf16_t* GB = (bf16_t*)(p.ws + WS_GB);
    float* ZB = (float*)(p.ws + WS_ZB);
    phase0(p, lds);
    xcd_barrier(xb);
    { pg8::Gemm g{XB, (const bf16_t*)(p.ws + WS_WT0), MPAD, 8192, 2048}; pg8::StaticOrder S; S.init(MPAD, 8192, G, blockIdx.x);
      EpiHgrnIn E{p.ws, (float*)(p.ws + WS_LF), (const float*)(p.ws + WS_LB)};
      pg8::gemm_phase<EpiHgrnIn, pg8::StaticOrder, false>(lds, g, S, E, nullptr);
      const int heavy = (37 * 32) % G; const int li = heavy ? (int)blockIdx.x - heavy : (int)blockIdx.x;
      if (li >= 0) phase0_rest(p, lds, li, heavy ? G - heavy : G); }
    xcd_barrier(xb);
    phase_hgrn(p, lds, xb);
    xcd_barrier(xb);
    { pg8::Gemm g{OB, (const bf16_t*)(p.ws + WS_WTO0), MPAD, 2048, 2048}; OrderOut S; S.init(G, blockIdx.x);
      EpiY E{VB, (float*)(p.ws + WS_LF)};
      pg8::gemm_phase<EpiY, OrderOut, false>(lds, g, S, E, nullptr); }
    xcd_barrier(xb);
    phase_ln<1>(p, 0);
    xcd_barrier(xb);
    { pg8::Gemm g{XB, (const bf16_t*)(p.ws + WS_WT1), MPAD, 4608, 2048}; pg8::StaticOrder S; S.init(MPAD, 4608, G, blockIdx.x);
      EpiSwaIn E{QB, (bf16_t*)(p.ws + WS_K1), (bf16_t*)(p.ws + WS_V1), GB, p.out};
      pg8::gemm_phase<EpiSwaIn, pg8::StaticOrder, false>(lds, g, S, E, nullptr);
      const int heavy = (37 * 18) % G; const int li = heavy ? (int)blockIdx.x - heavy : (int)blockIdx.x;
      if (li >= 0) phase_cache_shift(p, li, heavy ? G - heavy : G); }
    xcd_barrier(xb);
    { AttPre pre; int it = att_item_of(blockIdx.x, 0, G), n1 = att_item_of(blockIdx.x, 1, G);
      if (it < ATT_ITEMS) { attn_load(p, it, pre); attn_stage(lds, it, pre); }
      if (n1 < ATT_ITEMS) attn_load(p, n1, pre);
      for (int r = 0; it < ATT_ITEMS; ++r) { const int n2 = (n1 < ATT_ITEMS) ? att_item_of(blockIdx.x, r + 2, G) : ATT_ITEMS; attn_item(p, lds, it, n1, n2, r & 1, pre); it = n1; n1 = n2; } }
    xcd_barrier(xb);
    { pg8::Gemm g{OB, (const bf16_t*)(p.ws + WS_WTO1), MPAD, 2048, 2048}; OrderOut S; S.init(G, blockIdx.x);
      EpiY E{VB, (float*)(p.ws + WS_LF)};
      pg8::gemm_phase<EpiY, OrderOut, false>(lds, g, S, E, nullptr); }
    xcd_barrier(xb);
    for (int rep = 0; rep < REP_LN; ++rep) phase_ln<2>(p, 1);
}

extern "C" void kernel_launch(void* const* d_in, const int* in_sizes, int n_in, void* d_out, int out_size, void* d_ws, size_t ws_size, hipStream_t stream) {
    static int grid_blocks = 0;
    if (!grid_blocks) {
        int dev = 0, cus = 0, per_cu = 0;
        hipGetDevice(&dev);
        hipDeviceGetAttribute(&cus, hipDeviceAttributeMultiprocessorCount, dev);
        hipFuncSetAttribute((const void*)fwd_megakernel, hipFuncAttributeMaxDynamicSharedMemorySize, LDS_BYTES);
        hipOccupancyMaxActiveBlocksPerMultiprocessor(&per_cu, (const void*)fwd_megakernel, 512, LDS_BYTES);
        if (per_cu < 1) { fprintf(stderr, "kernel_launch: occupancy query reports %d blocks/CU\n", per_cu); per_cu = 1; }
        grid_blocks = cus;
    }
    if (ws_size < WS_END) { fprintf(stderr, "kernel_launch: workspace too small (%zu < %zu)\n", ws_size, (size_t)WS_END); return; }
    Params p{};
    p.x_prompt = (const float*)d_in[0]; p.x_sample = (const float*)d_in[1]; p.state = (const float*)d_in[2]; p.cache_k = (const float*)d_in[3]; p.cache_v = (const float*)d_in[4];
    p.meta = (const float*)d_in[5]; p.w_in0 = (const float*)d_in[6]; p.lb_logits = (const float*)d_in[7]; p.norm_w = (const float*)d_in[8]; p.w_out0 = (const float*)d_in[9];
    p.w_in1 = (const float*)d_in[10]; p.sinks = (const float*)d_in[11]; p.w_out1 = (const float*)d_in[12]; p.ln_g = (const float*)d_in[13]; p.ln_b = (const float*)d_in[14];
    p.out = (float*)d_out; p.ws = (unsigned char*)d_ws;
    if (hipMemsetAsync((char*)d_ws + WS_BAR, 0, 16384, stream) != hipSuccess) { fprintf(stderr, "kernel_launch: memset of the barrier words failed\n"); return; }
    void* args[] = {&p};
    hipError_t e = hipLaunchCooperativeKernel((const void*)fwd_megakernel, dim3(grid_blocks), dim3(512), args, LDS_BYTES, stream);
    if (e != hipSuccess) fprintf(stderr, "cooperative launch failed: %s (grid %d)\n", hipGetErrorString(e), grid_blocks);
}
```

```cpp
#include <hip/hip_runtime.h>
#include <hip/hip_cooperative_groups.h>
#include <cstdio>
#include <cstdint>
namespace pg8 {
#define PG8_LAS __attribute__((address_space(3)))
typedef unsigned short bf16_t;
typedef short bf16x8 __attribute__((ext_vector_type(8)));
typedef float f32x4 __attribute__((ext_vector_type(4)));
typedef unsigned u32x4 __attribute__((ext_vector_type(4)));
constexpr int BM = 256, BK = 64, HALF = 128, HTB = HALF * BK * 2  , STAGE_BYTES = 8 * HTB, NXCD = 8, WGM = 8;

__host__ __device__ __forceinline__ int lds_byte(int r, int c) { const int st = (r >> 4) * 2 + (c >> 5), rr = r & 15, cc = c & 31, ob = rr * 64 + cc * 2; return st * 1024 + (ob ^ (((ob >> 9) & 1) << 5)); }
__host__ __device__ __forceinline__ void stage_rc(int b, int& R, int& C) { const int st = b / 1024, sb = b % 1024, swz = sb ^ (((sb >> 9) & 1) << 5); R = (st >> 1) * 16 + swz / 64; C = (st & 1) * 32 + (swz % 64) / 2; }
__host__ __device__ __forceinline__ int perm32(int rho) { const int n = rho >> 4, i = rho & 15; return 8 * (i >> 2) + 4 * n + (i & 3); }

struct Unit { int pm, pn, kt0, nkt; };
struct Gemm { const bf16_t* A; const bf16_t* Bt; int M, N, K; };

struct StaticOrder {
    int reps = 1;
    int nM, nN, nwg, G, c, nkt, nfull, sk;
    __host__ __device__ void init(int M, int N, int G_, int c_, int K = 2048, int split = 0) { nM = M / BM; nN = N / BM; nwg = nM * nN; G = G_; c = c_; nkt = K / BK; nfull = nwg; sk = 1;
        if (split) { const int R = nwg / G, rem = nwg - R * G; if (rem > 0 && rem * 4 <= G && (nkt % 8) == 0) { nfull = R * G; sk = 4; } } }
    __host__ __device__ bool next(int i, Unit& u) const {
        if (reps > 1) { const int R = (nwg + G - 1) / G; if (i >= R * reps) return false; i = i % R; }
        long L = (long)i * G + c; u.kt0 = 0; u.nkt = nkt;
        if (L >= nfull && sk > 1) { if (L >= nfull + G) return false; const int j = (int)(L - nfull); L = nfull + j / sk; u.nkt = nkt / sk; u.kt0 = (j % sk) * u.nkt; }
        if (L >= nwg) return false;
        int wgid = (int)L; { const int q = nwg / NXCD, r = nwg % NXCD, xcd = wgid % NXCD, off = wgid / NXCD; wgid = (xcd < r ? xcd * (q + 1) : r * (q + 1) + (xcd - r) * q) + off; }
        const int nig = WGM * nN, gid = wgid / nig, fm = gid * WGM, gsz = (nM - fm) < WGM ? (nM - fm) : WGM;
        u.pm = fm + ((wgid % nig) % gsz); u.pn = (wgid % nig) / gsz; return true;
    }
    __device__ __forceinline__ void a_ready(const Unit&) const {}
    __device__ __forceinline__ void done(const Unit&) const {}
};
__device__ __forceinline__ unsigned cvt_pk_bf16(float lo, float hi) { unsigned r; asm volatile("v_cvt_pk_bf16_f32 %0, %1, %2" : "=v"(r) : "v"(lo), "v"(hi)); return r; }
template <class Epi, class Sched, bool STAMP = false>
__device__ __forceinline__ void gemm_phase(PG8_LAS unsigned char* lds, const Gemm g, const Sched& S, const Epi& E, unsigned long long* stamps) {
    int tid_l = threadIdx.x; asm volatile("" : "+v"(tid_l));
    const int tid = tid_l, wid = __builtin_amdgcn_readfirstlane(tid >> 6), lane = tid & 63, wr = wid >> 2, wc = wid & 3, fr = lane & 15, fq = lane >> 4;
    const int K = g.K;
    int ts_lo = 0, ts_hi = 0, nts = 0; const unsigned long long rt_entry = STAMP ? (unsigned long long)wall_clock64() : 0ull;
#define PG8_STAMP() do { if (STAMP && wid == 0 && nts < 64) { const unsigned long long _c = (unsigned long long)clock64(); \
        ts_lo = (lane == nts) ? (int)(unsigned)_c : ts_lo; ts_hi = (lane == nts) ? (int)(unsigned)(_c >> 32) : ts_hi; ++nts; } } while (0)
    PG8_STAMP();
    unsigned voffA[2], voffB[2];
#pragma unroll
    for (int i = 0; i < 2; ++i) { int R, C; stage_rc(tid * 16 + i * 8192, R, C); const int Rb = Epi::PERM ? ((R & ~31) + perm32(R & 31)) : R;
        voffA[i] = (unsigned)(R * K + C) * 2u; voffB[i] = (unsigned)(Rb * K + C) * 2u; }
    const size_t kstep = (size_t)(BK * 2);
    const size_t hstep = (size_t)HALF * K * 2;
    const size_t tstep = 2 * hstep;
    const unsigned ldsw = (unsigned)wid * 1024u;
    const int aoff = lds_byte(wr * 64 + fr, fq * 8), boff = lds_byte(wc * 32 + fr, fq * 8);
#define PG8_SA(b, h) (((b) * 2 + (h)) * HTB)
#define PG8_SB(b, h) ((4 + (b) * 2 + (h)) * HTB)
#define PG8_STAGE(bufoff, gbase, voff) do { _Pragma("unroll") for (int _i = 0; _i < 2; ++_i) \
        __builtin_amdgcn_global_load_lds((const unsigned*)((const char*)(gbase) + (voff)[_i]), (PG8_LAS unsigned*)(lds + (bufoff) + ldsw + _i * 8192), 16, 0, 0); } while (0)
#define PG8_LDA(dst, b, h) do { _Pragma("unroll") for (int m = 0; m < 4; ++m) _Pragma("unroll") for (int k = 0; k < 2; ++k) dst[m][k] = *(const PG8_LAS bf16x8*)(lds + PG8_SA(b, h) + aoff + m * 2048 + k * 1024); } while (0)
#define PG8_LDB(dst, b, h) do { _Pragma("unroll") for (int n = 0; n < 2; ++n) _Pragma("unroll") for (int k = 0; k < 2; ++k) dst[n][k] = *(const PG8_LAS bf16x8*)(lds + PG8_SB(b, h) + boff + n * 2048 + k * 1024); } while (0)
#define PG8_MMA(ai, bj, At, Bt) do { __builtin_amdgcn_s_setprio(1); _Pragma("unroll") for (int m = 0; m < 4; ++m) _Pragma("unroll") for (int n = 0; n < 2; ++n) _Pragma("unroll") for (int k = 0; k < 2; ++k) \
        acc[ai][bj][m][n] = __builtin_amdgcn_mfma_f32_16x16x32_bf16(Bt[n][k], At[m][k], acc[ai][bj][m][n], 0, 0, 0); __builtin_amdgcn_s_setprio(0); } while (0)
#define PG8_WAIT_V(n) asm volatile("s_waitcnt vmcnt(" #n ")" ::: "memory")
#define PG8_WAIT_L(n) asm volatile("s_waitcnt lgkmcnt(" #n ")" ::: "memory")
#define PG8_BAR __builtin_amdgcn_s_barrier()
#define PG8_SCHED __builtin_amdgcn_sched_barrier(0)
    Unit cur, nxt; int ui = 0;
    if (!S.next(0, cur)) return;
    f32x4 acc[2][2][4][2];
#pragma unroll
    for (int a = 0; a < 2; ++a)
#pragma unroll
        for (int b = 0; b < 2; ++b)
#pragma unroll
            for (int m = 0; m < 4; ++m)
#pragma unroll
                for (int n = 0; n < 2; ++n) acc[a][b][m][n] = (f32x4){0.f, 0.f, 0.f, 0.f};
    bf16x8 At[4][2], B0[2][2], B1[2][2];
    const char* cA = (const char*)g.A + (size_t)cur.pm * tstep + (size_t)cur.kt0 * kstep; const char* cB = (const char*)g.Bt + (size_t)cur.pn * tstep + (size_t)cur.kt0 * kstep;
    int nt = cur.nkt;
    S.a_ready(cur);
    PG8_STAGE(PG8_SB(0, 0), cB, voffB); PG8_STAGE(PG8_SB(0, 1), cB + hstep, voffB); PG8_STAGE(PG8_SA(0, 0), cA, voffA); PG8_STAGE(PG8_SA(0, 1), cA + hstep, voffA);
    if (wr == 1) PG8_BAR;
    PG8_WAIT_V(2); PG8_BAR;
    PG8_STAGE(PG8_SB(1, 0), cB + kstep, voffB); PG8_STAGE(PG8_SA(1, 0), cA + kstep, voffA); PG8_STAGE(PG8_SB(1, 1), cB + hstep + kstep, voffB);
    PG8_WAIT_V(6); PG8_BAR;
    PG8_STAMP();
    for (;;) {
        const bool has_next = S.next(ui + 1, nxt);
        const char* nA = has_next ? (const char*)g.A + (size_t)nxt.pm * tstep + (size_t)nxt.kt0 * kstep : cA; const char* nB = has_next ? (const char*)g.Bt + (size_t)nxt.pn * tstep + (size_t)nxt.kt0 * kstep : cB;
        for (int t = 0; t < nt; t += 2) {
            const bool last = (t == nt - 2);
            const char* a1 = cA + (size_t)(t + 1) * kstep;
            const char* a2 = last ? nA : cA + (size_t)(t + 2) * kstep; const char* b2 = last ? nB : cB + (size_t)(t + 2) * kstep;
            const char* a3 = a2 + kstep; const char* b3 = b2 + kstep;
            if (last && has_next) S.a_ready(nxt);
            PG8_LDB(B0, 0, 0); PG8_LDB(B1, 0, 1); PG8_SCHED; PG8_LDA(At, 0, 0); PG8_STAGE(PG8_SA(1, 1), a1 + hstep, voffA);
            PG8_WAIT_V(8); PG8_WAIT_L(0); PG8_BAR; PG8_MMA(0, 0, At, B0); PG8_MMA(0, 1, At, B1); PG8_BAR; PG8_SCHED;
            PG8_LDA(At, 0, 1); PG8_STAGE(PG8_SB(0, 0), b2, voffB); PG8_STAGE(PG8_SB(0, 1), b2 + hstep, voffB); PG8_STAGE(PG8_SA(0, 0), a2, voffA);
            PG8_WAIT_V(8); PG8_WAIT_L(0); PG8_BAR; PG8_MMA(1, 0, At, B0); PG8_MMA(1, 1, At, B1); PG8_BAR; PG8_SCHED;
            PG8_LDB(B0, 1, 0); PG8_LDB(B1, 1, 1); PG8_SCHED; PG8_LDA(At, 1, 0); PG8_STAGE(PG8_SA(0, 1), a2 + hstep, voffA);
            PG8_WAIT_V(8); PG8_WAIT_L(0); PG8_BAR; PG8_MMA(0, 0, At, B0); PG8_MMA(0, 1, At, B1); PG8_BAR; PG8_SCHED;
            PG8_LDA(At, 1, 1); PG8_STAGE(PG8_SB(1, 0), b3, voffB); PG8_STAGE(PG8_SB(1, 1), b3 + hstep, voffB); PG8_STAGE(PG8_SA(1, 0), a3, voffA);
            PG8_WAIT_V(8); PG8_WAIT_L(0); PG8_BAR; PG8_MMA(1, 0, At, B0); PG8_MMA(1, 1, At, B1); PG8_BAR; PG8_SCHED;
        }
        PG8_STAMP();
        if (wr == 0) PG8_BAR;
        if constexpr (!Epi::AFTER_DRAIN) { E(acc, cur, wr, wc, fr, fq); S.done(cur); }
        PG8_STAMP();
        if (!has_next) break;
#pragma unroll
        for (int a = 0; a < 2; ++a)
#pragma unroll
            for (int b = 0; b < 2; ++b)
#pragma unroll
                for (int m = 0; m < 4; ++m)
#pragma unroll
                    for (int n = 0; n < 2; ++n) acc[a][b][m][n] = (f32x4){0.f, 0.f, 0.f, 0.f};
        cur = nxt; cA = nA; cB = nB; ++ui; nt = cur.nkt;
        if (wr == 1) PG8_BAR;
    }
    PG8_WAIT_V(0);
    PG8_BAR;
    if constexpr (Epi::AFTER_DRAIN) { E.fused(acc, cur, wr, wc, fr, fq, lds, wid, lane); S.done(cur); }
    PG8_STAMP();
    if (STAMP && wid == 0) { stamps[lane] = lane < nts ? (((unsigned long long)(unsigned)ts_hi << 32) | (unsigned)ts_lo) : 0ull;
        if (lane == 62) stamps[62] = rt_entry; if (lane == 63) stamps[63] = (unsigned long long)wall_clock64(); }
#undef PG8_STAMP
#undef PG8_SA
#undef PG8_SB
#undef PG8_STAGE
#undef PG8_LDA
#undef PG8_LDB
#undef PG8_MMA
#undef PG8_WAIT_V
#undef PG8_WAIT_L
#undef PG8_BAR
#undef PG8_SCHED
}
}
#define LAS __attribute__((address_space(3)))
#include <vector>

#define XB_TMO      128
#define XB_XCNT(j)  (256  + 64 * (j))
#define XB_XSUB(j)  (1280 + 64 * (j))
#define XB_XGEN(j)  (2304 + 64 * (j))
#define XB_TOP      3328
#define XB_TOPGEN   3392
#define XCD_BAR_WORDS 3456
#define XB_SPIN_CAP (1u << 18)

__device__ __forceinline__ unsigned xb_ld(unsigned* p)              { return __hip_atomic_load(p, __ATOMIC_RELAXED, __HIP_MEMORY_SCOPE_AGENT); }
__device__ __forceinline__ unsigned xb_add(unsigned* p, unsigned v) { return __hip_atomic_fetch_add(p, v, __ATOMIC_RELAXED, __HIP_MEMORY_SCOPE_AGENT); }
__device__ __forceinline__ unsigned xb_xcc_id() { return (unsigned)__builtin_amdgcn_s_getreg((3 << 11) | 20) & 0xFu; }
#define XB_SPIN(cond, bar) do { unsigned _sp = 0; while (cond) { __builtin_amdgcn_s_sleep(1); \
    if ((++_sp & 255u) == 0u) { if (xb_ld(&(bar)[XB_TMO])) break; if (_sp > XB_SPIN_CAP) { atomicAdd(&(bar)[XB_TMO], 1u); break; } } } } while (0)

struct XcdBarrier {
    unsigned* bar; unsigned x;
    volatile LAS unsigned* st;
};

__device__ __forceinline__ XcdBarrier xcd_barrier_post(unsigned* bar, volatile LAS unsigned* st) {
    XcdBarrier b; b.bar = bar; b.x = xb_xcc_id(); b.st = st;
    if (threadIdx.x == 0) (void)xb_add(&bar[XB_XCNT(b.x)], 1u);
    return b;
}
__device__ __forceinline__ void xcd_barrier_complete(unsigned* bar, unsigned x, unsigned& nloc, unsigned& nx) {
    const unsigned G = gridDim.x * gridDim.y * gridDim.z;
    unsigned sum, cnt, mine, sp = 0u;
    for (;;) {
        sum = 0u; cnt = 0u; mine = 0u;
#pragma unroll
        for (unsigned j = 0; j < 16; ++j) { const unsigned c = xb_ld(&bar[XB_XCNT(j)]); sum += c; cnt += (c > 0u) ? 1u : 0u; mine = (j == x) ? c : mine; }
        if (sum == G) break;
        __builtin_amdgcn_s_sleep(1);
        if ((++sp & 255u) == 0u) { if (xb_ld(&bar[XB_TMO])) break; if (sp > XB_SPIN_CAP) { atomicAdd(&bar[XB_TMO], 1u); break; } }
    }
    nloc = mine > 0u ? mine : 1u; nx = cnt > 0u ? cnt : 1u;
}

__device__ __forceinline__ void xcd_barrier(const XcdBarrier& b) {
    asm volatile("s_waitcnt vmcnt(0)" ::: "memory");
    __syncthreads();
    if (threadIdx.x == 0) {
        unsigned* bar = b.bar;
        __builtin_amdgcn_s_waitcnt(0);
        unsigned nloc = b.st[0], nx = b.st[1];
        if (nloc == 0u) { xcd_barrier_complete(bar, b.x, nloc, nx); b.st[0] = nloc; b.st[1] = nx; }
        const unsigned old = xb_add(&bar[XB_XSUB(b.x)], 1u);
        const unsigned gen = old / nloc;
        if (old + 1u == (gen + 1u) * nloc) {
            __builtin_amdgcn_fence(__ATOMIC_RELEASE, "agent");
            asm volatile("s_waitcnt vmcnt(0)" ::: "memory");
            const unsigned og = xb_add(&bar[XB_TOP], 1u);
            const unsigned tg = og / nx;
            if (og + 1u == (tg + 1u) * nx) xb_add(&bar[XB_TOPGEN], 1u);
            else XB_SPIN(xb_ld(&bar[XB_TOPGEN]) == tg, bar);
            __builtin_amdgcn_fence(__ATOMIC_ACQUIRE, "agent");
            xb_add(&bar[XB_XGEN(b.x)], 1u);
            asm volatile("s_waitcnt vmcnt(0)" ::: "memory");
        } else {
            XB_SPIN(xb_ld(&bar[XB_XGEN(b.x)]) == gen, bar);
            __builtin_amdgcn_fence(__ATOMIC_ACQUIRE, "agent");
            asm volatile("s_waitcnt vmcnt(0)" ::: "memory");
        }
    }
    __syncthreads();
}
namespace cg = cooperative_groups;
using pg8::bf16_t; using pg8::bf16x8; using pg8::f32x4; using pg8::u32x4;

typedef unsigned u32x2 __attribute__((ext_vector_type(2)));
typedef float f32x2v __attribute__((ext_vector_type(2)));

constexpr int D = 2048, TP = 2064, NBP = 4, MPR = NBP * TP, NBS = 128, TSM = 8, MSM = NBS * TSM, MTOT = MPR + MSM, MPAD = 9472;
constexpr float ALPHA = 1.41421356237309515f;
#ifndef REP_P0
#define REP_P0 1
#endif
#ifndef REP_HGRN
#define REP_HGRN 1
#endif
#ifndef REP_ATT
#define REP_ATT 1
#endif
#ifndef REP_LN
#define REP_LN 1
#endif
#ifndef REP_G1
#define REP_G1 1
#endif
#ifndef REP_G2
#define REP_G2 1
#endif
constexpr float LN_EPS = 1e-5f, RMS_EPS = 1e-6f;
constexpr int LDS_BYTES = 131072 + 64;
constexpr size_t OUT_YP = 0, OUT_YS = 16777216, OUT_SP = 18874368, OUT_SS = 19922944, OUT_KP = 53477376, OUT_VP = 53608448, OUT_KS = 53739520, OUT_VS = 57933824;
constexpr size_t SZ_BF = (size_t)MPAD * D * 2, SZ_F32 = (size_t)MPAD * D * 4;
constexpr size_t WS_WT0 = 0, WS_WTO0 = WS_WT0 + 33554432, WS_WT1 = WS_WTO0 + 8388608, WS_WTO1 = WS_WT1 + 18874368, WS_XB = WS_WTO1 + 8388608,
                 WS_QB = WS_XB + SZ_BF, WS_VB = WS_QB + SZ_BF, WS_GB = WS_VB + SZ_BF, WS_OB = WS_GB + SZ_BF, WS_LF = WS_OB + SZ_BF, WS_ZB = WS_LF + SZ_F32,
                 WS_K1 = WS_ZB + SZ_F32, WS_V1 = WS_K1 + 4849664, WS_LB = WS_V1 + 4849664, WS_BAR = WS_LB + 8192, WS_HU = WS_BAR + 16384, WS_HD = WS_HU + 256 * 65536, WS_END = WS_HD + 256 * 512;

struct Params {
    const float *x_prompt, *x_sample, *state, *cache_k, *cache_v, *meta, *w_in0, *lb_logits, *norm_w, *w_out0, *w_in1, *sinks, *w_out1, *ln_g, *ln_b;
    float* out; unsigned char* ws;
};

__device__ __forceinline__ float bf2f(unsigned short b) { return __uint_as_float(((unsigned)b) << 16); }
__device__ __forceinline__ unsigned short f2bf(float f) { unsigned u = __float_as_uint(f); u += 0x7FFFu + ((u >> 16) & 1u); return (unsigned short)(u >> 16); }
__device__ __forceinline__ unsigned pk2(float lo, float hi) { return pg8::cvt_pk_bf16(lo, hi); }
__device__ __forceinline__ float sigmoidf_(float x) { return __builtin_amdgcn_rcpf(1.0f + __builtin_amdgcn_exp2f(x * -1.44269504089f)); }
__device__ __forceinline__ float siluf_(float x) { return x * __builtin_amdgcn_rcpf(1.0f + __builtin_amdgcn_exp2f(x * -1.44269504089f)); }
#define LDS_WAIT() asm volatile("s_waitcnt lgkmcnt(0)" ::: "memory")

__device__ __forceinline__ const float* xrow_ptr(const Params& p, int row) {
    if (row < MPR) { const int b = row / TP, t = row - b * TP; return t < 16 ? p.meta + (size_t)t * D : p.x_prompt + ((size_t)b * 2048 + (t - 16)) * D; }
    return p.x_sample + (size_t)(row - MPR) * D;
}

__device__ __forceinline__ void p0_transpose_item(const float* __restrict__ W, int K, int N, bf16_t* __restrict__ WT, LAS float* scr, int item, int lane) {
    const int nblk = N / 32, kb = item / nblk, nb = item % nblk, k0 = 64 * kb, n0 = 32 * nb;
    f32x4 wv[8];
#pragma unroll
    for (int i = 0; i < 8; ++i) wv[i] = __builtin_nontemporal_load((const f32x4*)(W + (size_t)(k0 + 8 * i + (lane >> 3)) * N + n0 + 4 * (lane & 7)));
#pragma unroll
    for (int i = 0; i < 8; ++i) { LAS float* d_ = scr + (8 * i + (lane >> 3)) * 33 + 4 * (lane & 7); d_[0] = wv[i].x; d_[1] = wv[i].y; d_[2] = wv[i].z; d_[3] = wv[i].w; }
    LDS_WAIT();
    const int c = lane & 7;
#pragma unroll
    for (int j = 0; j < 4; ++j) { const int n = (lane >> 3) + 8 * j; const LAS float* s = scr + (8 * c) * 33 + n;
        u32x4 o; o.x = pk2(s[0 * 33], s[1 * 33]); o.y = pk2(s[2 * 33], s[3 * 33]); o.z = pk2(s[4 * 33], s[5 * 33]); o.w = pk2(s[6 * 33], s[7 * 33]);
        *(u32x4*)(WT + (size_t)(n0 + n) * K + k0 + 8 * c) = o; }
    LDS_WAIT();
}

__device__ __forceinline__ void phase0(const Params& p, LAS unsigned char* lds) {
    int tid_l = threadIdx.x; asm volatile("" : "+v"(tid_l)); const int tid = tid_l, wave = tid >> 6, lane = tid & 63;
    const int NGW = gridDim.x * 8, gw = wave * gridDim.x + blockIdx.x;
    LAS float* scr = (LAS float*)(lds + wave * 8448);
    constexpr int I0 = 32 * 256;
    bf16_t* WT0 = (bf16_t*)(p.ws + WS_WT0);
    for (int it = gw; it < I0; it += NGW) p0_transpose_item(p.w_in0, 2048, 8192, WT0, scr, it, lane);
    bf16_t* XB = (bf16_t*)(p.ws + WS_XB);
    for (int m = gw; m < MTOT; m += NGW) {
        const f32x4* src = (const f32x4*)xrow_ptr(p, m) + lane; u32x2* dst = (u32x2*)(XB + (size_t)m * D) + lane;
#pragma unroll
        for (int j = 0; j < 8; ++j) { const f32x4 v = __builtin_nontemporal_load(src + 64 * j); u32x2 o; o.x = pk2(v.x, v.y); o.y = pk2(v.z, v.w); dst[64 * j] = o; }
    }
    const int gt = blockIdx.x * 512 + tid, NGT = gridDim.x * 512;
    float* LB = (float*)(p.ws + WS_LB);
    for (int c = gt; c < D; c += NGT) { const float a = p.lb_logits[c], b = p.lb_logits[D + c], cc = p.lb_logits[2 * D + c]; const float m = fmaxf(a, fmaxf(b, cc));
        const float ea = __expf(a - m), eb = __expf(b - m), ec = __expf(cc - m); LB[c] = ea / (ea + eb + ec); }
}
__device__ __forceinline__ void phase0_rest(const Params& p, LAS unsigned char* lds, int li, int nl) {
    int tid_l = threadIdx.x; asm volatile("" : "+v"(tid_l)); const int tid = tid_l, wave = tid >> 6, lane = tid & 63;
    const int gw = li * 8 + wave, NGW = nl * 8;
    LAS float* scr = (LAS float*)(lds + wave * 8448);
    constexpr int I1 = 32 * 64, I2 = 32 * 144, I3 = 32 * 64;
    bf16_t* WTO0 = (bf16_t*)(p.ws + WS_WTO0); bf16_t* WT1 = (bf16_t*)(p.ws + WS_WT1); bf16_t* WTO1 = (bf16_t*)(p.ws + WS_WTO1);
    for (int it = gw; it < I1 + I2 + I3; it += NGW) {
        int r = it;
        if (r < I1) { p0_transpose_item(p.w_out0, 2048, 2048, WTO0, scr, r, lane); continue; } r -= I1;
        if (r < I2) { p0_transpose_item(p.w_in1, 2048, 4608, WT1, scr, r, lane); continue; } r -= I2;
        p0_transpose_item(p.w_out1, 2048, 2048, WTO1, scr, r, lane);
    }
}
__device__ __forceinline__ void phase_cache_shift(const Params& p, int li, int nl) {
    const int gt = li * 512 + threadIdx.x, NGT = nl * 512;
    const f32x4* ck = (const f32x4*)p.cache_k; const f32x4* cv = (const f32x4*)p.cache_v; f32x4* ok = (f32x4*)(p.out + OUT_KS); f32x4* ov = (f32x4*)(p.out + OUT_VS);
    constexpr int PER_B = 120 * 64;
    for (int i0 = gt; i0 < NBS * PER_B; i0 += 4 * NGT) { f32x4 a[4], c[4]; size_t o[4]; bool ok_[4];
#pragma unroll
        for (int u = 0; u < 4; ++u) { const int i = i0 + u * NGT; ok_[u] = i < NBS * PER_B; const int ii = ok_[u] ? i : 0; const int b = ii / PER_B, r = ii - b * PER_B; o[u] = (size_t)b * 8192 + r;
            a[u] = __builtin_nontemporal_load(ck + o[u] + 512); c[u] = __builtin_nontemporal_load(cv + o[u] + 512); }
#pragma unroll
        for (int u = 0; u < 4; ++u) if (ok_[u]) { __builtin_nontemporal_store(a[u], ok + o[u]); __builtin_nontemporal_store(c[u], ov + o[u]); } }
}

struct EpiHgrnIn {
    static constexpr bool PERM = true, AFTER_DRAIN = false;
    unsigned char* ws; float* LF; const float* LB;
    __device__ __forceinline__ void operator()(const f32x4 (&acc)[2][2][4][2], const pg8::Unit& u, int wr, int wc, int fr, int fq) const {
        const int sec = u.pn >> 3, colt = (u.pn & 7) * 256;
        const size_t secoff = sec == 0 ? WS_QB : (sec == 2 ? WS_VB : WS_GB);
        bf16_t* dst = (bf16_t*)(ws + secoff);
        const int row0 = u.pm * 256 + wr * 64 + fr, col0 = colt + wc * 32 + 8 * fq;
        float lb[2][8];
        if (sec == 1) {
#pragma unroll
            for (int bj = 0; bj < 2; ++bj) { const f32x4 a = *(const f32x4*)(LB + col0 + bj * 128), b = *(const f32x4*)(LB + col0 + bj * 128 + 4);
                lb[bj][0] = a.x; lb[bj][1] = a.y; lb[bj][2] = a.z; lb[bj][3] = a.w; lb[bj][4] = b.x; lb[bj][5] = b.y; lb[bj][6] = b.z; lb[bj][7] = b.w; }
        }
#pragma unroll
        for (int ai = 0; ai < 2; ++ai)
#pragma unroll
            for (int m = 0; m < 4; ++m) {
                const int row = row0 + ai * 128 + m * 16; if (row >= MTOT) continue;
#pragma unroll
                for (int bj = 0; bj < 2; ++bj) {
                    const size_t off = (size_t)row * D + col0 + bj * 128;
                    const f32x4 v0 = acc[ai][bj][m][0], v1 = acc[ai][bj][m][1];
                    float x[8] = {v0.x, v0.y, v0.z, v0.w, v1.x, v1.y, v1.z, v1.w};
                    if (sec == 1) {
#pragma unroll
                        for (int j = 0; j < 8; ++j) { const float l = lb[bj][j]; x[j] = l + (1.0f - l) * sigmoidf_(x[j]); }
                        *(f32x4*)(LF + off) = (f32x4){x[0], x[1], x[2], x[3]}; *(f32x4*)(LF + off + 4) = (f32x4){x[4], x[5], x[6], x[7]};
                    } else {
                        if (sec == 3) {
#pragma unroll
                            for (int j = 0; j < 8; ++j) x[j] = siluf_(x[j]);
                        }
                        u32x4 w; w.x = pk2(x[0], x[1]); w.y = pk2(x[2], x[3]); w.z = pk2(x[4], x[5]); w.w = pk2(x[6], x[7]);
                        *(u32x4*)(dst + off) = w;
                    }
                }
            }
    }
};
struct EpiSwaIn {
    static constexpr bool PERM = true, AFTER_DRAIN = false;
    bf16_t* Q; bf16_t* K1; bf16_t* V1; bf16_t* G; float* out;
    __device__ __forceinline__ void operator()(const f32x4 (&acc)[2][2][4][2], const pg8::Unit& u, int wr, int wc, int fr, int fq) const {
        const int pn = u.pn;
        const int row0 = u.pm * 256 + wr * 64 + fr, cw = wc * 32 + 8 * fq;
#pragma unroll
        for (int ai = 0; ai < 2; ++ai)
#pragma unroll
            for (int m = 0; m < 4; ++m) {
                const int row = row0 + ai * 128 + m * 16; if (row >= MTOT) continue;
#pragma unroll
                for (int bj = 0; bj < 2; ++bj) {
                    const f32x4 v0 = acc[ai][bj][m][0], v1 = acc[ai][bj][m][1];
                    float x[8] = {v0.x, v0.y, v0.z, v0.w, v1.x, v1.y, v1.z, v1.w};
                    const int c = cw + bj * 128;
                    if (pn < 8) {
                        constexpr float QS = 0.125f * 1.44269504089f;
                        u32x4 w; w.x = pk2(x[0] * QS, x[1] * QS); w.y = pk2(x[2] * QS, x[3] * QS); w.z = pk2(x[4] * QS, x[5] * QS); w.w = pk2(x[6] * QS, x[7] * QS);
                        *(u32x4*)(Q + (size_t)row * D + pn * 256 + c) = w;
                    } else if (pn >= 10) {
#pragma unroll
                        for (int j = 0; j < 8; ++j) x[j] = siluf_(x[j]);
                        u32x4 w; w.x = pk2(x[0], x[1]); w.y = pk2(x[2], x[3]); w.z = pk2(x[4], x[5]); w.w = pk2(x[6], x[7]);
                        *(u32x4*)(G + (size_t)row * D + (pn - 10) * 256 + c) = w;
                    } else {
                        u32x4 w; w.x = pk2(x[0], x[1]); w.y = pk2(x[2], x[3]); w.z = pk2(x[4], x[5]); w.w = pk2(x[6], x[7]);
                        bf16_t* dst = pn == 8 ? K1 : V1;
                        *(u32x4*)(dst + (size_t)row * 256 + c) = w;
                        float* co = nullptr;
                        if (row < MPR) { const int b = row / TP, t = row - b * TP; if (t >= TP - 128) co = out + (pn == 8 ? OUT_KP : OUT_VP) + ((size_t)b * 128 + (t - (TP - 128))) * 256 + c; }
                        else { const int r = row - MPR, b = r >> 3, t = r & 7; co = out + (pn == 8 ? OUT_KS : OUT_VS) + ((size_t)b * 128 + 120 + t) * 256 + c; }
                        if (co) { __builtin_nontemporal_store(v0, (f32x4*)co); __builtin_nontemporal_store(v1, (f32x4*)(co + 4)); }
                    }
                }
            }
    }
};
constexpr int SPLIT_ROW0 = 8192, SLAB_ROWS = MTOT - 8192;
struct OrderOut {
    pg8::StaticOrder S32; int G, c;
    __device__ void init(int G_, int c_) { S32.init(SPLIT_ROW0, 2048, G_, c_, 2048, 0); G = G_; c = c_; }
    __device__ bool next(int i, pg8::Unit& u) const {
        if (S32.next(i, u)) return true;
        const int R = (256 + G - 1) / G; if (i < R) return false;
        const long j = (long)(i - R) * G + c; if (j >= 160) return false;
        const int un = (int)(j >> 2); u.pm = 32 + (un >> 3); u.pn = un & 7; u.nkt = 8; u.kt0 = 8 * (int)(j & 3); return true;
    }
    __device__ __forceinline__ void a_ready(const pg8::Unit&) const {}
    __device__ __forceinline__ void done(const pg8::Unit&) const {}
};
struct EpiY {
    static constexpr bool PERM = true, AFTER_DRAIN = false;
    bf16_t* Y; float* slab;
    __device__ __forceinline__ void operator()(const f32x4 (&acc)[2][2][4][2], const pg8::Unit& u, int wr, int wc, int fr, int fq) const {
        const int row0 = u.pm * 256 + wr * 64 + fr, col0 = u.pn * 256 + wc * 32 + 8 * fq;
        const bool whole = u.nkt == 32;
        float* sbase = slab + ((size_t)(u.kt0 >> 3) * SLAB_ROWS - SPLIT_ROW0) * D;
#pragma unroll
        for (int ai = 0; ai < 2; ++ai)
#pragma unroll
            for (int m = 0; m < 4; ++m) {
                const int row = row0 + ai * 128 + m * 16; if (row >= MTOT) continue;
#pragma unroll
                for (int bj = 0; bj < 2; ++bj) { const f32x4 v0 = acc[ai][bj][m][0], v1 = acc[ai][bj][m][1]; const size_t off = (size_t)row * D + col0 + bj * 128;
                    if (whole) { u32x4 w; w.x = pk2(v0.x, v0.y); w.y = pk2(v0.z, v0.w); w.z = pk2(v1.x, v1.y); w.w = pk2(v1.z, v1.w); *(u32x4*)(Y + off) = w; }
                    else { *(f32x4*)(sbase + off) = v0; *(f32x4*)(sbase + off + 4) = v1; } }
            }
    }
};

template <int MODE> __device__ __forceinline__ void phase_ln(const Params& p, int layer) {
    int tid_l = threadIdx.x; asm volatile("" : "+v"(tid_l)); const int tid = tid_l, wave = tid >> 6, lane = tid & 63;
    const int NGW = gridDim.x * 8, gw = wave * gridDim.x + blockIdx.x;
    float* ZB = (float*)(p.ws + WS_ZB); bf16_t* XB = (bf16_t*)(p.ws + WS_XB); const bf16_t* YB = (const bf16_t*)(p.ws + WS_VB); const float* SL = (const float*)(p.ws + WS_LF);
    const f32x4* gp = (const f32x4*)(p.ln_g + (size_t)layer * D) + lane; const f32x4* bp = (const f32x4*)(p.ln_b + (size_t)layer * D) + lane;
    f32x4 nv[8]; u32x2 ny[8];
#define LN_LOAD(m_) do { const u32x2* y_ = (const u32x2*)(YB + (size_t)(m_) * D) + lane; \
        if (MODE == 1) { const f32x4* x_ = (const f32x4*)xrow_ptr(p, (m_)) + lane; _Pragma("unroll") for (int j = 0; j < 8; ++j) nv[j] = __builtin_nontemporal_load(x_ + 64 * j); } \
        else { const u32x2* x_ = (const u32x2*)(XB + (size_t)(m_) * D) + lane; _Pragma("unroll") for (int j = 0; j < 8; ++j) { const u32x2 w_ = x_[64 * j]; nv[j] = (f32x4){bf2f((unsigned short)(w_.x & 0xffffu)), bf2f((unsigned short)(w_.x >> 16)), bf2f((unsigned short)(w_.y & 0xffffu)), bf2f((unsigned short)(w_.y >> 16))}; } } \
        if ((m_) < SPLIT_ROW0) { _Pragma("unroll") for (int j = 0; j < 8; ++j) ny[j] = __builtin_nontemporal_load(y_ + 64 * j); } } while (0)
    if (gw < MTOT) LN_LOAD(gw);
    for (int m = gw; m < MTOT; m += NGW) {
        f32x4 v[8]; float s = 0.f;
        if (m < SPLIT_ROW0) {
#pragma unroll
            for (int j = 0; j < 8; ++j) { const f32x4 y = (f32x4){bf2f((unsigned short)(ny[j].x & 0xffffu)), bf2f((unsigned short)(ny[j].x >> 16)), bf2f((unsigned short)(ny[j].y & 0xffffu)), bf2f((unsigned short)(ny[j].y >> 16))}; v[j] = nv[j] * ALPHA + y; }
        } else {
#pragma unroll
            for (int j = 0; j < 8; ++j) v[j] = nv[j] * ALPHA;
            const f32x4* sl = (const f32x4*)(SL + (size_t)(m - SPLIT_ROW0) * D) + lane;
#pragma unroll
            for (int pc = 0; pc < 4; ++pc)
#pragma unroll
                for (int j = 0; j < 8; ++j) v[j] = v[j] + __builtin_nontemporal_load(sl + (size_t)pc * SLAB_ROWS * (D / 4) + 64 * j);
        }
        if (m + NGW < MTOT) LN_LOAD(m + NGW);
#pragma unroll
        for (int j = 0; j < 8; ++j) s += (v[j].x + v[j].y) + (v[j].z + v[j].w);
#pragma unroll
        for (int o = 1; o < 64; o <<= 1) s += __shfl_xor(s, o);
        const float mean = s * (1.0f / D); float s2 = 0.f;
#pragma unroll
        for (int j = 0; j < 8; ++j) { v[j] = v[j] - mean; s2 += (v[j].x * v[j].x + v[j].y * v[j].y) + (v[j].z * v[j].z + v[j].w * v[j].w); }
#pragma unroll
        for (int o = 1; o < 64; o <<= 1) s2 += __shfl_xor(s2, o);
        const float rstd = rsqrtf(s2 * (1.0f / D) + LN_EPS);
        if (MODE == 1) {
            u32x2* xb = (u32x2*)(XB + (size_t)m * D) + lane;
#pragma unroll
            for (int j = 0; j < 8; ++j) { const f32x4 y = v[j] * rstd * gp[64 * j] + bp[64 * j]; u32x2 o; o.x = pk2(y.x, y.y); o.y = pk2(y.z, y.w); xb[64 * j] = o; }
        } else {
            float* dst = nullptr;
            if (m < MPR) { const int b = m / TP, t = m - b * TP; if (t >= 16) dst = p.out + OUT_YP + ((size_t)b * 2048 + (t - 16)) * D; }
            else dst = p.out + OUT_YS + (size_t)(m - MPR) * D;
            if (dst) { f32x4* d4 = (f32x4*)dst + lane;
#pragma unroll
                for (int j = 0; j < 8; ++j) __builtin_nontemporal_store(v[j] * rstd * gp[64 * j] + bp[64 * j], d4 + 64 * j); }
        }
    }
#undef LN_LOAD
}

constexpr int H_QT = 0, H_KT = 17408, H_KTT = 34816, H_VT = 53248, H_AM = 71680, H_S0T = 80896, H_DEC = 115712, H_SEG = 116224;
#define MFMA16(a, b, c) __builtin_amdgcn_mfma_f32_16x16x32_bf16((a), (b), (c), 0, 0, 0)

__device__ __forceinline__ void hgrn_chain(const Params& p, LAS unsigned char* lds, int item, int pass) {
    const int ci = item >> 2, sg = item & 3;
    const int c_begin = sg == 0 ? 0 : 1 + 8 * sg, c_end = 9 + 8 * sg;
    const bool full = pass != 0;
    if (!full && sg == 3) return;
    int tid_l = threadIdx.x; asm volatile("" : "+v"(tid_l)); const int tid = tid_l, w = tid >> 6, lane = tid & 63, r16 = lane & 15, quad = lane >> 4;
    const int kcol = tid & 127, seg = tid >> 7;
    const int b = ci >> 4, h = ci & 15;
    const bf16_t* QB = (const bf16_t*)(p.ws + WS_QB); const float* LF = (const float*)(p.ws + WS_LF); const bf16_t* VB = (const bf16_t*)(p.ws + WS_VB);
    const bf16_t* GB = (const bf16_t*)(p.ws + WS_GB); bf16_t* OB = (bf16_t*)(p.ws + WS_OB);
    const int colbase = h * 128;
    const int tt = w >> 1, vh = w & 1;
    f32x4 S[8];
#pragma unroll
    for (int i = 0; i < 8; ++i) S[i] = (f32x4){0.f, 0.f, 0.f, 0.f};
    f32x4 dprod = (f32x4){1.f, 1.f, 1.f, 1.f};
    float* HU = (float*)(p.ws + WS_HU); float* HD = (float*)(p.ws + WS_HD);
    if (full) {
        for (int j = 0; j < sg; ++j) { const float* U = HU + (size_t)(ci * 4 + j) * 16384; const f32x4 dj = *(const f32x4*)(HD + (ci * 4 + j) * 128 + 16 * w + 4 * quad);
#pragma unroll
            for (int vt = 0; vt < 8; ++vt)
#pragma unroll
                for (int r = 0; r < 4; ++r) S[vt][r] = dj[r] * S[vt][r] + U[(16 * w + 4 * quad + r) * 128 + 16 * vt + r16]; }
#pragma unroll
        for (int vt = 0; vt < 8; ++vt) *(LAS u32x2*)(lds + H_S0T + (16 * vt + r16) * 272 + (16 * w + 4 * quad) * 2) = (u32x2){pk2(S[vt].x, S[vt].y), pk2(S[vt].z, S[vt].w)};
    }
    float lf[16]; unsigned short qr[16], vr[16];
#define HG_LOAD(c_) do { const int t0_ = 64 * (c_); _Pragma("unroll") for (int i = 0; i < 16; ++i) { const int t_ = t0_ + 16 * seg + i; const bool ok_ = t_ < TP; \
        const size_t off_ = ((size_t)(b * TP + (ok_ ? t_ : 0))) * D + colbase + kcol; \
        float l_; unsigned short q_ = 0, v_; if (full) { l_ = __builtin_nontemporal_load(LF + off_); q_ = __builtin_nontemporal_load(QB + off_); v_ = __builtin_nontemporal_load(VB + off_); } else { l_ = LF[off_]; v_ = VB[off_]; } \
        lf[i] = ok_ ? l_ : 1.f; qr[i] = ok_ ? q_ : (unsigned short)0; vr[i] = ok_ ? v_ : (unsigned short)0; } } while (0)
    f32x4 nw4[4];
#pragma unroll
    for (int i = 0; i < 4; ++i) nw4[i] = *(const f32x4*)(p.norm_w + colbase + 16 * (tid & 7) + 4 * i);
    HG_LOAD(c_begin);
    for (int c = c_begin; c < c_end; ++c) {
        float bl[16]; float run = 1.f;
#pragma unroll
        for (int i = 0; i < 16; ++i) { run *= lf[i]; bl[i] = run; }
        ((LAS float*)(lds + H_SEG))[seg * 128 + kcol] = run;
        __syncthreads();
        float pre = 1.f;
        for (int s = 0; s < seg; ++s) pre *= ((LAS float*)(lds + H_SEG))[s * 128 + kcol];
        unsigned ktp[8], vtp[8]; float eb_last = 1.f;
#pragma unroll
        for (int i = 0; i < 16; i += 2) {
            float kt2[2], qt2[2];
#pragma unroll
            for (int e = 0; e < 2; ++e) { const float eb = pre * bl[i + e], enb = __builtin_amdgcn_rcpf(eb); const float q = bf2f(qr[i + e]); const float kk = 1.0f - lf[i + e];
                qt2[e] = q * eb; kt2[e] = kk * enb; eb_last = eb; }
            ktp[i >> 1] = pk2(kt2[0], kt2[1]); vtp[i >> 1] = (unsigned)vr[i] | ((unsigned)vr[i + 1] << 16);
            if (full) { const unsigned qp = pk2(qt2[0], qt2[1]); const int ts = 16 * seg + i;
                *(LAS unsigned short*)(lds + H_QT + ts * 272 + kcol * 2) = (unsigned short)qp; *(LAS unsigned short*)(lds + H_QT + (ts + 1) * 272 + kcol * 2) = (unsigned short)(qp >> 16);
                *(LAS unsigned short*)(lds + H_KT + ts * 272 + kcol * 2) = (unsigned short)ktp[i >> 1]; *(LAS unsigned short*)(lds + H_KT + (ts + 1) * 272 + kcol * 2) = (unsigned short)(ktp[i >> 1] >> 16); }
        }
        *(LAS u32x4*)(lds + H_KTT + kcol * 144 + seg * 32) = (u32x4){ktp[0], ktp[1], ktp[2], ktp[3]};
        *(LAS u32x4*)(lds + H_KTT + kcol * 144 + seg * 32 + 16) = (u32x4){ktp[4], ktp[5], ktp[6], ktp[7]};
        *(LAS u32x4*)(lds + H_VT + kcol * 144 + seg * 32) = (u32x4){vtp[0], vtp[1], vtp[2], vtp[3]};
        *(LAS u32x4*)(lds + H_VT + kcol * 144 + seg * 32 + 16) = (u32x4){vtp[4], vtp[5], vtp[6], vtp[7]};
        if (seg == 3) ((LAS float*)(lds + H_DEC))[kcol] = eb_last;
        { const int cn = (c + 1 < c_end) ? c + 1 : c; HG_LOAD(cn); }
        __syncthreads();
        const f32x4 dec = *(const LAS f32x4*)(lds + H_DEC + (16 * w + 4 * quad) * 4);
        dprod = dprod * dec;
        if (!full) {
#pragma unroll
            for (int ss = 0; ss < 2; ++ss) { const bf16x8 ka = *(const LAS bf16x8*)(lds + H_KTT + (16 * w + r16) * 144 + (32 * ss + 8 * quad) * 2);
#pragma unroll
                for (int vt = 0; vt < 8; ++vt) { const bf16x8 vb = *(const LAS bf16x8*)(lds + H_VT + (16 * vt + r16) * 144 + (32 * ss + 8 * quad) * 2); S[vt] = MFMA16(ka, vb, S[vt]); } }
#pragma unroll
            for (int vt = 0; vt < 8; ++vt) S[vt] = S[vt] * dec;
        } else {
        const int nt_ = tid >> 3, njj = tid & 7; const int tg = 64 * c + nt_;
        const size_t goff = ((size_t)(tg < TP ? b * TP + tg : MTOT + nt_)) * D + colbase + 16 * njj;
        const u32x4 g0 = __builtin_nontemporal_load((const u32x4*)(GB + goff)), g1 = __builtin_nontemporal_load((const u32x4*)(GB + goff + 8));
        bf16x8 qa[4];
#pragma unroll
        for (int ks = 0; ks < 4; ++ks) qa[ks] = *(const LAS bf16x8*)(lds + H_QT + (16 * tt + r16) * 272 + (32 * ks + 8 * quad) * 2);
        f32x4 O[4];
#pragma unroll
        for (int j = 0; j < 4; ++j) { O[j] = (f32x4){0.f, 0.f, 0.f, 0.f}; const int vt = 4 * vh + j;
#pragma unroll
            for (int ks = 0; ks < 4; ++ks) { const bf16x8 sb = *(const LAS bf16x8*)(lds + H_S0T + (16 * vt + r16) * 272 + (32 * ks + 8 * quad) * 2); O[j] = MFMA16(qa[ks], sb, O[j]); } }
#pragma unroll
        for (int j = 0; j < 2; ++j) { const int st = 2 * vh + j; f32x4 a = (f32x4){0.f, 0.f, 0.f, 0.f};
            if (st <= tt) {
#pragma unroll
                for (int ks = 0; ks < 4; ++ks) { const bf16x8 kb = *(const LAS bf16x8*)(lds + H_KT + (16 * st + r16) * 272 + (32 * ks + 8 * quad) * 2); a = MFMA16(qa[ks], kb, a); } }
#pragma unroll
            for (int r = 0; r < 4; ++r) { const int tl = 16 * tt + 4 * quad + r, sl = 16 * st + r16; const float val = (sl <= tl) ? a[r] : 0.f;
                *(LAS unsigned short*)(lds + H_AM + tl * 144 + sl * 2) = f2bf(val); } }
        __syncthreads();
#pragma unroll
        for (int ss = 0; ss < 2; ++ss) { const bf16x8 aa = *(const LAS bf16x8*)(lds + H_AM + (16 * tt + r16) * 144 + (32 * ss + 8 * quad) * 2);
#pragma unroll
            for (int j = 0; j < 4; ++j) { const int vt = 4 * vh + j; const bf16x8 vb = *(const LAS bf16x8*)(lds + H_VT + (16 * vt + r16) * 144 + (32 * ss + 8 * quad) * 2); O[j] = MFMA16(aa, vb, O[j]); } }
#pragma unroll
        for (int ss = 0; ss < 2; ++ss) { const bf16x8 ka = *(const LAS bf16x8*)(lds + H_KTT + (16 * w + r16) * 144 + (32 * ss + 8 * quad) * 2);
#pragma unroll
            for (int vt = 0; vt < 8; ++vt) { const bf16x8 vb = *(const LAS bf16x8*)(lds + H_VT + (16 * vt + r16) * 144 + (32 * ss + 8 * quad) * 2); S[vt] = MFMA16(ka, vb, S[vt]); } }
#pragma unroll
        for (int vt = 0; vt < 8; ++vt) { S[vt] = S[vt] * dec;
            *(LAS u32x2*)(lds + H_S0T + (16 * vt + r16) * 272 + (16 * w + 4 * quad) * 2) = (u32x2){pk2(S[vt].x, S[vt].y), pk2(S[vt].z, S[vt].w)}; }
#pragma unroll
        for (int j = 0; j < 4; ++j) { const int vt = 4 * vh + j;
#pragma unroll
            for (int r = 0; r < 4; ++r) ((LAS float*)lds)[(16 * tt + 4 * quad + r) * 132 + 16 * vt + r16] = O[j][r]; }
        __syncthreads();
        { const int t = nt_, jj = njj;
          f32x4 o4[4]; float ss = 0.f;
#pragma unroll
          for (int i = 0; i < 4; ++i) { o4[i] = *(const LAS f32x4*)(lds + (t * 132 + 16 * jj + 4 * i) * 4); ss += (o4[i].x * o4[i].x + o4[i].y * o4[i].y) + (o4[i].z * o4[i].z + o4[i].w * o4[i].w); }
          ss += __shfl_xor(ss, 1); ss += __shfl_xor(ss, 2); ss += __shfl_xor(ss, 4);
          const float rstd = rsqrtf(ss * (1.0f / 128.0f) + RMS_EPS);
          { const size_t off = goff;
              const unsigned gw_[8] = {g0.x, g0.y, g0.z, g0.w, g1.x, g1.y, g1.z, g1.w};
              unsigned ow[8];
#pragma unroll
              for (int i = 0; i < 4; ++i) { const f32x4 n4 = nw4[i];
                  const float y0 = o4[i].x * rstd * n4.x * bf2f((unsigned short)(gw_[2 * i] & 0xffffu)), y1 = o4[i].y * rstd * n4.y * bf2f((unsigned short)(gw_[2 * i] >> 16));
                  const float y2 = o4[i].z * rstd * n4.z * bf2f((unsigned short)(gw_[2 * i + 1] & 0xffffu)), y3 = o4[i].w * rstd * n4.w * bf2f((unsigned short)(gw_[2 * i + 1] >> 16));
                  ow[2 * i] = pk2(y0, y1); ow[2 * i + 1] = pk2(y2, y3); }
              *(u32x4*)(OB + off) = (u32x4){ow[0], ow[1], ow[2], ow[3]}; *(u32x4*)(OB + off + 8) = (u32x4){ow[4], ow[5], ow[6], ow[7]}; }
        }
        }
    }
#undef HG_LOAD
    if (!full || sg == 3) {
        float* so = full ? p.out + OUT_SP + ((size_t)(b * 16 + h)) * 16384 : HU + (size_t)item * 16384;
#pragma unroll
        for (int vt = 0; vt < 8; ++vt)
#pragma unroll
            for (int r = 0; r < 4; ++r) { float* d_ = so + (16 * w + 4 * quad + r) * 128 + 16 * vt + r16; if (full) __builtin_nontemporal_store(S[vt][r], d_); else *d_ = S[vt][r]; }
        if (!full && r16 == 0) *(f32x4*)(HD + item * 128 + 16 * w + 4 * quad) = dprod;
    }
    __syncthreads();
}

constexpr int SS_Q = 0, SS_K = 4096, SS_V = 8192, SS_E8 = 12288, SS_A = 12800, SS_B = 13056, SS_QR = 17152, SS_PART = 25600;
struct SampRaw { float lf[2]; unsigned short q[2], v[2]; f32x4 s0[8]; };
__device__ __forceinline__ void hgrn_sample_load(const Params& p, int it, SampRaw& r) {
    int tid_l = threadIdx.x; asm volatile("" : "+v"(tid_l)); const int tid = tid_l, b = it >> 4, h = it & 15;
    const bf16_t* QB = (const bf16_t*)(p.ws + WS_QB); const float* LF = (const float*)(p.ws + WS_LF); const bf16_t* VB = (const bf16_t*)(p.ws + WS_VB);
    const size_t rbase = ((size_t)(MPR + b * 8)) * D + h * 128;
#pragma unroll
    for (int j = 0; j < 2; ++j) { const int rem = tid + 512 * j, t = rem >> 7, k = rem & 127; const size_t o = rbase + (size_t)t * D + k; r.lf[j] = __builtin_nontemporal_load(LF + o); r.q[j] = __builtin_nontemporal_load(QB + o); r.v[j] = __builtin_nontemporal_load(VB + o); }
    { const int v4 = tid & 31, kg = tid >> 5; const float* S0 = p.state + ((size_t)(b * 16 + h)) * 16384;
#pragma unroll
      for (int i = 0; i < 8; ++i) r.s0[i] = __builtin_nontemporal_load((const f32x4*)(S0 + (8 * kg + i) * 128 + 4 * v4)); }
}
__device__ __forceinline__ void hgrn_sample_item(const Params& p, LAS unsigned char* lds, int it, int it_next, SampRaw& raw) {
    int tid_l = threadIdx.x; asm volatile("" : "+v"(tid_l)); const int tid = tid_l, lane = tid & 63;
    const int b = it >> 4, h = it & 15;
    const bf16_t* GB = (const bf16_t*)(p.ws + WS_GB); bf16_t* OB = (bf16_t*)(p.ws + WS_OB);
    const size_t rbase = ((size_t)(MPR + b * 8)) * D + h * 128;
    LAS float* SQ = (LAS float*)(lds + SS_Q); LAS float* SK = (LAS float*)(lds + SS_K); LAS float* SV = (LAS float*)(lds + SS_V); LAS float* SE8 = (LAS float*)(lds + SS_E8);
    LAS float* SA = (LAS float*)(lds + SS_A); LAS float* SB = (LAS float*)(lds + SS_B); LAS float* SQR = (LAS float*)(lds + SS_QR);
    LAS float* PART = (LAS float*)(lds + SS_PART);
    const int v4 = tid & 31, kg = tid >> 5;
    const float* S0 = p.state + ((size_t)(b * 16 + h)) * 16384; float* S1 = p.out + OUT_SS + ((size_t)(b * 16 + h)) * 16384;
    f32x4 s0[8];
#pragma unroll
    for (int i = 0; i < 8; ++i) s0[i] = raw.s0[i];
    const size_t goff3 = rbase + (size_t)(tid >> 6) * D + 2 * lane;
    const unsigned g3 = __builtin_nontemporal_load((const unsigned*)(GB + goff3)); const f32x2v nw3 = *(const f32x2v*)(p.norm_w + h * 128 + 2 * lane);
#pragma unroll
    for (int j = 0; j < 2; ++j) { const int rem = tid + 512 * j; SB[rem] = raw.lf[j]; SQR[rem] = bf2f(raw.q[j]); SV[rem] = bf2f(raw.v[j]); }
    __syncthreads();
    if (it_next < 2048) hgrn_sample_load(p, it_next, raw);
    if (tid < 128) { const int k = tid; float lfv[8], bt[8]; float run = 1.f;
#pragma unroll
        for (int t = 0; t < 8; ++t) { lfv[t] = SB[t * 128 + k]; run *= lfv[t]; bt[t] = run; }
#pragma unroll
        for (int t = 0; t < 8; ++t) { SQ[k * 8 + t] = SQR[t * 128 + k] * bt[t]; SK[k * 8 + t] = (1.0f - lfv[t]) * __builtin_amdgcn_rcpf(bt[t]); }
        SE8[k] = run;
    }
    __syncthreads();
    { const int pair = tid >> 3, ks = tid & 7, t = pair >> 3, s = pair & 7; float a = 0.f;
#pragma unroll
        for (int i = 0; i < 16; ++i) a += SQ[(ks + 8 * i) * 8 + t] * SK[(ks + 8 * i) * 8 + s];
        a += __shfl_xor(a, 1); a += __shfl_xor(a, 2); a += __shfl_xor(a, 4);
        if (ks == 0) SA[pair] = (s <= t) ? a : 0.f; }
    {
        f32x4 vv[8], o[8];
#pragma unroll
        for (int s = 0; s < 8; ++s) { vv[s] = *(const LAS f32x4*)(SV + s * 128 + 4 * v4); o[s] = (f32x4){0.f, 0.f, 0.f, 0.f}; }
#pragma unroll
        for (int i = 0; i < 8; ++i) { const int k = 8 * kg + i;
            const f32x4 qa = *(const LAS f32x4*)(SQ + k * 8), qb = *(const LAS f32x4*)(SQ + k * 8 + 4), ka = *(const LAS f32x4*)(SK + k * 8), kb = *(const LAS f32x4*)(SK + k * 8 + 4);
            const float q8[8] = {qa.x, qa.y, qa.z, qa.w, qb.x, qb.y, qb.z, qb.w}, k8[8] = {ka.x, ka.y, ka.z, ka.w, kb.x, kb.y, kb.z, kb.w};
            f32x4 sn = s0[i];
#pragma unroll
            for (int t = 0; t < 8; ++t) { o[t] = o[t] + s0[i] * q8[t]; sn = sn + vv[t] * k8[t]; }
            __builtin_nontemporal_store(sn * SE8[k], (f32x4*)(S1 + k * 128 + 4 * v4)); }
#pragma unroll
        for (int t = 0; t < 8; ++t) *(LAS f32x4*)(PART + (kg * 8 + t) * 128 + 4 * v4) = o[t];
    }
    __syncthreads();
    { const int t = tid >> 6, vp = lane; f32x2v o2 = (f32x2v){0.f, 0.f};
#pragma unroll
        for (int g = 0; g < 16; ++g) o2 = o2 + *(const LAS f32x2v*)(PART + (g * 8 + t) * 128 + 2 * vp);
#pragma unroll
        for (int s = 0; s < 8; ++s) o2 = o2 + *(const LAS f32x2v*)(SV + s * 128 + 2 * vp) * SA[t * 8 + s];
        float ss = o2.x * o2.x + o2.y * o2.y;
#pragma unroll
        for (int m = 1; m < 64; m <<= 1) ss += __shfl_xor(ss, m);
        const float rstd = rsqrtf(ss * (1.0f / 128.0f) + RMS_EPS);
        const size_t off = rbase + (size_t)t * D + 2 * vp;
        const unsigned g = g3; const f32x2v nw = nw3;
        *(unsigned*)(OB + off) = pk2(o2.x * rstd * nw.x * bf2f((unsigned short)(g & 0xffffu)), o2.y * rstd * nw.y * bf2f((unsigned short)(g >> 16))); }
    __syncthreads();
}

__device__ __forceinline__ void phase_hgrn(const Params& p, LAS unsigned char* lds, const XcdBarrier& xb) {
    const int G = gridDim.x, blk = blockIdx.x;
    const bool early = (G == 256) && ((blk & 3) == 3); constexpr int NEARLY = 64 * 6;
    const int s_lo = (G == 256) ? NEARLY : 0;
    const bool swap = (G == 256) && (((blk >> 2) & 1) != 0);
    for (int stage = 0; stage < 2; ++stage) {
        for (int k = 0; k < 2; ++k) {
            const bool do_chain = (stage == 0) ? (k == 0) : ((k == 0) != swap);
            if (do_chain) { for (int it = blk; it < 256; it += G) hgrn_chain(p, lds, it, stage); }
            else {
                int it, step, end;
                if (stage == 0) { it = early ? (blk >> 2) : 4096; step = 64; end = NEARLY; } else { it = s_lo + blk; step = G; end = 2048; }
                SampRaw raw; if (it < end) hgrn_sample_load(p, it, raw);
                for (; it < end; it += step) hgrn_sample_item(p, lds, it, (it + step < end) ? it + step : 4096, raw);
            }
        }
        if (stage == 0) xcd_barrier(xb);
    }
}

constexpr int A_KS = 0, A_VT = 23040;
constexpr int ATT_PROMPT_ITEMS = NBP * 4 * 65, ATT_ITEMS = ATT_PROMPT_ITEMS + NBS * 4;
struct AttPre { u32x4 r[3][4]; };
__device__ __forceinline__ void attn_load(const Params& p, int it, AttPre& pre) {
    const int tid = threadIdx.x;
    const bf16_t* K1 = (const bf16_t*)(p.ws + WS_K1); const bf16_t* V1 = (const bf16_t*)(p.ws + WS_V1);
    const bool samp = it >= ATT_PROMPT_ITEMS;
    int b, kvh, t0 = 0;
    if (!samp) { b = it / 260; const int rem = it - b * 260; kvh = rem / 65; t0 = 32 * (rem - kvh * 65); } else { const int j = it - ATT_PROMPT_ITEMS; b = j >> 2; kvh = j & 3; }
#pragma unroll
    for (int u = 0; u < 3; ++u) { const int idx = tid + 512 * u;
        const int kA = idx >> 3, cA = idx & 7;
        const int cB = idx / 160, kB = idx - 160 * cB;
        const u32x4 z = (u32x4){0u, 0u, 0u, 0u}; pre.r[u][0] = z; pre.r[u][1] = z; pre.r[u][2] = z; pre.r[u][3] = z;
        if (idx < 1280) {
            if (!samp) { const int pA = t0 - 128 + kA, pB = t0 - 128 + kB;
                if (pA >= 0 && pA < TP) pre.r[u][0] = *(const u32x4*)(K1 + ((size_t)(b * TP + pA)) * 256 + kvh * 64 + 8 * cA);
                if (pB >= 0 && pB < TP) pre.r[u][1] = *(const u32x4*)(V1 + ((size_t)(b * TP + pB)) * 256 + kvh * 64 + 8 * cB); }
            else {
                if (kA < 128) { const size_t o = (((size_t)b * 128 + kA) * 4 + kvh) * 64 + 8 * cA; pre.r[u][0] = *(const u32x4*)(p.cache_k + o); pre.r[u][1] = *(const u32x4*)(p.cache_k + o + 4); }
                else if (kA < 136) pre.r[u][0] = *(const u32x4*)(K1 + ((size_t)(MPR + b * 8 + kA - 128)) * 256 + kvh * 64 + 8 * cA);
                if (kB < 128) { const size_t o = (((size_t)b * 128 + kB) * 4 + kvh) * 64 + 8 * cB; pre.r[u][2] = *(const u32x4*)(p.cache_v + o); pre.r[u][3] = *(const u32x4*)(p.cache_v + o + 4); }
                else if (kB < 136) pre.r[u][2] = *(const u32x4*)(V1 + ((size_t)(MPR + b * 8 + kB - 128)) * 256 + kvh * 64 + 8 * cB);
            }
        } }
}
__device__ __forceinline__ void attn_stage(LAS unsigned char* base, int itp, const AttPre& pre) {
    const int tid = threadIdx.x; const bool samp = itp >= ATT_PROMPT_ITEMS;
#pragma unroll
    for (int u = 0; u < 3; ++u) { const int idx = tid + 512 * u;
        const int kA = idx >> 3, cA = idx & 7, cB = idx / 160, kB = idx - 160 * cB;
        if (idx < 1280) {
            u32x4 kv = pre.r[u][0], vv = samp ? pre.r[u][2] : pre.r[u][1];
            if (samp && kA < 128) { const f32x4 a = __builtin_bit_cast(f32x4, pre.r[u][0]), bq = __builtin_bit_cast(f32x4, pre.r[u][1]); kv = (u32x4){pk2(a.x, a.y), pk2(a.z, a.w), pk2(bq.x, bq.y), pk2(bq.z, bq.w)}; }
            if (samp && kB < 128) { const f32x4 c = __builtin_bit_cast(f32x4, pre.r[u][2]), d = __builtin_bit_cast(f32x4, pre.r[u][3]); vv = (u32x4){pk2(c.x, c.y), pk2(c.z, c.w), pk2(d.x, d.y), pk2(d.z, d.w)}; }
            *(LAS u32x4*)(base + A_KS + kA * 144 + cA * 16) = kv;
            const unsigned vw[4] = {vv.x, vv.y, vv.z, vv.w};
#pragma unroll
            for (int j = 0; j < 4; ++j) { *(LAS unsigned short*)(base + A_VT + (8 * cB + 2 * j) * 336 + kB * 2) = (unsigned short)(vw[j] & 0xffffu);
                *(LAS unsigned short*)(base + A_VT + (8 * cB + 2 * j + 1) * 336 + kB * 2) = (unsigned short)(vw[j] >> 16); }
        } }
}
constexpr int ATT_BUF = 44544;
__device__ __forceinline__ void attn_item(const Params& p, LAS unsigned char* lds_all, int it, int it_n1, int it_n2, int cur, AttPre& pre) {
    int tid_l = threadIdx.x; asm volatile("" : "+v"(tid_l)); const int tid = tid_l, w = tid >> 6, lane = tid & 63, r16 = lane & 15, quad = lane >> 4;
    LAS unsigned char* lds = lds_all + cur * ATT_BUF; LAS unsigned char* ldsn = lds_all + (cur ^ 1) * ATT_BUF;
    const bf16_t* Q1 = (const bf16_t*)(p.ws + WS_QB);
    const bf16_t* GB = (const bf16_t*)(p.ws + WS_GB); bf16_t* OB = (bf16_t*)(p.ws + WS_OB);
    const bool samp = it >= ATT_PROMPT_ITEMS;
    int b, kvh, t0 = 0;
    if (!samp) { b = it / 260; const int rem = it - b * 260; kvh = rem / 65; t0 = 32 * (rem - kvh * 65); } else { const int j = it - ATT_PROMPT_ITEMS; b = j >> 2; kvh = j & 3; }
    const int hq = kvh * 8 + w;
    bf16x8 qf[2][2]; bool qok[2]; size_t qrow[2];
#pragma unroll
    for (int tt = 0; tt < 2; ++tt) { const int i = 16 * tt + r16;
        if (!samp) { const int t = t0 + i; qok[tt] = t < TP; qrow[tt] = (size_t)(b * TP + (qok[tt] ? t : 0)); } else { qok[tt] = i < 8; qrow[tt] = (size_t)(MPR + b * 8 + (qok[tt] ? i : 0)); }
#pragma unroll
        for (int ds = 0; ds < 2; ++ds) { bf16x8 q = __builtin_nontemporal_load((const bf16x8*)(Q1 + qrow[tt] * D + hq * 64 + 32 * ds + 8 * quad)); if (!qok[tt]) q = (bf16x8){0, 0, 0, 0, 0, 0, 0, 0}; qf[tt][ds] = q; } }
    u32x4 gw[4]; size_t orow[4]; bool ook[4];
#pragma unroll
    for (int k = 0; k < 4; ++k) { const int i = 8 * k + (lane >> 3);
        if (!samp) { const int t = t0 + i; ook[k] = t < TP; orow[k] = (size_t)(b * TP + (ook[k] ? t : 0)); } else { ook[k] = i < 8; orow[k] = (size_t)(MPR + b * 8 + (ook[k] ? i : 0)); }
        gw[k] = __builtin_nontemporal_load((const u32x4*)(GB + orow[k] * D + hq * 64 + 8 * (lane & 7))); }
    __syncthreads();
    f32x4 st[10][2];
#pragma unroll
    for (int kt = 0; kt < 10; ++kt) { st[kt][0] = (f32x4){0.f, 0.f, 0.f, 0.f}; st[kt][1] = (f32x4){0.f, 0.f, 0.f, 0.f};
#pragma unroll
        for (int ds = 0; ds < 2; ++ds) { const bf16x8 ka = *(const LAS bf16x8*)(lds + A_KS + (16 * kt + r16) * 144 + (32 * ds + 8 * quad) * 2);
            st[kt][0] = MFMA16(ka, qf[0][ds], st[kt][0]); if (!samp) st[kt][1] = MFMA16(ka, qf[1][ds], st[kt][1]); } }
    const float sink = p.sinks[hq] * 1.44269504089f;
    const int kminv = samp ? 0 : (128 - t0 > 0 ? 128 - t0 : 0);
    const bool midfree = kminv <= 32;
    const int ntt = samp ? 1 : 2;
    bf16x8 pb[5][2]; float inv[2] = {0.f, 0.f};
#pragma unroll
    for (int tt = 0; tt < 2; ++tt) if (tt < ntt) { const int i = 16 * tt + r16; const int lo = (i + 1 > kminv) ? i + 1 : kminv, hi = i + 128;
        float m = -INFINITY;
#pragma unroll
        for (int kt = 0; kt < 10; ++kt) {
            if (kt >= 2 && kt < 8 && midfree) {
#pragma unroll
                for (int r = 0; r < 4; ++r) m = fmaxf(m, st[kt][tt][r]);
            } else {
#pragma unroll
                for (int r = 0; r < 4; ++r) { const int kp = 16 * kt + 4 * quad + r; const float s = (kp >= lo && kp <= hi) ? st[kt][tt][r] : -INFINITY; st[kt][tt][r] = s; m = fmaxf(m, s); }
            } }
        m = fmaxf(m, __shfl_xor(m, 16)); m = fmaxf(m, __shfl_xor(m, 32)); m = fmaxf(m, sink);
        float sum = 0.f;
#pragma unroll
        for (int kt = 0; kt < 10; ++kt)
#pragma unroll
            for (int r = 0; r < 4; ++r) { const float e = __builtin_amdgcn_exp2f(st[kt][tt][r] - m); st[kt][tt][r] = e; sum += e; }
        sum += __shfl_xor(sum, 16); sum += __shfl_xor(sum, 32); sum += __builtin_amdgcn_exp2f(sink - m);
        inv[tt] = __builtin_amdgcn_rcpf(sum);
#pragma unroll
        for (int ks = 0; ks < 5; ++ks) { const f32x4 a = st[2 * ks][tt], c = st[2 * ks + 1][tt];
            const u32x4 pw = (u32x4){pk2(a.x, a.y), pk2(a.z, a.w), pk2(c.x, c.y), pk2(c.z, c.w)}; pb[ks][tt] = __builtin_bit_cast(bf16x8, pw); }
    }
    if (it_n1 < ATT_ITEMS) attn_stage(ldsn, it_n1, pre);
    if (it_n2 < ATT_ITEMS) attn_load(p, it_n2, pre);
    f32x4 o[4][2];
#pragma unroll
    for (int dt = 0; dt < 4; ++dt) { o[dt][0] = (f32x4){0.f, 0.f, 0.f, 0.f}; o[dt][1] = (f32x4){0.f, 0.f, 0.f, 0.f}; }
#pragma unroll
    for (int ks = 0; ks < 5; ++ks)
#pragma unroll
        for (int dt = 0; dt < 4; ++dt) { const u32x2 l8 = *(const LAS u32x2*)(lds + A_VT + (16 * dt + r16) * 336 + (32 * ks + 4 * quad) * 2), h8 = *(const LAS u32x2*)(lds + A_VT + (16 * dt + r16) * 336 + (32 * ks + 16 + 4 * quad) * 2);
            const bf16x8 va = __builtin_bit_cast(bf16x8, (u32x4){l8.x, l8.y, h8.x, h8.y});
            o[dt][0] = MFMA16(va, pb[ks][0], o[dt][0]); if (ntt > 1) o[dt][1] = MFMA16(va, pb[ks][1], o[dt][1]); }
    LAS unsigned char* os = lds_all + 2 * ATT_BUF + w * 4608;
#pragma unroll
    for (int tt = 0; tt < 2; ++tt) if (tt < ntt) {
#pragma unroll
        for (int dt = 0; dt < 4; ++dt) { const f32x4 x = o[dt][tt] * inv[tt];
            *(LAS u32x2*)(os + (16 * tt + r16) * 144 + (16 * dt + 4 * quad) * 2) = (u32x2){pk2(x.x, x.y), pk2(x.z, x.w)}; } }
    LDS_WAIT();
#pragma unroll
    for (int k = 0; k < 4; ++k) if (k < 2 * ntt) { const int i = 8 * k + (lane >> 3);
        const u32x4 ov = *(const LAS u32x4*)(os + i * 144 + (lane & 7) * 16);
        const unsigned ow_[4] = {ov.x, ov.y, ov.z, ov.w}, gg[4] = {gw[k].x, gw[k].y, gw[k].z, gw[k].w}; unsigned rr[4];
#pragma unroll
        for (int j = 0; j < 4; ++j) rr[j] = pk2(__uint_as_float(ow_[j] << 16) * __uint_as_float(gg[j] << 16), __uint_as_float(ow_[j] & 0xffff0000u) * __uint_as_float(gg[j] & 0xffff0000u));
        if (ook[k]) *(u32x4*)(OB + orow[k] * D + hq * 64 + 8 * (lane & 7)) = (u32x4){rr[0], rr[1], rr[2], rr[3]}; }
    LDS_WAIT();
}
__device__ __forceinline__ int att_item_of(int blk, int r, int G) {
    if (G != 256) return blk + r * G;
    const int x = blk & 7, j = blk >> 3;
    if (r < 6) return 256 * r + 32 * x + j;
    return (r == 6 && x == 1 && j < 16) ? 1536 + j : ATT_ITEMS;
}

__global__ void __launch_bounds__(512, 2) fwd_megakernel(Params p) {
    extern __shared__ __attribute__((aligned(16))) unsigned char shm[];
    LAS unsigned char* lds = (LAS unsigned char*)shm;
    const int G = gridDim.x;
    if (threadIdx.x < 4) ((LAS unsigned*)(lds + 131072))[threadIdx.x] = 0u;
    __syncthreads();
    const XcdBarrier xb = xcd_barrier_post((unsigned*)(p.ws + WS_BAR), (volatile LAS unsigned*)(lds + 131072));
    bf16_t* XB = (bf16_t*)(p.ws + WS_XB); bf16_t* OB = (bf16_t*)(p.ws + WS_OB); bf16_t* QB = (bf16_t*)(p.ws + WS_QB); bf16_t* VB = (bf16_t*)(p.ws + WS_VB); bf16_t* GB = (bf16_t*)(p.ws + WS_GB);
    float* ZB = (float*)(p.ws + WS_ZB);
    phase0(p, lds);
    xcd_barrier(xb);
    { pg8::Gemm g{XB, (const bf16_t*)(p.ws + WS_WT0), MPAD, 8192, 2048}; pg8::StaticOrder S; S.init(MPAD, 8192, G, blockIdx.x);
      EpiHgrnIn E{p.ws, (float*)(p.ws + WS_LF), (const float*)(p.ws + WS_LB)};
      pg8::gemm_phase<EpiHgrnIn, pg8::StaticOrder, false>(lds, g, S, E, nullptr);
      const int heavy = (37 * 32) % G; const int li = heavy ? (int)blockIdx.x - heavy : (int)blockIdx.x;
      if (li >= 0) phase0_rest(p, lds, li, heavy ? G - heavy : G); }
    xcd_barrier(xb);
    phase_hgrn(p, lds, xb);
    xcd_barrier(xb);
    { pg8::Gemm g{OB, (const bf16_t*)(p.ws + WS_WTO0), MPAD, 2048, 2048}; OrderOut S; S.init(G, blockIdx.x);
      EpiY E{VB, (float*)(p.ws + WS_LF)};
      pg8::gemm_phase<EpiY, OrderOut, false>(lds, g, S, E, nullptr); }
    xcd_barrier(xb);
    phase_ln<1>(p, 0);
    xcd_barrier(xb);
    { pg8::Gemm g{XB, (const bf16_t*)(p.ws + WS_WT1), MPAD, 4608, 2048}; pg8::StaticOrder S; S.init(MPAD, 4608, G, blockIdx.x);
      EpiSwaIn E{QB, (bf16_t*)(p.ws + WS_K1), (bf16_t*)(p.ws + WS_V1), GB, p.out};
      pg8::gemm_phase<EpiSwaIn, pg8::StaticOrder, false>(lds, g, S, E, nullptr);
      const int heavy = (37 * 18) % G; const int li = heavy ? (int)blockIdx.x - heavy : (int)blockIdx.x;
      if (li >= 0) phase_cache_shift(p, li, heavy ? G - heavy : G); }
    xcd_barrier(xb);
    { AttPre pre; int it = att_item_of(blockIdx.x, 0, G), n1 = att_item_of(blockIdx.x, 1, G);
      if (it < ATT_ITEMS) { attn_load(p, it, pre); attn_stage(lds, it, pre); }
      if (n1 < ATT_ITEMS) attn_load(p, n1, pre);
      for (int r = 0; it < ATT_ITEMS; ++r) { const int n2 = (n1 < ATT_ITEMS) ? att_item_of(blockIdx.x, r + 2, G) : ATT_ITEMS; attn_item(p, lds, it, n1, n2, r & 1, pre); it = n1; n1 = n2; } }
    xcd_barrier(xb);
    { pg8::Gemm g{OB, (const bf16_t*)(p.ws + WS_WTO1), MPAD, 2048, 2048}; OrderOut S; S.init(G, blockIdx.x);
      EpiY E{VB, (float*)(p.ws + WS_LF)};
      pg8::gemm_phase<EpiY, OrderOut, false>(lds, g, S, E, nullptr); }
    xcd_barrier(xb);
    for (int rep = 0; rep < REP_LN; ++rep) phase_ln<2>(p, 1);
}

extern "C" void kernel_launch(void* const* d_in, const int* in_sizes, int n_in, void* d_out, int out_size, void* d_ws, size_t ws_size, hipStream_t stream) {
    static int grid_blocks = 0;
    if (!grid_blocks) {
        int dev = 0, cus = 0, per_cu = 0;
        hipGetDevice(&dev);
        hipDeviceGetAttribute(&cus, hipDeviceAttributeMultiprocessorCount, dev);
        hipFuncSetAttribute((const void*)fwd_megakernel, hipFuncAttributeMaxDynamicSharedMemorySize, LDS_BYTES);
        hipOccupancyMaxActiveBlocksPerMultiprocessor(&per_cu, (const void*)fwd_megakernel, 512, LDS_BYTES);
        if (per_cu < 1) { fprintf(stderr, "kernel_launch: occupancy query reports %d blocks/CU\n", per_cu); per_cu = 1; }
        grid_blocks = cus;
    }
    if (ws_size < WS_END) { fprintf(stderr, "kernel_launch: workspace too small (%zu < %zu)\n", ws_size, (size_t)WS_END); return; }
    Params p{};
    p.x_prompt = (const float*)d_in[0]; p.x_sample = (const float*)d_in[1]; p.state = (const float*)d_in[2]; p.cache_k = (const float*)d_in[3]; p.cache_v = (const float*)d_in[4];
    p.meta = (const float*)d_in[5]; p.w_in0 = (const float*)d_in[6]; p.lb_logits = (const float*)d_in[7]; p.norm_w = (const float*)d_in[8]; p.w_out0 = (const float*)d_in[9];
    p.w_in1 = (const float*)d_in[10]; p.sinks = (const float*)d_in[11]; p.w_out1 = (const float*)d_in[12]; p.ln_g = (const float*)d_in[13]; p.ln_b = (const float*)d_in[14];
    p.out = (float*)d_out; p.ws = (unsigned char*)d_ws;
    if (hipMemsetAsync((char*)d_ws + WS_BAR, 0, 16384, stream) != hipSuccess) { fprintf(stderr, "kernel_launch: memset of the barrier words failed\n"); return; }
    void* args[] = {&p};
    hipError_t e = hipLaunchCooperativeKernel((const void*)fwd_megakernel, dim3(grid_blocks), dim3(512), args, LDS_BYTES, stream);
    if (e != hipSuccess) fprintf(stderr, "cooperative launch failed: %s (grid %d)\n", hipGetErrorString(e), grid_blocks);
}
```

```cpp
#include <hip/hip_runtime.h>
#include <hip/hip_cooperative_groups.h>
#include <cstdio>
#include <cstdint>
namespace pg8 {
#define PG8_LAS __attribute__((address_space(3)))
typedef unsigned short bf16_t;
typedef short bf16x8 __attribute__((ext_vector_type(8)));
typedef float f32x4 __attribute__((ext_vector_type(4)));
typedef unsigned u32x4 __attribute__((ext_vector_type(4)));
constexpr int BM = 256, BK = 64, HALF = 128, HTB = HALF * BK * 2  , STAGE_BYTES = 8 * HTB, NXCD = 8, WGM = 8;

__host__ __device__ __forceinline__ int lds_byte(int r, int c) { const int st = (r >> 4) * 2 + (c >> 5), rr = r & 15, cc = c & 31, ob = rr * 64 + cc * 2; return st * 1024 + (ob ^ (((ob >> 9) & 1) << 5)); }
__host__ __device__ __forceinline__ void stage_rc(int b, int& R, int& C) { const int st = b / 1024, sb = b % 1024, swz = sb ^ (((sb >> 9) & 1) << 5); R = (st >> 1) * 16 + swz / 64; C = (st & 1) * 32 + (swz % 64) / 2; }
__host__ __device__ __forceinline__ int perm32(int rho) { const int n = rho >> 4, i = rho & 15; return 8 * (i >> 2) + 4 * n + (i & 3); }

struct Unit { int pm, pn, kt0, nkt; };
struct Gemm { const bf16_t* A; const bf16_t* Bt; int M, N, K; };

struct StaticOrder {
    int reps = 1;
    int nM, nN, nwg, G, c, nkt, nfull, sk;
    __host__ __device__ void init(int M, int N, int G_, int c_, int K = 2048, int split = 0) { nM = M / BM; nN = N / BM; nwg = nM * nN; G = G_; c = c_; nkt = K / BK; nfull = nwg; sk = 1;
        if (split) { const int R = nwg / G, rem = nwg - R * G; if (rem > 0 && rem * 4 <= G && (nkt % 8) == 0) { nfull = R * G; sk = 4; } } }
    __host__ __device__ bool next(int i, Unit& u) const {
        if (reps > 1) { const int R = (nwg + G - 1) / G; if (i >= R * reps) return false; i = i % R; }
        long L = (long)i * G + c; u.kt0 = 0; u.nkt = nkt;
        if (L >= nfull && sk > 1) { if (L >= nfull + G) return false; const int j = (int)(L - nfull); L = nfull + j / sk; u.nkt = nkt / sk; u.kt0 = (j % sk) * u.nkt; }
        if (L >= nwg) return false;
        int wgid = (int)L; { const int q = nwg / NXCD, r = nwg % NXCD, xcd = wgid % NXCD, off = wgid / NXCD; wgid = (xcd < r ? xcd * (q + 1) : r * (q + 1) + (xcd - r) * q) + off; }
        const int nig = WGM * nN, gid = wgid / nig, fm = gid * WGM, gsz = (nM - fm) < WGM ? (nM - fm) : WGM;
        u.pm = fm + ((wgid % nig) % gsz); u.pn = (wgid % nig) / gsz; return true;
    }
    __device__ __forceinline__ void a_ready(const Unit&) const {}
    __device__ __forceinline__ void done(const Unit&) const {}
};
__device__ __forceinline__ unsigned cvt_pk_bf16(float lo, float hi) { unsigned r; asm volatile("v_cvt_pk_bf16_f32 %0, %1, %2" : "=v"(r) : "v"(lo), "v"(hi)); return r; }
template <class Epi, class Sched, bool STAMP = false>
__device__ __forceinline__ void gemm_phase(PG8_LAS unsigned char* lds, const Gemm g, const Sched& S, const Epi& E, unsigned long long* stamps) {
    int tid_l = threadIdx.x; asm volatile("" : "+v"(tid_l));
    const int tid = tid_l, wid = __builtin_amdgcn_readfirstlane(tid >> 6), lane = tid & 63, wr = wid >> 2, wc = wid & 3, fr = lane & 15, fq = lane >> 4;
    const int K = g.K;
    int ts_lo = 0, ts_hi = 0, nts = 0; const unsigned long long rt_entry = STAMP ? (unsigned long long)wall_clock64() : 0ull;
#define PG8_STAMP() do { if (STAMP && wid == 0 && nts < 64) { const unsigned long long _c = (unsigned long long)clock64(); \
        ts_lo = (lane == nts) ? (int)(unsigned)_c : ts_lo; ts_hi = (lane == nts) ? (int)(unsigned)(_c >> 32) : ts_hi; ++nts; } } while (0)
    PG8_STAMP();
    unsigned voffA[2], voffB[2];
#pragma unroll
    for (int i = 0; i < 2; ++i) { int R, C; stage_rc(tid * 16 + i * 8192, R, C); const int Rb = Epi::PERM ? ((R & ~31) + perm32(R & 31)) : R;
        voffA[i] = (unsigned)(R * K + C) * 2u; voffB[i] = (unsigned)(Rb * K + C) * 2u; }
    const size_t kstep = (size_t)(BK * 2);
    const size_t hstep = (size_t)HALF * K * 2;
    const size_t tstep = 2 * hstep;
    const unsigned ldsw = (unsigned)wid * 1024u;
    const int aoff = lds_byte(wr * 64 + fr, fq * 8), boff = lds_byte(wc * 32 + fr, fq * 8);
#define PG8_SA(b, h) (((b) * 2 + (h)) * HTB)
#define PG8_SB(b, h) ((4 + (b) * 2 + (h)) * HTB)
#define PG8_STAGE(bufoff, gbase, voff) do { _Pragma("unroll") for (int _i = 0; _i < 2; ++_i) \
        __builtin_amdgcn_global_load_lds((const unsigned*)((const char*)(gbase) + (voff)[_i]), (PG8_LAS unsigned*)(lds + (bufoff) + ldsw + _i * 8192), 16, 0, 0); } while (0)
#define PG8_LDA(dst, b, h) do { _Pragma("unroll") for (int m = 0; m < 4; ++m) _Pragma("unroll") for (int k = 0; k < 2; ++k) dst[m][k] = *(const PG8_LAS bf16x8*)(lds + PG8_SA(b, h) + aoff + m * 2048 + k * 1024); } while (0)
#define PG8_LDB(dst, b, h) do { _Pragma("unroll") for (int n = 0; n < 2; ++n) _Pragma("unroll") for (int k = 0; k < 2; ++k) dst[n][k] = *(const PG8_LAS bf16x8*)(lds + PG8_SB(b, h) + boff + n * 2048 + k * 1024); } while (0)
#define PG8_MMA(ai, bj, At, Bt) do { __builtin_amdgcn_s_setprio(1); _Pragma("unroll") for (int m = 0; m < 4; ++m) _Pragma("unroll") for (int n = 0; n < 2; ++n) _Pragma("unroll") for (int k = 0; k < 2; ++k) \
        acc[ai][bj][m][n] = __builtin_amdgcn_mfma_f32_16x16x32_bf16(Bt[n][k], At[m][k], acc[ai][bj][m][n], 0, 0, 0); __builtin_amdgcn_s_setprio(0); } while (0)
#define PG8_WAIT_V(n) asm volatile("s_waitcnt vmcnt(" #n ")" ::: "memory")
#define PG8_WAIT_L(n) asm volatile("s_waitcnt lgkmcnt(" #n ")" ::: "memory")
#define PG8_BAR __builtin_amdgcn_s_barrier()
#define PG8_SCHED __builtin_amdgcn_sched_barrier(0)
    Unit cur, nxt; int ui = 0;
    if (!S.next(0, cur)) return;
    f32x4 acc[2][2][4][2];
#pragma unroll
    for (int a = 0; a < 2; ++a)
#pragma unroll
        for (int b = 0; b < 2; ++b)
#pragma unroll
            for (int m = 0; m < 4; ++m)
#pragma unroll
                for (int n = 0; n < 2; ++n) acc[a][b][m][n] = (f32x4){0.f, 0.f, 0.f, 0.f};
    bf16x8 At[4][2], B0[2][2], B1[2][2];
    const char* cA = (const char*)g.A + (size_t)cur.pm * tstep + (size_t)cur.kt0 * kstep; const char* cB = (const char*)g.Bt + (size_t)cur.pn * tstep + (size_t)cur.kt0 * kstep;
    int nt = cur.nkt;
    S.a_ready(cur);
    PG8_STAGE(PG8_SB(0, 0), cB, voffB); PG8_STAGE(PG8_SB(0, 1), cB + hstep, voffB); PG8_STAGE(PG8_SA(0, 0), cA, voffA); PG8_STAGE(PG8_SA(0, 1), cA + hstep, voffA);
    if (wr == 1) PG8_BAR;
    PG8_WAIT_V(2); PG8_BAR;
    PG8_STAGE(PG8_SB(1, 0), cB + kstep, voffB); PG8_STAGE(PG8_SA(1, 0), cA + kstep, voffA); PG8_STAGE(PG8_SB(1, 1), cB + hstep + kstep, voffB);
    PG8_WAIT_V(6); PG8_BAR;
    PG8_STAMP();
    for (;;) {
        const bool has_next = S.next(ui + 1, nxt);
        const char* nA = has_next ? (const char*)g.A + (size_t)nxt.pm * tstep + (size_t)nxt.kt0 * kstep : cA; const char* nB = has_next ? (const char*)g.Bt + (size_t)nxt.pn * tstep + (size_t)nxt.kt0 * kstep : cB;
        for (int t = 0; t < nt; t += 2) {
            const bool last = (t == nt - 2);
            const char* a1 = cA + (size_t)(t + 1) * kstep;
            const char* a2 = last ? nA : cA + (size_t)(t + 2) * kstep; const char* b2 = last ? nB : cB + (size_t)(t + 2) * kstep;
            const char* a3 = a2 + kstep; const char* b3 = b2 + kstep;
            if (last && has_next) S.a_ready(nxt);
            PG8_LDB(B0, 0, 0); PG8_LDB(B1, 0, 1); PG8_SCHED; PG8_LDA(At, 0, 0); PG8_STAGE(PG8_SA(1, 1), a1 + hstep, voffA);
            PG8_WAIT_V(8); PG8_WAIT_L(0); PG8_BAR; PG8_MMA(0, 0, At, B0); PG8_MMA(0, 1, At, B1); PG8_BAR; PG8_SCHED;
            PG8_LDA(At, 0, 1); PG8_STAGE(PG8_SB(0, 0), b2, voffB); PG8_STAGE(PG8_SB(0, 1), b2 + hstep, voffB); PG8_STAGE(PG8_SA(0, 0), a2, voffA);
            PG8_WAIT_V(8); PG8_WAIT_L(0); PG8_BAR; PG8_MMA(1, 0, At, B0); PG8_MMA(1, 1, At, B1); PG8_BAR; PG8_SCHED;
            PG8_LDB(B0, 1, 0); PG8_LDB(B1, 1, 1); PG8_SCHED; PG8_LDA(At, 1, 0); PG8_STAGE(PG8_SA(0, 1), a2 + hstep, voffA);
            PG8_WAIT_V(8); PG8_WAIT_L(0); PG8_BAR; PG8_MMA(0, 0, At, B0); PG8_MMA(0, 1, At, B1); PG8_BAR; PG8_SCHED;
            PG8_LDA(At, 1, 1); PG8_STAGE(PG8_SB(1, 0), b3, voffB); PG8_STAGE(PG8_SB(1, 1), b3 + hstep, voffB); PG8_STAGE(PG8_SA(1, 0), a3, voffA);
            PG8_WAIT_V(8); PG8_WAIT_L(0); PG8_BAR; PG8_MMA(1, 0, At, B0); PG8_MMA(1, 1, At, B1); PG8_BAR; PG8_SCHED;
        }
        PG8_STAMP();
        if (wr == 0) PG8_BAR;
        if constexpr (!Epi::AFTER_DRAIN) { E(acc, cur, wr, wc, fr, fq); S.done(cur); }
        PG8_STAMP();
        if (!has_next) break;
#pragma unroll
        for (int a = 0; a < 2; ++a)
#pragma unroll
            for (int b = 0; b < 2; ++b)
#pragma unroll
                for (int m = 0; m < 4; ++m)
#pragma unroll
                    for (int n = 0; n < 2; ++n) acc[a][b][m][n] = (f32x4){0.f, 0.f, 0.f, 0.f};
        cur = nxt; cA = nA; cB = nB; ++ui; nt = cur.nkt;
        if (wr == 1) PG8_BAR;
    }
    PG8_WAIT_V(0);
    PG8_BAR;
    if constexpr (Epi::AFTER_DRAIN) { E.fused(acc, cur, wr, wc, fr, fq, lds, wid, lane); S.done(cur); }
    PG8_STAMP();
    if (STAMP && wid == 0) { stamps[lane] = lane < nts ? (((unsigned long long)(unsigned)ts_hi << 32) | (unsigned)ts_lo) : 0ull;
        if (lane == 62) stamps[62] = rt_entry; if (lane == 63) stamps[63] = (unsigned long long)wall_clock64(); }
#undef PG8_STAMP
#undef PG8_SA
#undef PG8_SB
#undef PG8_STAGE
#undef PG8_LDA
#undef PG8_LDB
#undef PG8_MMA
#undef PG8_WAIT_V
#undef PG8_WAIT_L
#undef PG8_BAR
#undef PG8_SCHED
}
}
#define LAS __attribute__((address_space(3)))
#include <vector>

#define XB_TMO      128
#define XB_XCNT(j)  (256  + 64 * (j))
#define XB_XSUB(j)  (1280 + 64 * (j))
#define XB_XGEN(j)  (2304 + 64 * (j))
#define XB_TOP      3328
#define XB_TOPGEN   3392
#define XCD_BAR_WORDS 3456
#define XB_SPIN_CAP (1u << 18)

__device__ __forceinline__ unsigned xb_ld(unsigned* p)              { return __hip_atomic_load(p, __ATOMIC_RELAXED, __HIP_MEMORY_SCOPE_AGENT); }
__device__ __forceinline__ unsigned xb_add(unsigned* p, unsigned v) { return __hip_atomic_fetch_add(p, v, __ATOMIC_RELAXED, __HIP_MEMORY_SCOPE_AGENT); }
__device__ __forceinline__ unsigned xb_xcc_id() { return (unsigned)__builtin_amdgcn_s_getreg((3 << 11) | 20) & 0xFu; }
#define XB_SPIN(cond, bar) do { unsigned _sp = 0; while (cond) { __builtin_amdgcn_s_sleep(1); \
    if ((++_sp & 255u) == 0u) { if (xb_ld(&(bar)[XB_TMO])) break; if (_sp > XB_SPIN_CAP) { atomicAdd(&(bar)[XB_TMO], 1u); break; } } } } while (0)

struct XcdBarrier {
    unsigned* bar; unsigned x;
    volatile LAS unsigned* st;
};

__device__ __forceinline__ XcdBarrier xcd_barrier_post(unsigned* bar, volatile LAS unsigned* st) {
    XcdBarrier b; b.bar = bar; b.x = xb_xcc_id(); b.st = st;
    if (threadIdx.x == 0) (void)xb_add(&bar[XB_XCNT(b.x)], 1u);
    return b;
}
__device__ __forceinline__ void xcd_barrier_complete(unsigned* bar, unsigned x, unsigned& nloc, unsigned& nx) {
    const unsigned G = gridDim.x * gridDim.y * gridDim.z;
    unsigned sum, cnt, mine, sp = 0u;
    for (;;) {
        sum = 0u; cnt = 0u; mine = 0u;
#pragma unroll
        for (unsigned j = 0; j < 16; ++j) { const unsigned c = xb_ld(&bar[XB_XCNT(j)]); sum += c; cnt += (c > 0u) ? 1u : 0u; mine = (j == x) ? c : mine; }
        if (sum == G) break;
        __builtin_amdgcn_s_sleep(1);
        if ((++sp & 255u) == 0u) { if (xb_ld(&bar[XB_TMO])) break; if (sp > XB_SPIN_CAP) { atomicAdd(&bar[XB_TMO], 1u); break; } }
    }
    nloc = mine > 0u ? mine : 1u; nx = cnt > 0u ? cnt : 1u;
}

__device__ __forceinline__ void xcd_barrier(const XcdBarrier& b) {
    asm volatile("s_waitcnt vmcnt(0)" ::: "memory");
    __syncthreads();
    if (threadIdx.x == 0) {
        unsigned* bar = b.bar;
        __builtin_amdgcn_s_waitcnt(0);
        unsigned nloc = b.st[0], nx = b.st[1];
        if (nloc == 0u) { xcd_barrier_complete(bar, b.x, nloc, nx); b.st[0] = nloc; b.st[1] = nx; }
        const unsigned old = xb_add(&bar[XB_XSUB(b.x)], 1u);
        const unsigned gen = old / nloc;
        if (old + 1u == (gen + 1u) * nloc) {
            __builtin_amdgcn_fence(__ATOMIC_RELEASE, "agent");
            asm volatile("s_waitcnt vmcnt(0)" ::: "memory");
            const unsigned og = xb_add(&bar[XB_TOP], 1u);
            const unsigned tg = og / nx;
            if (og + 1u == (tg + 1u) * nx) xb_add(&bar[XB_TOPGEN], 1u);
            else XB_SPIN(xb_ld(&bar[XB_TOPGEN]) == tg, bar);
            __builtin_amdgcn_fence(__ATOMIC_ACQUIRE, "agent");
            xb_add(&bar[XB_XGEN(b.x)], 1u);
            asm volatile("s_waitcnt vmcnt(0)" ::: "memory");
        } else {
            XB_SPIN(xb_ld(&bar[XB_XGEN(b.x)]) == gen, bar);
            __builtin_amdgcn_fence(__ATOMIC_ACQUIRE, "agent");
            asm volatile("s_waitcnt vmcnt(0)" ::: "memory");
        }
    }
    __syncthreads();
}
namespace cg = cooperative_groups;
using pg8::bf16_t; using pg8::bf16x8; using pg8::f32x4; using pg8::u32x4;

typedef unsigned u32x2 __attribute__((ext_vector_type(2)));
typedef float f32x2v __attribute__((ext_vector_type(2)));

constexpr int D = 2048, TP = 2064, NBP = 4, MPR = NBP * TP, NBS = 128, TSM = 8, MSM = NBS * TSM, MTOT = MPR + MSM, MPAD = 9472;
constexpr float ALPHA = 1.41421356237309515f;
#ifndef REP_P0
#define REP_P0 1
#endif
#ifndef REP_HGRN
#define REP_HGRN 1
#endif
#ifndef REP_ATT
#define REP_ATT 1
#endif
#ifndef REP_LN
#define REP_LN 1
#endif
#ifndef REP_G1
#define REP_G1 1
#endif
#ifndef REP_G2
#define REP_G2 1
#endif
constexpr float LN_EPS = 1e-5f, RMS_EPS = 1e-6f;
constexpr int LDS_BYTES = 131072 + 64;
constexpr size_t OUT_YP = 0, OUT_YS = 16777216, OUT_SP = 18874368, OUT_SS = 19922944, OUT_KP = 53477376, OUT_VP = 53608448, OUT_KS = 53739520, OUT_VS = 57933824;
constexpr size_t SZ_BF = (size_t)MPAD * D * 2, SZ_F32 = (size_t)MPAD * D * 4;
constexpr size_t WS_WT0 = 0, WS_WTO0 = WS_WT0 + 33554432, WS_WT1 = WS_WTO0 + 8388608, WS_WTO1 = WS_WT1 + 18874368, WS_XB = WS_WTO1 + 8388608,
                 WS_QB = WS_XB + SZ_BF, WS_VB = WS_QB + SZ_BF, WS_GB = WS_VB + SZ_BF, WS_OB = WS_GB + SZ_BF, WS_LF = WS_OB + SZ_BF, WS_ZB = WS_LF + SZ_F32,
                 WS_K1 = WS_ZB + SZ_F32, WS_V1 = WS_K1 + 4849664, WS_LB = WS_V1 + 4849664, WS_BAR = WS_LB + 8192, WS_HU = WS_BAR + 16384, WS_HD = WS_HU + 256 * 65536, WS_END = WS_HD + 256 * 512;

struct Params {
    const float *x_prompt, *x_sample, *state, *cache_k, *cache_v, *meta, *w_in0, *lb_logits, *norm_w, *w_out0, *w_in1, *sinks, *w_out1, *ln_g, *ln_b;
    float* out; unsigned char* ws;
};

__device__ __forceinline__ float bf2f(unsigned short b) { return __uint_as_float(((unsigned)b) << 16); }
__device__ __forceinline__ unsigned short f2bf(float f) { unsigned u = __float_as_uint(f); u += 0x7FFFu + ((u >> 16) & 1u); return (unsigned short)(u >> 16); }
__device__ __forceinline__ unsigned pk2(float lo, float hi) { return pg8::cvt_pk_bf16(lo, hi); }
__device__ __forceinline__ float sigmoidf_(float x) { return __builtin_amdgcn_rcpf(1.0f + __builtin_amdgcn_exp2f(x * -1.44269504089f)); }
__device__ __forceinline__ float siluf_(float x) { return x * __builtin_amdgcn_rcpf(1.0f + __builtin_amdgcn_exp2f(x * -1.44269504089f)); }
#define LDS_WAIT() asm volatile("s_waitcnt lgkmcnt(0)" ::: "memory")

__device__ __forceinline__ const float* xrow_ptr(const Params& p, int row) {
    if (row < MPR) { const int b = row / TP, t = row - b * TP; return t < 16 ? p.meta + (size_t)t * D : p.x_prompt + ((size_t)b * 2048 + (t - 16)) * D; }
    return p.x_sample + (size_t)(row - MPR) * D;
}

__device__ __forceinline__ void p0_transpose_item(const float* __restrict__ W, int K, int N, bf16_t* __restrict__ WT, LAS float* scr, int item, int lane) {
    const int nblk = N / 32, kb = item / nblk, nb = item % nblk, k0 = 64 * kb, n0 = 32 * nb;
    f32x4 wv[8];
#pragma unroll
    for (int i = 0; i < 8; ++i) wv[i] = __builtin_nontemporal_load((const f32x4*)(W + (size_t)(k0 + 8 * i + (lane >> 3)) * N + n0 + 4 * (lane & 7)));
#pragma unroll
    for (int i = 0; i < 8; ++i) { LAS float* d_ = scr + (8 * i + (lane >> 3)) * 33 + 4 * (lane & 7); d_[0] = wv[i].x; d_[1] = wv[i].y; d_[2] = wv[i].z; d_[3] = wv[i].w; }
    LDS_WAIT();
    const int c = lane & 7;
#pragma unroll
    for (int j = 0; j < 4; ++j) { const int n = (lane >> 3) + 8 * j; const LAS float* s = scr + (8 * c) * 33 + n;
        u32x4 o; o.x = pk2(s[0 * 33], s[1 * 33]); o.y = pk2(s[2 * 33], s[3 * 33]); o.z = pk2(s[4 * 33], s[5 * 33]); o.w = pk2(s[6 * 33], s[7 * 33]);
        *(u32x4*)(WT + (size_t)(n0 + n) * K + k0 + 8 * c) = o; }
    LDS_WAIT();
}

__device__ __forceinline__ void phase0(const Params& p, LAS unsigned char* lds) {
    int tid_l = threadIdx.x; asm volatile("" : "+v"(tid_l)); const int tid = tid_l, wave = tid >> 6, lane = tid & 63;
    const int NGW = gridDim.x * 8, gw = wave * gridDim.x + blockIdx.x;
    LAS float* scr = (LAS float*)(lds + wave * 8448);
    constexpr int I0 = 32 * 256;
    bf16_t* WT0 = (bf16_t*)(p.ws + WS_WT0);
    for (int it = gw; it < I0; it += NGW) p0_transpose_item(p.w_in0, 2048, 8192, WT0, scr, it, lane);
    bf16_t* XB = (bf16_t*)(p.ws + WS_XB);
    for (int m = gw; m < MTOT; m += NGW) {
        const f32x4* src = (const f32x4*)xrow_ptr(p, m) + lane; u32x2* dst = (u32x2*)(XB + (size_t)m * D) + lane;
#pragma unroll
        for (int j = 0; j < 8; ++j) { const f32x4 v = __builtin_nontemporal_load(src + 64 * j); u32x2 o; o.x = pk2(v.x, v.y); o.y = pk2(v.z, v.w); dst[64 * j] = o; }
    }
    const int gt = blockIdx.x * 512 + tid, NGT = gridDim.x * 512;
    float* LB = (float*)(p.ws + WS_LB);
    for (int c = gt; c < D; c += NGT) { const float a = p.lb_logits[c], b = p.lb_logits[D + c], cc = p.lb_logits[2 * D + c]; const float m = fmaxf(a, fmaxf(b, cc));
        const float ea = __expf(a - m), eb = __expf(b - m), ec = __expf(cc - m); LB[c] = ea / (ea + eb + ec); }
}
__device__ __forceinline__ void phase0_rest(const Params& p, LAS unsigned char* lds, int li, int nl) {
    int tid_l = threadIdx.x; asm volatile("" : "+v"(tid_l)); const int tid = tid_l, wave = tid >> 6, lane = tid & 63;
    const int gw = li * 8 + wave, NGW = nl * 8;
    LAS float* scr = (LAS float*)(lds + wave * 8448);
    constexpr int I1 = 32 * 64, I2 = 32 * 144, I3 = 32 * 64;
    bf16_t* WTO0 = (bf16_t*)(p.ws + WS_WTO0); bf16_t* WT1 = (bf16_t*)(p.ws + WS_WT1); bf16_t* WTO1 = (bf16_t*)(p.ws + WS_WTO1);
    for (int it = gw; it < I1 + I2 + I3; it += NGW) {
        int r = it;
        if (r < I1) { p0_transpose_item(p.w_out0, 2048, 2048, WTO0, scr, r, lane); continue; } r -= I1;
        if (r < I2) { p0_transpose_item(p.w_in1, 2048, 4608, WT1, scr, r, lane); continue; } r -= I2;
        p0_transpose_item(p.w_out1, 2048, 2048, WTO1, scr, r, lane);
    }
}
__device__ __forceinline__ void phase_cache_shift(const Params& p, int li, int nl) {
    const int gt = li * 512 + threadIdx.x, NGT = nl * 512;
    const f32x4* ck = (const f32x4*)p.cache_k; const f32x4* cv = (const f32x4*)p.cache_v; f32x4* ok = (f32x4*)(p.out + OUT_KS); f32x4* ov = (f32x4*)(p.out + OUT_VS);
    constexpr int PER_B = 120 * 64;
    for (int i0 = gt; i0 < NBS * PER_B; i0 += 4 * NGT) { f32x4 a[4], c[4]; size_t o[4]; bool ok_[4];
#pragma unroll
        for (int u = 0; u < 4; ++u) { const int i = i0 + u * NGT; ok_[u] = i < NBS * PER_B; const int ii = ok_[u] ? i : 0; const int b = ii / PER_B, r = ii - b * PER_B; o[u] = (size_t)b * 8192 + r;
            a[u] = __builtin_nontemporal_load(ck + o[u] + 512); c[u] = __builtin_nontemporal_load(cv + o[u] + 512); }
#pragma unroll
        for (int u = 0; u < 4; ++u) if (ok_[u]) { __builtin_nontemporal_store(a[u], ok + o[u]); __builtin_nontemporal_store(c[u], ov + o[u]); } }
}

struct EpiHgrnIn {
    static constexpr bool PERM = true, AFTER_DRAIN = false;
    unsigned char* ws; float* LF; const float* LB;
    __device__ __forceinline__ void operator()(const f32x4 (&acc)[2][2][4][2], const pg8::Unit& u, int wr, int wc, int fr, int fq) const {
        const int sec = u.pn >> 3, colt = (u.pn & 7) * 256;
        const size_t secoff = sec == 0 ? WS_QB : (sec == 2 ? WS_VB : WS_GB);
        bf16_t* dst = (bf16_t*)(ws + secoff);
        const int row0 = u.pm * 256 + wr * 64 + fr, col0 = colt + wc * 32 + 8 * fq;
        float lb[2][8];
        if (sec == 1) {
#pragma unroll
            for (int bj = 0; bj < 2; ++bj) { const f32x4 a = *(const f32x4*)(LB + col0 + bj * 128), b = *(const f32x4*)(LB + col0 + bj * 128 + 4);
                lb[bj][0] = a.x; lb[bj][1] = a.y; lb[bj][2] = a.z; lb[bj][3] = a.w; lb[bj][4] = b.x; lb[bj][5] = b.y; lb[bj][6] = b.z; lb[bj][7] = b.w; }
        }
#pragma unroll
        for (int ai = 0; ai < 2; ++ai)
#pragma unroll
            for (int m = 0; m < 4; ++m) {
                const int row = row0 + ai * 128 + m * 16; if (row >= MTOT) continue;
#pragma unroll
                for (int bj = 0; bj < 2; ++bj) {
                    const size_t off = (size_t)row * D + col0 + bj * 128;
                    const f32x4 v0 = acc[ai][bj][m][0], v1 = acc[ai][bj][m][1];
                    float x[8] = {v0.x, v0.y, v0.z, v0.w, v1.x, v1.y, v1.z, v1.w};
                    if (sec == 1) {
#pragma unroll
                        for (int j = 0; j < 8; ++j) { const float l = lb[bj][j]; x[j] = l + (1.0f - l) * sigmoidf_(x[j]); }
                        *(f32x4*)(LF + off) = (f32x4){x[0], x[1], x[2], x[3]}; *(f32x4*)(LF + off + 4) = (f32x4){x[4], x[5], x[6], x[7]};
                    } else {
                        if (sec == 3) {
#pragma unroll
                            for (int j = 0; j < 8; ++j) x[j] = siluf_(x[j]);
                        }
                        u32x4 w; w.x = pk2(x[0], x[1]); w.y = pk2(x[2], x[3]); w.z = pk2(x[4], x[5]); w.w = pk2(x[6], x[7]);
                        *(u32x4*)(dst + off) = w;
                    }
                }
            }
    }
};
struct EpiSwaIn {
    static constexpr bool PERM = true, AFTER_DRAIN = false;
    bf16_t* Q; bf16_t* K1; bf16_t* V1; bf16_t* G; float* out;
    __device__ __forceinline__ void operator()(const f32x4 (&acc)[2][2][4][2], const pg8::Unit& u, int wr, int wc, int fr, int fq) const {
        const int pn = u.pn;
        const int row0 = u.pm * 256 + wr * 64 + fr, cw = wc * 32 + 8 * fq;
#pragma unroll
        for (int ai = 0; ai < 2; ++ai)
#pragma unroll
            for (int m = 0; m < 4; ++m) {
                const int row = row0 + ai * 128 + m * 16; if (row >= MTOT) continue;
#pragma unroll
                for (int bj = 0; bj < 2; ++bj) {
                    const f32x4 v0 = acc[ai][bj][m][0], v1 = acc[ai][bj][m][1];
                    float x[8] = {v0.x, v0.y, v0.z, v0.w, v1.x, v1.y, v1.z, v1.w};
                    const int c = cw + bj * 128;
                    if (pn < 8) {
                        constexpr float QS = 0.125f * 1.44269504089f;
                        u32x4 w; w.x = pk2(x[0] * QS, x[1] * QS); w.y = pk2(x[2] * QS, x[3] * QS); w.z = pk2(x[4] * QS, x[5] * QS); w.w = pk2(x[6] * QS, x[7] * QS);
                        *(u32x4*)(Q + (size_t)row * D + pn * 256 + c) = w;
                    } else if (pn >= 10) {
#pragma unroll
                        for (int j = 0; j < 8; ++j) x[j] = siluf_(x[j]);
                        u32x4 w; w.x = pk2(x[0], x[1]); w.y = pk2(x[2], x[3]); w.z = pk2(x[4], x[5]); w.w = pk2(x[6], x[7]);
                        *(u32x4*)(G + (size_t)row * D + (pn - 10) * 256 + c) = w;
                    } else {
                        u32x4 w; w.x = pk2(x[0], x[1]); w.y = pk2(x[2], x[3]); w.z = pk2(x[4], x[5]); w.w = pk2(x[6], x[7]);
                        bf16_t* dst = pn == 8 ? K1 : V1;
                        *(u32x4*)(dst + (size_t)row * 256 + c) = w;
                        float* co = nullptr;
                        if (row < MPR) { const int b = row / TP, t = row - b * TP; if (t >= TP - 128) co = out + (pn == 8 ? OUT_KP : OUT_VP) + ((size_t)b * 128 + (t - (TP - 128))) * 256 + c; }
                        else { const int r = row - MPR, b = r >> 3, t = r & 7; co = out + (pn == 8 ? OUT_KS : OUT_VS) + ((size_t)b * 128 + 120 + t) * 256 + c; }
                        if (co) { __builtin_nontemporal_store(v0, (f32x4*)co); __builtin_nontemporal_store(v1, (f32x4*)(co + 4)); }
                    }
                }
            }
    }
};
constexpr int SPLIT_ROW0 = 8192, SLAB_ROWS = MTOT - 8192;
struct OrderOut {
    pg8::StaticOrder S32; int G, c;
    __device__ void init(int G_, int c_) { S32.init(SPLIT_ROW0, 2048, G_, c_, 2048, 0); G = G_; c = c_; }
    __device__ bool next(int i, pg8::Unit& u) const {
        if (S32.next(i, u)) return true;
        const int R = (256 + G - 1) / G; if (i < R) return false;
        const long j = (long)(i - R) * G + c; if (j >= 160) return false;
        const int un = (int)(j >> 2); u.pm = 32 + (un >> 3); u.pn = un & 7; u.nkt = 8; u.kt0 = 8 * (int)(j & 3); return true;
    }
    __device__ __forceinline__ void a_ready(const pg8::Unit&) const {}
    __device__ __forceinline__ void done(const pg8::Unit&) const {}
};
struct EpiY {
    static constexpr bool PERM = true, AFTER_DRAIN = false;
    bf16_t* Y; float* slab;
    __device__ __forceinline__ void operator()(const f32x4 (&acc)[2][2][4][2], const pg8::Unit& u, int wr, int wc, int fr, int fq) const {
        const int row0 = u.pm * 256 + wr * 64 + fr, col0 = u.pn * 256 + wc * 32 + 8 * fq;
        const bool whole = u.nkt == 32;
        float* sbase = slab + ((size_t)(u.kt0 >> 3) * SLAB_ROWS - SPLIT_ROW0) * D;
#pragma unroll
        for (int ai = 0; ai < 2; ++ai)
#pragma unroll
            for (int m = 0; m < 4; ++m) {
                const int row = row0 + ai * 128 + m * 16; if (row >= MTOT) continue;
#pragma unroll
                for (int bj = 0; bj < 2; ++bj) { const f32x4 v0 = acc[ai][bj][m][0], v1 = acc[ai][bj][m][1]; const size_t off = (size_t)row * D + col0 + bj * 128;
                    if (whole) { u32x4 w; w.x = pk2(v0.x, v0.y); w.y = pk2(v0.z, v0.w); w.z = pk2(v1.x, v1.y); w.w = pk2(v1.z, v1.w); *(u32x4*)(Y + off) = w; }
                    else { *(f32x4*)(sbase + off) = v0; *(f32x4*)(sbase + off + 4) = v1; } }
            }
    }
};

template <int MODE> __device__ __forceinline__ void phase_ln(const Params& p, int layer) {
    int tid_l = threadIdx.x; asm volatile("" : "+v"(tid_l)); const int tid = tid_l, wave = tid >> 6, lane = tid & 63;
    const int NGW = gridDim.x * 8, gw = wave * gridDim.x + blockIdx.x;
    float* ZB = (float*)(p.ws + WS_ZB); bf16_t* XB = (bf16_t*)(p.ws + WS_XB); const bf16_t* YB = (const bf16_t*)(p.ws + WS_VB); const float* SL = (const float*)(p.ws + WS_LF);
    const f32x4* gp = (const f32x4*)(p.ln_g + (size_t)layer * D) + lane; const f32x4* bp = (const f32x4*)(p.ln_b + (size_t)layer * D) + lane;
    f32x4 gam[8], bet[8];
#pragma unroll
    for (int j = 0; j < 8; ++j) { gam[j] = gp[64 * j]; bet[j] = bp[64 * j]; }
    f32x4 nv[8]; u32x2 ny[8];
#define LN_LOAD(m_) do { const u32x2* y_ = (const u32x2*)(YB + (size_t)(m_) * D) + lane; \
        if (MODE == 1) { const f32x4* x_ = (const f32x4*)xrow_ptr(p, (m_)) + lane; _Pragma("unroll") for (int j = 0; j < 8; ++j) nv[j] = __builtin_nontemporal_load(x_ + 64 * j); } \
        else { const u32x2* x_ = (const u32x2*)(XB + (size_t)(m_) * D) + lane; _Pragma("unroll") for (int j = 0; j < 8; ++j) { const u32x2 w_ = x_[64 * j]; nv[j] = (f32x4){bf2f((unsigned short)(w_.x & 0xffffu)), bf2f((unsigned short)(w_.x >> 16)), bf2f((unsigned short)(w_.y & 0xffffu)), bf2f((unsigned short)(w_.y >> 16))}; } } \
        if ((m_) < SPLIT_ROW0) { _Pragma("unroll") for (int j = 0; j < 8; ++j) ny[j] = __builtin_nontemporal_load(y_ + 64 * j); } } while (0)
    if (gw < MTOT) LN_LOAD(gw);
    for (int m = gw; m < MTOT; m += NGW) {
        f32x4 v[8]; float s = 0.f;
        if (m < SPLIT_ROW0) {
#pragma unroll
            for (int j = 0; j < 8; ++j) { const f32x4 y = (f32x4){bf2f((unsigned short)(ny[j].x & 0xffffu)), bf2f((unsigned short)(ny[j].x >> 16)), bf2f((unsigned short)(ny[j].y & 0xffffu)), bf2f((unsigned short)(ny[j].y >> 16))}; v[j] = nv[j] * ALPHA + y; }
        } else {
#pragma unroll
            for (int j = 0; j < 8; ++j) v[j] = nv[j] * ALPHA;
            const f32x4* sl = (const f32x4*)(SL + (size_t)(m - SPLIT_ROW0) * D) + lane;
#pragma unroll
            for (int pc = 0; pc < 4; ++pc)
#pragma unroll
                for (int j = 0; j < 8; ++j) v[j] = v[j] + __builtin_nontemporal_load(sl + (size_t)pc * SLAB_ROWS * (D / 4) + 64 * j);
        }
        if (m + NGW < MTOT) LN_LOAD(m + NGW);
#pragma unroll
        for (int j = 0; j < 8; ++j) s += (v[j].x + v[j].y) + (v[j].z + v[j].w);
#pragma unroll
        for (int o = 1; o < 64; o <<= 1) s += __shfl_xor(s, o);
        const float mean = s * (1.0f / D); float s2 = 0.f;
#pragma unroll
        for (int j = 0; j < 8; ++j) { v[j] = v[j] - mean; s2 += (v[j].x * v[j].x + v[j].y * v[j].y) + (v[j].z * v[j].z + v[j].w * v[j].w); }
#pragma unroll
        for (int o = 1; o < 64; o <<= 1) s2 += __shfl_xor(s2, o);
        const float rstd = rsqrtf(s2 * (1.0f / D) + LN_EPS);
        if (MODE == 1) {
            u32x2* xb = (u32x2*)(XB + (size_t)m * D) + lane;
#pragma unroll
            for (int j = 0; j < 8; ++j) { const f32x4 y = v[j] * rstd * gam[j] + bet[j]; u32x2 o; o.x = pk2(y.x, y.y); o.y = pk2(y.z, y.w); xb[64 * j] = o; }
        } else {
            float* dst = nullptr;
            if (m < MPR) { const int b = m / TP, t = m - b * TP; if (t >= 16) dst = p.out + OUT_YP + ((size_t)b * 2048 + (t - 16)) * D; }
            else dst = p.out + OUT_YS + (size_t)(m - MPR) * D;
            if (dst) { f32x4* d4 = (f32x4*)dst + lane;
#pragma unroll
                for (int j = 0; j < 8; ++j) __builtin_nontemporal_store(v[j] * rstd * gam[j] + bet[j], d4 + 64 * j); }
        }
    }
#undef LN_LOAD
}

constexpr int H_QT = 0, H_KT = 17408, H_KTT = 34816, H_VT = 53248, H_AM = 71680, H_S0T = 80896, H_DEC = 115712, H_SEG = 116224;
#define MFMA16(a, b, c) __builtin_amdgcn_mfma_f32_16x16x32_bf16((a), (b), (c), 0, 0, 0)

__device__ __forceinline__ void hgrn_chain(const Params& p, LAS unsigned char* lds, int item, int pass) {
    const int ci = item >> 2, sg = item & 3;
    const int c_begin = sg == 0 ? 0 : 1 + 8 * sg, c_end = 9 + 8 * sg;
    const bool full = pass != 0;
    if (!full && sg == 3) return;
    int tid_l = threadIdx.x; asm volatile("" : "+v"(tid_l)); const int tid = tid_l, w = tid >> 6, lane = tid & 63, r16 = lane & 15, quad = lane >> 4;
    const int kcol = tid & 127, seg = tid >> 7;
    const int b = ci >> 4, h = ci & 15;
    const bf16_t* QB = (const bf16_t*)(p.ws + WS_QB); const float* LF = (const float*)(p.ws + WS_LF); const bf16_t* VB = (const bf16_t*)(p.ws + WS_VB);
    const bf16_t* GB = (const bf16_t*)(p.ws + WS_GB); bf16_t* OB = (bf16_t*)(p.ws + WS_OB);
    const int colbase = h * 128;
    const int tt = w >> 1, vh = w & 1;
    f32x4 S[8];
#pragma unroll
    for (int i = 0; i < 8; ++i) S[i] = (f32x4){0.f, 0.f, 0.f, 0.f};
    f32x4 dprod = (f32x4){1.f, 1.f, 1.f, 1.f};
    float* HU = (float*)(p.ws + WS_HU); float* HD = (float*)(p.ws + WS_HD);
    if (full) {
        for (int j = 0; j < sg; ++j) { const float* U = HU + (size_t)(ci * 4 + j) * 16384; const f32x4 dj = *(const f32x4*)(HD + (ci * 4 + j) * 128 + 16 * w + 4 * quad);
#pragma unroll
            for (int vt = 0; vt < 8; ++vt)
#pragma unroll
                for (int r = 0; r < 4; ++r) S[vt][r] = dj[r] * S[vt][r] + U[(16 * w + 4 * quad + r) * 128 + 16 * vt + r16]; }
#pragma unroll
        for (int vt = 0; vt < 8; ++vt) *(LAS u32x2*)(lds + H_S0T + (16 * vt + r16) * 272 + (16 * w + 4 * quad) * 2) = (u32x2){pk2(S[vt].x, S[vt].y), pk2(S[vt].z, S[vt].w)};
    }
    float lf[16]; unsigned short qr[16], vr[16];
#define HG_LOAD(c_) do { const int t0_ = 64 * (c_); _Pragma("unroll") for (int i = 0; i < 16; ++i) { const int t_ = t0_ + 16 * seg + i; const bool ok_ = t_ < TP; \
        const size_t off_ = ((size_t)(b * TP + (ok_ ? t_ : 0))) * D + colbase + kcol; \
        float l_; unsigned short q_ = 0, v_; if (full) { l_ = __builtin_nontemporal_load(LF + off_); q_ = __builtin_nontemporal_load(QB + off_); v_ = __builtin_nontemporal_load(VB + off_); } else { l_ = LF[off_]; v_ = VB[off_]; } \
        lf[i] = ok_ ? l_ : 1.f; qr[i] = ok_ ? q_ : (unsigned short)0; vr[i] = ok_ ? v_ : (unsigned short)0; } } while (0)
    f32x4 nw4[4];
#pragma unroll
    for (int i = 0; i < 4; ++i) nw4[i] = *(const f32x4*)(p.norm_w + colbase + 16 * (tid & 7) + 4 * i);
    HG_LOAD(c_begin);
    for (int c = c_begin; c < c_end; ++c) {
        float bl[16]; float run = 1.f;
#pragma unroll
        for (int i = 0; i < 16; ++i) { run *= lf[i]; bl[i] = run; }
        ((LAS float*)(lds + H_SEG))[seg * 128 + kcol] = run;
        __syncthreads();
        float pre = 1.f;
        for (int s = 0; s < seg; ++s) pre *= ((LAS float*)(lds + H_SEG))[s * 128 + kcol];
        unsigned ktp[8], vtp[8]; float eb_last = 1.f;
#pragma unroll
        for (int i = 0; i < 16; i += 2) {
            float kt2[2], qt2[2];
#pragma unroll
            for (int e = 0; e < 2; ++e) { const float eb = pre * bl[i + e], enb = __builtin_amdgcn_rcpf(eb); const float q = bf2f(qr[i + e]); const float kk = 1.0f - lf[i + e];
                qt2[e] = q * eb; kt2[e] = kk * enb; eb_last = eb; }
            ktp[i >> 1] = pk2(kt2[0], kt2[1]); vtp[i >> 1] = (unsigned)vr[i] | ((unsigned)vr[i + 1] << 16);
            if (full) { const unsigned qp = pk2(qt2[0], qt2[1]); const int ts = 16 * seg + i;
                *(LAS unsigned short*)(lds + H_QT + ts * 272 + kcol * 2) = (unsigned short)qp; *(LAS unsigned short*)(lds + H_QT + (ts + 1) * 272 + kcol * 2) = (unsigned short)(qp >> 16);
                *(LAS unsigned short*)(lds + H_KT + ts * 272 + kcol * 2) = (unsigned short)ktp[i >> 1]; *(LAS unsigned short*)(lds + H_KT + (ts + 1) * 272 + kcol * 2) = (unsigned short)(ktp[i >> 1] >> 16); }
        }
        *(LAS u32x4*)(lds + H_KTT + kcol * 144 + seg * 32) = (u32x4){ktp[0], ktp[1], ktp[2], ktp[3]};
        *(LAS u32x4*)(lds + H_KTT + kcol * 144 + seg * 32 + 16) = (u32x4){ktp[4], ktp[5], ktp[6], ktp[7]};
        *(LAS u32x4*)(lds + H_VT + kcol * 144 + seg * 32) = (u32x4){vtp[0], vtp[1], vtp[2], vtp[3]};
        *(LAS u32x4*)(lds + H_VT + kcol * 144 + seg * 32 + 16) = (u32x4){vtp[4], vtp[5], vtp[6], vtp[7]};
        if (seg == 3) ((LAS float*)(lds + H_DEC))[kcol] = eb_last;
        { const int cn = (c + 1 < c_end) ? c + 1 : c; HG_LOAD(cn); }
        __syncthreads();
        const f32x4 dec = *(const LAS f32x4*)(lds + H_DEC + (16 * w + 4 * quad) * 4);
        dprod = dprod * dec;
        if (!full) {
#pragma unroll
            for (int ss = 0; ss < 2; ++ss) { const bf16x8 ka = *(const LAS bf16x8*)(lds + H_KTT + (16 * w + r16) * 144 + (32 * ss + 8 * quad) * 2);
#pragma unroll
                for (int vt = 0; vt < 8; ++vt) { const bf16x8 vb = *(const LAS bf16x8*)(lds + H_VT + (16 * vt + r16) * 144 + (32 * ss + 8 * quad) * 2); S[vt] = MFMA16(ka, vb, S[vt]); } }
#pragma unroll
            for (int vt = 0; vt < 8; ++vt) S[vt] = S[vt] * dec;
        } else {
        const int nt_ = tid >> 3, njj = tid & 7; const int tg = 64 * c + nt_;
        const size_t goff = ((size_t)(tg < TP ? b * TP + tg : MTOT + nt_)) * D + colbase + 16 * njj;
        const u32x4 g0 = __builtin_nontemporal_load((const u32x4*)(GB + goff)), g1 = __builtin_nontemporal_load((const u32x4*)(GB + goff + 8));
        bf16x8 qa[4];
#pragma unroll
        for (int ks = 0; ks < 4; ++ks) qa[ks] = *(const LAS bf16x8*)(lds + H_QT + (16 * tt + r16) * 272 + (32 * ks + 8 * quad) * 2);
        f32x4 O[4];
#pragma unroll
        for (int j = 0; j < 4; ++j) { O[j] = (f32x4){0.f, 0.f, 0.f, 0.f}; const int vt = 4 * vh + j;
#pragma unroll
            for (int ks = 0; ks < 4; ++ks) { const bf16x8 sb = *(const LAS bf16x8*)(lds + H_S0T + (16 * vt + r16) * 272 + (32 * ks + 8 * quad) * 2); O[j] = MFMA16(qa[ks], sb, O[j]); } }
#pragma unroll
        for (int j = 0; j < 2; ++j) { const int st = 2 * vh + j; f32x4 a = (f32x4){0.f, 0.f, 0.f, 0.f};
            if (st <= tt) {
#pragma unroll
                for (int ks = 0; ks < 4; ++ks) { const bf16x8 kb = *(const LAS bf16x8*)(lds + H_KT + (16 * st + r16) * 272 + (32 * ks + 8 * quad) * 2); a = MFMA16(qa[ks], kb, a); } }
#pragma unroll
            for (int r = 0; r < 4; ++r) { const int tl = 16 * tt + 4 * quad + r, sl = 16 * st + r16; const float val = (sl <= tl) ? a[r] : 0.f;
                *(LAS unsigned short*)(lds + H_AM + tl * 144 + sl * 2) = f2bf(val); } }
        __syncthreads();
#pragma unroll
        for (int ss = 0; ss < 2; ++ss) { const bf16x8 aa = *(const LAS bf16x8*)(lds + H_AM + (16 * tt + r16) * 144 + (32 * ss + 8 * quad) * 2);
#pragma unroll
            for (int j = 0; j < 4; ++j) { const int vt = 4 * vh + j; const bf16x8 vb = *(const LAS bf16x8*)(lds + H_VT + (16 * vt + r16) * 144 + (32 * ss + 8 * quad) * 2); O[j] = MFMA16(aa, vb, O[j]); } }
#pragma unroll
        for (int ss = 0; ss < 2; ++ss) { const bf16x8 ka = *(const LAS bf16x8*)(lds + H_KTT + (16 * w + r16) * 144 + (32 * ss + 8 * quad) * 2);
#pragma unroll
            for (int vt = 0; vt < 8; ++vt) { const bf16x8 vb = *(const LAS bf16x8*)(lds + H_VT + (16 * vt + r16) * 144 + (32 * ss + 8 * quad) * 2); S[vt] = MFMA16(ka, vb, S[vt]); } }
#pragma unroll
        for (int vt = 0; vt < 8; ++vt) { S[vt] = S[vt] * dec;
            *(LAS u32x2*)(lds + H_S0T + (16 * vt + r16) * 272 + (16 * w + 4 * quad) * 2) = (u32x2){pk2(S[vt].x, S[vt].y), pk2(S[vt].z, S[vt].w)}; }
#pragma unroll
        for (int j = 0; j < 4; ++j) { const int vt = 4 * vh + j;
#pragma unroll
            for (int r = 0; r < 4; ++r) ((LAS float*)lds)[(16 * tt + 4 * quad + r) * 132 + 16 * vt + r16] = O[j][r]; }
        __syncthreads();
        { const int t = nt_, jj = njj;
          f32x4 o4[4]; float ss = 0.f;
#pragma unroll
          for (int i = 0; i < 4; ++i) { o4[i] = *(const LAS f32x4*)(lds + (t * 132 + 16 * jj + 4 * i) * 4); ss += (o4[i].x * o4[i].x + o4[i].y * o4[i].y) + (o4[i].z * o4[i].z + o4[i].w * o4[i].w); }
          ss += __shfl_xor(ss, 1); ss += __shfl_xor(ss, 2); ss += __shfl_xor(ss, 4);
          const float rstd = rsqrtf(ss * (1.0f / 128.0f) + RMS_EPS);
          { const size_t off = goff;
              const unsigned gw_[8] = {g0.x, g0.y, g0.z, g0.w, g1.x, g1.y, g1.z, g1.w};
              unsigned ow[8];
#pragma unroll
              for (int i = 0; i < 4; ++i) { const f32x4 n4 = nw4[i];
                  const float y0 = o4[i].x * rstd * n4.x * bf2f((unsigned short)(gw_[2 * i] & 0xffffu)), y1 = o4[i].y * rstd * n4.y * bf2f((unsigned short)(gw_[2 * i] >> 16));
                  const float y2 = o4[i].z * rstd * n4.z * bf2f((unsigned short)(gw_[2 * i + 1] & 0xffffu)), y3 = o4[i].w * rstd * n4.w * bf2f((unsigned short)(gw_[2 * i + 1] >> 16));
                  ow[2 * i] = pk2(y0, y1); ow[2 * i + 1] = pk2(y2, y3); }
              *(u32x4*)(OB + off) = (u32x4){ow[0], ow[1], ow[2], ow[3]}; *(u32x4*)(OB + off + 8) = (u32x4){ow[4], ow[5], ow[6], ow[7]}; }
        }
        }
    }
#undef HG_LOAD
    if (!full || sg == 3) {
        float* so = full ? p.out + OUT_SP + ((size_t)(b * 16 + h)) * 16384 : HU + (size_t)item * 16384;
#pragma unroll
        for (int vt = 0; vt < 8; ++vt)
#pragma unroll
            for (int r = 0; r < 4; ++r) { float* d_ = so + (16 * w + 4 * quad + r) * 128 + 16 * vt + r16; if (full) __builtin_nontemporal_store(S[vt][r], d_); else *d_ = S[vt][r]; }
        if (!full && r16 == 0) *(f32x4*)(HD + item * 128 + 16 * w + 4 * quad) = dprod;
    }
    __syncthreads();
}

constexpr int SS_Q = 0, SS_K = 4096, SS_V = 8192, SS_E8 = 12288, SS_A = 12800, SS_B = 13056, SS_QR = 17152, SS_PART = 25600;
struct SampRaw { float lf[2]; unsigned short q[2], v[2]; f32x4 s0[8]; };
__device__ __forceinline__ void hgrn_sample_load(const Params& p, int it, SampRaw& r) {
    int tid_l = threadIdx.x; asm volatile("" : "+v"(tid_l)); const int tid = tid_l, b = it >> 4, h = it & 15;
    const bf16_t* QB = (const bf16_t*)(p.ws + WS_QB); const float* LF = (const float*)(p.ws + WS_LF); const bf16_t* VB = (const bf16_t*)(p.ws + WS_VB);
    const size_t rbase = ((size_t)(MPR + b * 8)) * D + h * 128;
#pragma unroll
    for (int j = 0; j < 2; ++j) { const int rem = tid + 512 * j, t = rem >> 7, k = rem & 127; const size_t o = rbase + (size_t)t * D + k; r.lf[j] = __builtin_nontemporal_load(LF + o); r.q[j] = __builtin_nontemporal_load(QB + o); r.v[j] = __builtin_nontemporal_load(VB + o); }
    { const int v4 = tid & 31, kg = tid >> 5; const float* S0 = p.state + ((size_t)(b * 16 + h)) * 16384;
#pragma unroll
      for (int i = 0; i < 8; ++i) r.s0[i] = __builtin_nontemporal_load((const f32x4*)(S0 + (8 * kg + i) * 128 + 4 * v4)); }
}
__device__ __forceinline__ void hgrn_sample_item(const Params& p, LAS unsigned char* lds, int it, int it_next, SampRaw& raw) {
    int tid_l = threadIdx.x; asm volatile("" : "+v"(tid_l)); const int tid = tid_l, lane = tid & 63;
    const int b = it >> 4, h = it & 15;
    const bf16_t* GB = (const bf16_t*)(p.ws + WS_GB); bf16_t* OB = (bf16_t*)(p.ws + WS_OB);
    const size_t rbase = ((size_t)(MPR + b * 8)) * D + h * 128;
    LAS float* SQ = (LAS float*)(lds + SS_Q); LAS float* SK = (LAS float*)(lds + SS_K); LAS float* SV = (LAS float*)(lds + SS_V); LAS float* SE8 = (LAS float*)(lds + SS_E8);
    LAS float* SA = (LAS float*)(lds + SS_A); LAS float* SB = (LAS float*)(lds + SS_B); LAS float* SQR = (LAS float*)(lds + SS_QR);
    LAS float* PART = (LAS float*)(lds + SS_PART);
    const int v4 = tid & 31, kg = tid >> 5;
    const float* S0 = p.state + ((size_t)(b * 16 + h)) * 16384; float* S1 = p.out + OUT_SS + ((size_t)(b * 16 + h)) * 16384;
    f32x4 s0[8];
#pragma unroll
    for (int i = 0; i < 8; ++i) s0[i] = raw.s0[i];
    const size_t goff3 = rbase + (size_t)(tid >> 6) * D + 2 * lane;
    const unsigned g3 = __builtin_nontemporal_load((const unsigned*)(GB + goff3)); const f32x2v nw3 = *(const f32x2v*)(p.norm_w + h * 128 + 2 * lane);
#pragma unroll
    for (int j = 0; j < 2; ++j) { const int rem = tid + 512 * j; SB[rem] = raw.lf[j]; SQR[rem] = bf2f(raw.q[j]); SV[rem] = bf2f(raw.v[j]); }
    __syncthreads();
    if (it_next < 2048) hgrn_sample_load(p, it_next, raw);
    if (tid < 128) { const int k = tid; float lfv[8], bt[8]; float run = 1.f;
#pragma unroll
        for (int t = 0; t < 8; ++t) { lfv[t] = SB[t * 128 + k]; run *= lfv[t]; bt[t] = run; }
#pragma unroll
        for (int t = 0; t < 8; ++t) { SQ[k * 8 + t] = SQR[t * 128 + k] * bt[t]; SK[k * 8 + t] = (1.0f - lfv[t]) * __builtin_amdgcn_rcpf(bt[t]); }
        SE8[k] = run;
    }
    __syncthreads();
    { const int pair = tid >> 3, ks = tid & 7, t = pair >> 3, s = pair & 7; float a = 0.f;
#pragma unroll
        for (int i = 0; i < 16; ++i) a += SQ[(ks + 8 * i) * 8 + t] * SK[(ks + 8 * i) * 8 + s];
        a += __shfl_xor(a, 1); a += __shfl_xor(a, 2); a += __shfl_xor(a, 4);
        if (ks == 0) SA[pair] = (s <= t) ? a : 0.f; }
    {
        f32x4 vv[8], o[8];
#pragma unroll
        for (int s = 0; s < 8; ++s) { vv[s] = *(const LAS f32x4*)(SV + s * 128 + 4 * v4); o[s] = (f32x4){0.f, 0.f, 0.f, 0.f}; }
#pragma unroll
        for (int i = 0; i < 8; ++i) { const int k = 8 * kg + i;
            const f32x4 qa = *(const LAS f32x4*)(SQ + k * 8), qb = *(const LAS f32x4*)(SQ + k * 8 + 4), ka = *(const LAS f32x4*)(SK + k * 8), kb = *(const LAS f32x4*)(SK + k * 8 + 4);
            const float q8[8] = {qa.x, qa.y, qa.z, qa.w, qb.x, qb.y, qb.z, qb.w}, k8[8] = {ka.x, ka.y, ka.z, ka.w, kb.x, kb.y, kb.z, kb.w};
            f32x4 sn = s0[i];
#pragma unroll
            for (int t = 0; t < 8; ++t) { o[t] = o[t] + s0[i] * q8[t]; sn = sn + vv[t] * k8[t]; }
            __builtin_nontemporal_store(sn * SE8[k], (f32x4*)(S1 + k * 128 + 4 * v4)); }
#pragma unroll
        for (int t = 0; t < 8; ++t) *(LAS f32x4*)(PART + (kg * 8 + t) * 128 + 4 * v4) = o[t];
    }
    __syncthreads();
    { const int t = tid >> 6, vp = lane; f32x2v o2 = (f32x2v){0.f, 0.f};
#pragma unroll
        for (int g = 0; g < 16; ++g) o2 = o2 + *(const LAS f32x2v*)(PART + (g * 8 + t) * 128 + 2 * vp);
#pragma unroll
        for (int s = 0; s < 8; ++s) o2 = o2 + *(const LAS f32x2v*)(SV + s * 128 + 2 * vp) * SA[t * 8 + s];
        float ss = o2.x * o2.x + o2.y * o2.y;
#pragma unroll
        for (int m = 1; m < 64; m <<= 1) ss += __shfl_xor(ss, m);
        const float rstd = rsqrtf(ss * (1.0f / 128.0f) + RMS_EPS);
        const size_t off = rbase + (size_t)t * D + 2 * vp;
        const unsigned g = g3; const f32x2v nw = nw3;
        *(unsigned*)(OB + off) = pk2(o2.x * rstd * nw.x * bf2f((unsigned short)(g & 0xffffu)), o2.y * rstd * nw.y * bf2f((unsigned short)(g >> 16))); }
    __syncthreads();
}

__device__ __forceinline__ void phase_hgrn(const Params& p, LAS unsigned char* lds, const XcdBarrier& xb) {
    const int G = gridDim.x, blk = blockIdx.x;
    const bool early = (G == 256) && ((blk & 3) == 3); constexpr int NEARLY = 64 * 6;
    const int s_lo = (G == 256) ? NEARLY : 0;
    const bool swap = (G == 256) && (((blk >> 2) & 1) != 0);
    for (int stage = 0; stage < 2; ++stage) {
        for (int k = 0; k < 2; ++k) {
            const bool do_chain = (stage == 0) ? (k == 0) : ((k == 0) != swap);
            if (do_chain) { for (int it = blk; it < 256; it += G) hgrn_chain(p, lds, it, stage); }
            else {
                int it, step, end;
                if (stage == 0) { it = early ? (blk >> 2) : 4096; step = 64; end = NEARLY; } else { it = s_lo + blk; step = G; end = 2048; }
                SampRaw raw; if (it < end) hgrn_sample_load(p, it, raw);
                for (; it < end; it += step) hgrn_sample_item(p, lds, it, (it + step < end) ? it + step : 4096, raw);
            }
        }
        if (stage == 0) xcd_barrier(xb);
    }
}

constexpr int A_KS = 0, A_VT = 23040;
constexpr int ATT_PROMPT_ITEMS = NBP * 4 * 65, ATT_ITEMS = ATT_PROMPT_ITEMS + NBS * 4;
struct AttPre { u32x4 r[3][4]; };
__device__ __forceinline__ void attn_load(const Params& p, int it, AttPre& pre) {
    const int tid = threadIdx.x;
    const bf16_t* K1 = (const bf16_t*)(p.ws + WS_K1); const bf16_t* V1 = (const bf16_t*)(p.ws + WS_V1);
    const bool samp = it >= ATT_PROMPT_ITEMS;
    int b, kvh, t0 = 0;
    if (!samp) { b = it / 260; const int rem = it - b * 260; kvh = rem / 65; t0 = 32 * (rem - kvh * 65); } else { const int j = it - ATT_PROMPT_ITEMS; b = j >> 2; kvh = j & 3; }
#pragma unroll
    for (int u = 0; u < 3; ++u) { const int idx = tid + 512 * u;
        const int kA = idx >> 3, cA = idx & 7;
        const int cB = idx / 160, kB = idx - 160 * cB;
        const u32x4 z = (u32x4){0u, 0u, 0u, 0u}; pre.r[u][0] = z; pre.r[u][1] = z; pre.r[u][2] = z; pre.r[u][3] = z;
        if (idx < 1280) {
            if (!samp) { const int pA = t0 - 128 + kA, pB = t0 - 128 + kB;
                if (pA >= 0 && pA < TP) pre.r[u][0] = *(const u32x4*)(K1 + ((size_t)(b * TP + pA)) * 256 + kvh * 64 + 8 * cA);
                if (pB >= 0 && pB < TP) pre.r[u][1] = *(const u32x4*)(V1 + ((size_t)(b * TP + pB)) * 256 + kvh * 64 + 8 * cB); }
            else {
                if (kA < 128) { const size_t o = (((size_t)b * 128 + kA) * 4 + kvh) * 64 + 8 * cA; pre.r[u][0] = *(const u32x4*)(p.cache_k + o); pre.r[u][1] = *(const u32x4*)(p.cache_k + o + 4); }
                else if (kA < 136) pre.r[u][0] = *(const u32x4*)(K1 + ((size_t)(MPR + b * 8 + kA - 128)) * 256 + kvh * 64 + 8 * cA);
                if (kB < 128) { const size_t o = (((size_t)b * 128 + kB) * 4 + kvh) * 64 + 8 * cB; pre.r[u][2] = *(const u32x4*)(p.cache_v + o); pre.r[u][3] = *(const u32x4*)(p.cache_v + o + 4); }
                else if (kB < 136) pre.r[u][2] = *(const u32x4*)(V1 + ((size_t)(MPR + b * 8 + kB - 128)) * 256 + kvh * 64 + 8 * cB);
            }
        } }
}
__device__ __forceinline__ void attn_stage(LAS unsigned char* base, int itp, const AttPre& pre) {
    const int tid = threadIdx.x; const bool samp = itp >= ATT_PROMPT_ITEMS;
#pragma unroll
    for (int u = 0; u < 3; ++u) { const int idx = tid + 512 * u;
        const int kA = idx >> 3, cA = idx & 7, cB = idx / 160, kB = idx - 160 * cB;
        if (idx < 1280) {
            u32x4 kv = pre.r[u][0], vv = samp ? pre.r[u][2] : pre.r[u][1];
            if (samp && kA < 128) { const f32x4 a = __builtin_bit_cast(f32x4, pre.r[u][0]), bq = __builtin_bit_cast(f32x4, pre.r[u][1]); kv = (u32x4){pk2(a.x, a.y), pk2(a.z, a.w), pk2(bq.x, bq.y), pk2(bq.z, bq.w)}; }
            if (samp && kB < 128) { const f32x4 c = __builtin_bit_cast(f32x4, pre.r[u][2]), d = __builtin_bit_cast(f32x4, pre.r[u][3]); vv = (u32x4){pk2(c.x, c.y), pk2(c.z, c.w), pk2(d.x, d.y), pk2(d.z, d.w)}; }
            *(LAS u32x4*)(base + A_KS + kA * 144 + cA * 16) = kv;
            const unsigned vw[4] = {vv.x, vv.y, vv.z, vv.w};
#pragma unroll
            for (int j = 0; j < 4; ++j) { *(LAS unsigned short*)(base + A_VT + (8 * cB + 2 * j) * 336 + kB * 2) = (unsigned short)(vw[j] & 0xffffu);
                *(LAS unsigned short*)(base + A_VT + (8 * cB + 2 * j + 1) * 336 + kB * 2) = (unsigned short)(vw[j] >> 16); }
        } }
}
constexpr int ATT_BUF = 44544;
__device__ __forceinline__ void attn_item(const Params& p, LAS unsigned char* lds_all, int it, int it_n1, int it_n2, int cur, AttPre& pre) {
    int tid_l = threadIdx.x; asm volatile("" : "+v"(tid_l)); const int tid = tid_l, w = tid >> 6, lane = tid & 63, r16 = lane & 15, quad = lane >> 4;
    LAS unsigned char* lds = lds_all + cur * ATT_BUF; LAS unsigned char* ldsn = lds_all + (cur ^ 1) * ATT_BUF;
    const bf16_t* Q1 = (const bf16_t*)(p.ws + WS_QB);
    const bf16_t* GB = (const bf16_t*)(p.ws + WS_GB); bf16_t* OB = (bf16_t*)(p.ws + WS_OB);
    const bool samp = it >= ATT_PROMPT_ITEMS;
    int b, kvh, t0 = 0;
    if (!samp) { b = it / 260; const int rem = it - b * 260; kvh = rem / 65; t0 = 32 * (rem - kvh * 65); } else { const int j = it - ATT_PROMPT_ITEMS; b = j >> 2; kvh = j & 3; }
    const int hq = kvh * 8 + w;
    const float sink_raw = p.sinks[hq];
    bf16x8 qf[2][2]; bool qok[2]; size_t qrow[2];
#pragma unroll
    for (int tt = 0; tt < 2; ++tt) { const int i = 16 * tt + r16;
        if (!samp) { const int t = t0 + i; qok[tt] = t < TP; qrow[tt] = (size_t)(b * TP + (qok[tt] ? t : 0)); } else { qok[tt] = i < 8; qrow[tt] = (size_t)(MPR + b * 8 + (qok[tt] ? i : 0)); }
#pragma unroll
        for (int ds = 0; ds < 2; ++ds) { bf16x8 q = __builtin_nontemporal_load((const bf16x8*)(Q1 + qrow[tt] * D + hq * 64 + 32 * ds + 8 * quad)); if (!qok[tt]) q = (bf16x8){0, 0, 0, 0, 0, 0, 0, 0}; qf[tt][ds] = q; } }
    u32x4 gw[4]; size_t orow[4]; bool ook[4];
#pragma unroll
    for (int k = 0; k < 4; ++k) { const int i = 8 * k + (lane >> 3);
        if (!samp) { const int t = t0 + i; ook[k] = t < TP; orow[k] = (size_t)(b * TP + (ook[k] ? t : 0)); } else { ook[k] = i < 8; orow[k] = (size_t)(MPR + b * 8 + (ook[k] ? i : 0)); }
        gw[k] = __builtin_nontemporal_load((const u32x4*)(GB + orow[k] * D + hq * 64 + 8 * (lane & 7))); }
    __syncthreads();
    f32x4 st[10][2];
#pragma unroll
    for (int kt = 0; kt < 10; ++kt) { st[kt][0] = (f32x4){0.f, 0.f, 0.f, 0.f}; st[kt][1] = (f32x4){0.f, 0.f, 0.f, 0.f};
#pragma unroll
        for (int ds = 0; ds < 2; ++ds) { const bf16x8 ka = *(const LAS bf16x8*)(lds + A_KS + (16 * kt + r16) * 144 + (32 * ds + 8 * quad) * 2);
            st[kt][0] = MFMA16(ka, qf[0][ds], st[kt][0]); if (!samp) st[kt][1] = MFMA16(ka, qf[1][ds], st[kt][1]); } }
    const float sink = sink_raw * 1.44269504089f;
    const int kminv = samp ? 0 : (128 - t0 > 0 ? 128 - t0 : 0);
    const bool midfree = kminv <= 32;
    const int ntt = samp ? 1 : 2;
    bf16x8 pb[5][2]; float inv[2] = {0.f, 0.f};
#pragma unroll
    for (int tt = 0; tt < 2; ++tt) if (tt < ntt) { const int i = 16 * tt + r16; const int lo = (i + 1 > kminv) ? i + 1 : kminv, hi = i + 128;
        float m = -INFINITY;
#pragma unroll
        for (int kt = 0; kt < 10; ++kt) {
            if (kt >= 2 && kt < 8 && midfree) {
#pragma unroll
                for (int r = 0; r < 4; ++r) m = fmaxf(m, st[kt][tt][r]);
            } else {
#pragma unroll
                for (int r = 0; r < 4; ++r) { const int kp = 16 * kt + 4 * quad + r; const float s = (kp >= lo && kp <= hi) ? st[kt][tt][r] : -INFINITY; st[kt][tt][r] = s; m = fmaxf(m, s); }
            } }
        m = fmaxf(m, __shfl_xor(m, 16)); m = fmaxf(m, __shfl_xor(m, 32)); m = fmaxf(m, sink);
        float sum = 0.f;
#pragma unroll
        for (int kt = 0; kt < 10; ++kt)
#pragma unroll
            for (int r = 0; r < 4; ++r) { const float e = __builtin_amdgcn_exp2f(st[kt][tt][r] - m); st[kt][tt][r] = e; sum += e; }
        sum += __shfl_xor(sum, 16); sum += __shfl_xor(sum, 32); sum += __builtin_amdgcn_exp2f(sink - m);
        inv[tt] = __builtin_amdgcn_rcpf(sum);
#pragma unroll
        for (int ks = 0; ks < 5; ++ks) { const f32x4 a = st[2 * ks][tt], c = st[2 * ks + 1][tt];
            const u32x4 pw = (u32x4){pk2(a.x, a.y), pk2(a.z, a.w), pk2(c.x, c.y), pk2(c.z, c.w)}; pb[ks][tt] = __builtin_bit_cast(bf16x8, pw); }
    }
    if (it_n1 < ATT_ITEMS) attn_stage(ldsn, it_n1, pre);
    if (it_n2 < ATT_ITEMS) attn_load(p, it_n2, pre);
    f32x4 o[4][2];
#pragma unroll
    for (int dt = 0; dt < 4; ++dt) { o[dt][0] = (f32x4){0.f, 0.f, 0.f, 0.f}; o[dt][1] = (f32x4){0.f, 0.f, 0.f, 0.f}; }
#pragma unroll
    for (int ks = 0; ks < 5; ++ks)
#pragma unroll
        for (int dt = 0; dt < 4; ++dt) { const u32x2 l8 = *(const LAS u32x2*)(lds + A_VT + (16 * dt + r16) * 336 + (32 * ks + 4 * quad) * 2), h8 = *(const LAS u32x2*)(lds + A_VT + (16 * dt + r16) * 336 + (32 * ks + 16 + 4 * quad) * 2);
            const bf16x8 va = __builtin_bit_cast(bf16x8, (u32x4){l8.x, l8.y, h8.x, h8.y});
            o[dt][0] = MFMA16(va, pb[ks][0], o[dt][0]); if (ntt > 1) o[dt][1] = MFMA16(va, pb[ks][1], o[dt][1]); }
    LAS unsigned char* os = lds_all + 2 * ATT_BUF + w * 4608;
#pragma unroll
    for (int tt = 0; tt < 2; ++tt) if (tt < ntt) {
#pragma unroll
        for (int dt = 0; dt < 4; ++dt) { const f32x4 x = o[dt][tt] * inv[tt];
            *(LAS u32x2*)(os + (16 * tt + r16) * 144 + (16 * dt + 4 * quad) * 2) = (u32x2){pk2(x.x, x.y), pk2(x.z, x.w)}; } }
    LDS_WAIT();
#pragma unroll
    for (int k = 0; k < 4; ++k) if (k < 2 * ntt) { const int i = 8 * k + (lane >> 3);
        const u32x4 ov = *(const LAS u32x4*)(os + i * 144 + (lane & 7) * 16);
        const unsigned ow_[4] = {ov.x, ov.y, ov.z, ov.w}, gg[4] = {gw[k].x, gw[k].y, gw[k].z, gw[k].w}; unsigned rr[4];
#pragma unroll
        for (int j = 0; j < 4; ++j) rr[j] = pk2(__uint_as_float(ow_[j] << 16) * __uint_as_float(gg[j] << 16), __uint_as_float(ow_[j] & 0xffff0000u) * __uint_as_float(gg[j] & 0xffff0000u));
        if (ook[k]) *(u32x4*)(OB + orow[k] * D + hq * 64 + 8 * (lane & 7)) = (u32x4){rr[0], rr[1], rr[2], rr[3]}; }
    LDS_WAIT();
}
__device__ __forceinline__ int att_item_of(int blk, int r, int G) {
    if (G != 256) return blk + r * G;
    const int x = blk & 7, j = blk >> 3;
    if (r < 6) return 256 * r + 32 * x + j;
    return (r == 6 && x == 1 && j < 16) ? 1536 + j : ATT_ITEMS;
}

__global__ void __launch_bounds__(512, 2) fwd_megakernel(Params p) {
    extern __shared__ __attribute__((aligned(16))) unsigned char shm[];
    LAS unsigned char* lds = (LAS unsigned char*)shm;
    const int G = gridDim.x;
    if (threadIdx.x < 4) ((LAS unsigned*)(lds + 131072))[threadIdx.x] = 0u;
    __syncthreads();
    const XcdBarrier xb = xcd_barrier_post((unsigned*)(p.ws + WS_BAR), (volatile LAS unsigned*)(lds + 131072));
    bf16_t* XB = (bf16_t*)(p.ws + WS_XB); bf16_t* OB = (bf16_t*)(p.ws + WS_OB); bf16_t* QB = (bf16_t*)(p.ws + WS_QB); bf16_t* VB = (bf16_t*)(p.ws + WS_VB); bf16_t* GB = (bf16_t*)(p.ws + WS_GB);
    float* ZB = (float*)(p.ws + WS_ZB);
    phase0(p, lds);
    xcd_barrier(xb);
    { pg8::Gemm g{XB, (const bf16_t*)(p.ws + WS_WT0), MPAD, 8192, 2048}; pg8::StaticOrder S; S.init(MPAD, 8192, G, blockIdx.x);
      EpiHgrnIn E{p.ws, (float*)(p.ws + WS_LF), (const float*)(p.ws + WS_LB)};
      pg8::gemm_phase<EpiHgrnIn, pg8::StaticOrder, false>(lds, g, S, E, nullptr);
      const int heavy = (37 * 32) % G; const int li = heavy ? (int)blockIdx.x - heavy : (int)blockIdx.x;
      if (li >= 0) phase0_rest(p, lds, li, heavy ? G - heavy : G); }
    xcd_barrier(xb);
    phase_hgrn(p, lds, xb);
    xcd_barrier(xb);
    { pg8::Gemm g{OB, (const bf16_t*)(p.ws + WS_WTO0), MPAD, 2048, 2048}; OrderOut S; S.init(G, blockIdx.x);
      EpiY E{VB, (float*)(p.ws + WS_LF)};
      pg8::gemm_phase<EpiY, OrderOut, false>(lds, g, S, E, nullptr); }
    xcd_barrier(xb);
    phase_ln<1>(p, 0);
    xcd_barrier(xb);
    { pg8::Gemm g{XB, (const bf16_t*)(p.ws + WS_WT1), MPAD, 4608, 2048}; pg8::StaticOrder S; S.init(MPAD, 4608, G, blockIdx.x);
      EpiSwaIn E{QB, (bf16_t*)(p.ws + WS_K1), (bf16_t*)(p.ws + WS_V1), GB, p.out};
      pg8::gemm_phase<EpiSwaIn, pg8::StaticOrder, false>(lds, g, S, E, nullptr);
      const int heavy = (37 * 18) % G; const int li = heavy ? (int)blockIdx.x - heavy : (int)blockIdx.x;
      if (li >= 0) phase_cache_shift(p, li, heavy ? G - heavy : G); }
    xcd_barrier(xb);
    { AttPre pre; int it = att_item_of(blockIdx.x, 0, G), n1 = att_item_of(blockIdx.x, 1, G);
      if (it < ATT_ITEMS) { attn_load(p, it, pre); attn_stage(lds, it, pre); }
      if (n1 < ATT_ITEMS) attn_load(p, n1, pre);
      for (int r = 0; it < ATT_ITEMS; ++r) { const int n2 = (n1 < ATT_ITEMS) ? att_item_of(blockIdx.x, r + 2, G) : ATT_ITEMS; attn_item(p, lds, it, n1, n2, r & 1, pre); it = n1; n1 = n2; } }
    xcd_barrier(xb);
    { pg8::Gemm g{OB, (const bf16_t*)(p.ws + WS_WTO1), MPAD, 2048, 2048}; OrderOut S; S.init(G, blockIdx.x);
      EpiY E{VB, (float*)(p.ws + WS_LF)};
      pg8::gemm_phase<EpiY, OrderOut, false>(lds, g, S, E, nullptr); }
    xcd_barrier(xb);
    for (int rep = 0; rep < REP_LN; ++rep) phase_ln<2>(p, 1);
}

extern "C" void kernel_launch(void* const* d_in, const int* in_sizes, int n_in, void* d_out, int out_size, void* d_ws, size_t ws_size, hipStream_t stream) {
    static int grid_blocks = 0;
    if (!grid_blocks) {
        int dev = 0, cus = 0, per_cu = 0;
        hipGetDevice(&dev);
        hipDeviceGetAttribute(&cus, hipDeviceAttributeMultiprocessorCount, dev);
        hipFuncSetAttribute((const void*)fwd_megakernel, hipFuncAttributeMaxDynamicSharedMemorySize, LDS_BYTES);
        hipOccupancyMaxActiveBlocksPerMultiprocessor(&per_cu, (const void*)fwd_megakernel, 512, LDS_BYTES);
        if (per_cu < 1) { fprintf(stderr, "kernel_launch: occupancy query reports %d blocks/CU\n", per_cu); per_cu = 1; }
        grid_blocks = cus;
    }
    if (ws_size < WS_END) { fprintf(stderr, "kernel_launch: workspace too small (%zu < %zu)\n", ws_size, (size_t)WS_END); return; }
    Params p{};
    p.x_prompt = (const float*)d_in[0]; p.x_sample = (const float*)d_in[1]; p.state = (const float*)d_in[2]; p.cache_k = (const float*)d_in[3]; p.cache_v = (const float*)d_in[4];
    p.meta = (const float*)d_in[5]; p.w_in0 = (const float*)d_in[6]; p.lb_logits = (const float*)d_in[7]; p.norm_w = (const float*)d_in[8]; p.w_out0 = (const float*)d_in[9];
    p.w_in1 = (const float*)d_in[10]; p.sinks = (const float*)d_in[11]; p.w_out1 = (const float*)d_in[12]; p.ln_g = (const float*)d_in[13]; p.ln_b = (const float*)d_in[14];
    p.out = (float*)d_out; p.ws = (unsigned char*)d_ws;
    if (hipMemsetAsync((char*)d_ws + WS_BAR, 0, 16384, stream) != hipSuccess) { fprintf(stderr, "kernel_launch: memset of the barrier words failed\n"); return; }
    void* args[] = {&p};
    hipError_t e = hipLaunchCooperativeKernel((const void*)fwd_megakernel, dim3(grid_blocks), dim3(512), args, LDS_BYTES, stream);
    if (e != hipSuccess) fprintf(stderr, "cooperative launch failed: %s (grid %d)\n", hipGetErrorString(e), grid_blocks);
}
```

```cpp
#include <hip/hip_runtime.h>
#include <hip/hip_cooperative_groups.h>
#include <cstdio>
#include <cstdint>
namespace pg8 {
#define PG8_LAS __attribute__((address_space(3)))
typedef unsigned short bf16_t;
typedef short bf16x8 __attribute__((ext_vector_type(8)));
typedef float f32x4 __attribute__((ext_vector_type(4)));
typedef unsigned u32x4 __attribute__((ext_vector_type(4)));
constexpr int BM = 256, BK = 64, HALF = 128, HTB = HALF * BK * 2  , STAGE_BYTES = 8 * HTB, NXCD = 8, WGM = 8;

__host__ __device__ __forceinline__ int lds_byte(int r, int c) { const int st = (r >> 4) * 2 + (c >> 5), rr = r & 15, cc = c & 31, ob = rr * 64 + cc * 2; return st * 1024 + (ob ^ (((ob >> 9) & 1) << 5)); }
__host__ __device__ __forceinline__ void stage_rc(int b, int& R, int& C) { const int st = b / 1024, sb = b % 1024, swz = sb ^ (((sb >> 9) & 1) << 5); R = (st >> 1) * 16 + swz / 64; C = (st & 1) * 32 + (swz % 64) / 2; }
__host__ __device__ __forceinline__ int perm32(int rho) { const int n = rho >> 4, i = rho & 15; return 8 * (i >> 2) + 4 * n + (i & 3); }

struct Unit { int pm, pn, kt0, nkt; };
struct Gemm { const bf16_t* A; const bf16_t* Bt; int M, N, K; };

struct StaticOrder {
    int reps = 1;
    int nM, nN, nwg, G, c, nkt, nfull, sk;
    __host__ __device__ void init(int M, int N, int G_, int c_, int K = 2048, int split = 0) { nM = M / BM; nN = N / BM; nwg = nM * nN; G = G_; c = c_; nkt = K / BK; nfull = nwg; sk = 1;
        if (split) { const int R = nwg / G, rem = nwg - R * G; if (rem > 0 && rem * 4 <= G && (nkt % 8) == 0) { nfull = R * G; sk = 4; } } }
    __host__ __device__ bool next(int i, Unit& u) const {
        if (reps > 1) { const int R = (nwg + G - 1) / G; if (i >= R * reps) return false; i = i % R; }
        long L = (long)i * G + c; u.kt0 = 0; u.nkt = nkt;
        if (L >= nfull && sk > 1) { if (L >= nfull + G) return false; const int j = (int)(L - nfull); L = nfull + j / sk; u.nkt = nkt / sk; u.kt0 = (j % sk) * u.nkt; }
        if (L >= nwg) return false;
        int wgid = (int)L; { const int q = nwg / NXCD, r = nwg % NXCD, xcd = wgid % NXCD, off = wgid / NXCD; wgid = (xcd < r ? xcd * (q + 1) : r * (q + 1) + (xcd - r) * q) + off; }
        const int nig = WGM * nN, gid = wgid / nig, fm = gid * WGM, gsz = (nM - fm) < WGM ? (nM - fm) : WGM;
        u.pm = fm + ((wgid % nig) % gsz); u.pn = (wgid % nig) / gsz; return true;
    }
    __device__ __forceinline__ void a_ready(const Unit&) const {}
    __device__ __forceinline__ void done(const Unit&) const {}
};
__device__ __forceinline__ unsigned cvt_pk_bf16(float lo, float hi) { unsigned r; asm volatile("v_cvt_pk_bf16_f32 %0, %1, %2" : "=v"(r) : "v"(lo), "v"(hi)); return r; }
template <class Epi, class Sched, bool STAMP = false>
__device__ __forceinline__ void gemm_phase(PG8_LAS unsigned char* lds, const Gemm g, const Sched& S, const Epi& E, unsigned long long* stamps) {
    int tid_l = threadIdx.x; asm volatile("" : "+v"(tid_l));
    const int tid = tid_l, wid = __builtin_amdgcn_readfirstlane(tid >> 6), lane = tid & 63, wr = wid >> 2, wc = wid & 3, fr = lane & 15, fq = lane >> 4;
    const int K = g.K;
    int ts_lo = 0, ts_hi = 0, nts = 0; const unsigned long long rt_entry = STAMP ? (unsigned long long)wall_clock64() : 0ull;
#define PG8_STAMP() do { if (STAMP && wid == 0 && nts < 64) { const unsigned long long _c = (unsigned long long)clock64(); \
        ts_lo = (lane == nts) ? (int)(unsigned)_c : ts_lo; ts_hi = (lane == nts) ? (int)(unsigned)(_c >> 32) : ts_hi; ++nts; } } while (0)
    PG8_STAMP();
    unsigned voffA[2], voffB[2];
#pragma unroll
    for (int i = 0; i < 2; ++i) { int R, C; stage_rc(tid * 16 + i * 8192, R, C); const int Rb = Epi::PERM ? ((R & ~31) + perm32(R & 31)) : R;
        voffA[i] = (unsigned)(R * K + C) * 2u; voffB[i] = (unsigned)(Rb * K + C) * 2u; }
    const size_t kstep = (size_t)(BK * 2);
    const size_t hstep = (size_t)HALF * K * 2;
    const size_t tstep = 2 * hstep;
    const unsigned ldsw = (unsigned)wid * 1024u;
    const int aoff = lds_byte(wr * 64 + fr, fq * 8), boff = lds_byte(wc * 32 + fr, fq * 8);
#define PG8_SA(b, h) (((b) * 2 + (h)) * HTB)
#define PG8_SB(b, h) ((4 + (b) * 2 + (h)) * HTB)
#define PG8_STAGE(bufoff, gbase, voff) do { _Pragma("unroll") for (int _i = 0; _i < 2; ++_i) \
        __builtin_amdgcn_global_load_lds((const unsigned*)((const char*)(gbase) + (voff)[_i]), (PG8_LAS unsigned*)(lds + (bufoff) + ldsw + _i * 8192), 16, 0, 0); } while (0)
#define PG8_LDA(dst, b, h) do { _Pragma("unroll") for (int m = 0; m < 4; ++m) _Pragma("unroll") for (int k = 0; k < 2; ++k) dst[m][k] = *(const PG8_LAS bf16x8*)(lds + PG8_SA(b, h) + aoff + m * 2048 + k * 1024); } while (0)
#define PG8_LDB(dst, b, h) do { _Pragma("unroll") for (int n = 0; n < 2; ++n) _Pragma("unroll") for (int k = 0; k < 2; ++k) dst[n][k] = *(const PG8_LAS bf16x8*)(lds + PG8_SB(b, h) + boff + n * 2048 + k * 1024); } while (0)
#define PG8_MMA(ai, bj, At, Bt) do { __builtin_amdgcn_s_setprio(1); _Pragma("unroll") for (int m = 0; m < 4; ++m) _Pragma("unroll") for (int n = 0; n < 2; ++n) _Pragma("unroll") for (int k = 0; k < 2; ++k) \
        acc[ai][bj][m][n] = __builtin_amdgcn_mfma_f32_16x16x32_bf16(Bt[n][k], At[m][k], acc[ai][bj][m][n], 0, 0, 0); __builtin_amdgcn_s_setprio(0); } while (0)
#define PG8_WAIT_V(n) asm volatile("s_waitcnt vmcnt(" #n ")" ::: "memory")
#define PG8_WAIT_L(n) asm volatile("s_waitcnt lgkmcnt(" #n ")" ::: "memory")
#define PG8_BAR __builtin_amdgcn_s_barrier()
#define PG8_SCHED __builtin_amdgcn_sched_barrier(0)
    Unit cur, nxt; int ui = 0;
    if (!S.next(0, cur)) return;
    f32x4 acc[2][2][4][2];
#pragma unroll
    for (int a = 0; a < 2; ++a)
#pragma unroll
        for (int b = 0; b < 2; ++b)
#pragma unroll
            for (int m = 0; m < 4; ++m)
#pragma unroll
                for (int n = 0; n < 2; ++n) acc[a][b][m][n] = (f32x4){0.f, 0.f, 0.f, 0.f};
    bf16x8 At[4][2], B0[2][2], B1[2][2];
    const char* cA = (const char*)g.A + (size_t)cur.pm * tstep + (size_t)cur.kt0 * kstep; const char* cB = (const char*)g.Bt + (size_t)cur.pn * tstep + (size_t)cur.kt0 * kstep;
    int nt = cur.nkt;
    S.a_ready(cur);
    PG8_STAGE(PG8_SB(0, 0), cB, voffB); PG8_STAGE(PG8_SB(0, 1), cB + hstep, voffB); PG8_STAGE(PG8_SA(0, 0), cA, voffA); PG8_STAGE(PG8_SA(0, 1), cA + hstep, voffA);
    if (wr == 1) PG8_BAR;
    PG8_WAIT_V(2); PG8_BAR;
    PG8_STAGE(PG8_SB(1, 0), cB + kstep, voffB); PG8_STAGE(PG8_SA(1, 0), cA + kstep, voffA); PG8_STAGE(PG8_SB(1, 1), cB + hstep + kstep, voffB);
    PG8_WAIT_V(6); PG8_BAR;
    PG8_STAMP();
    for (;;) {
        const bool has_next = S.next(ui + 1, nxt);
        const char* nA = has_next ? (const char*)g.A + (size_t)nxt.pm * tstep + (size_t)nxt.kt0 * kstep : cA; const char* nB = has_next ? (const char*)g.Bt + (size_t)nxt.pn * tstep + (size_t)nxt.kt0 * kstep : cB;
        for (int t = 0; t < nt; t += 2) {
            const bool last = (t == nt - 2);
            const char* a1 = cA + (size_t)(t + 1) * kstep;
            const char* a2 = last ? nA : cA + (size_t)(t + 2) * kstep; const char* b2 = last ? nB : cB + (size_t)(t + 2) * kstep;
            const char* a3 = a2 + kstep; const char* b3 = b2 + kstep;
            if (last && has_next) S.a_ready(nxt);
            PG8_LDB(B0, 0, 0); PG8_LDB(B1, 0, 1); PG8_SCHED; PG8_LDA(At, 0, 0); PG8_STAGE(PG8_SA(1, 1), a1 + hstep, voffA);
            PG8_WAIT_V(8); PG8_WAIT_L(0); PG8_BAR; PG8_MMA(0, 0, At, B0); PG8_MMA(0, 1, At, B1); PG8_BAR; PG8_SCHED;
            PG8_LDA(At, 0, 1); PG8_STAGE(PG8_SB(0, 0), b2, voffB); PG8_STAGE(PG8_SB(0, 1), b2 + hstep, voffB); PG8_STAGE(PG8_SA(0, 0), a2, voffA);
            PG8_WAIT_V(8); PG8_WAIT_L(0); PG8_BAR; PG8_MMA(1, 0, At, B0); PG8_MMA(1, 1, At, B1); PG8_BAR; PG8_SCHED;
            PG8_LDB(B0, 1, 0); PG8_LDB(B1, 1, 1); PG8_SCHED; PG8_LDA(At, 1, 0); PG8_STAGE(PG8_SA(0, 1), a2 + hstep, voffA);
            PG8_WAIT_V(8); PG8_WAIT_L(0); PG8_BAR; PG8_MMA(0, 0, At, B0); PG8_MMA(0, 1, At, B1); PG8_BAR; PG8_SCHED;
            PG8_LDA(At, 1, 1); PG8_STAGE(PG8_SB(1, 0), b3, voffB); PG8_STAGE(PG8_SB(1, 1), b3 + hstep, voffB); PG8_STAGE(PG8_SA(1, 0), a3, voffA);
            PG8_WAIT_V(8); PG8_WAIT_L(0); PG8_BAR; PG8_MMA(1, 0, At, B0); PG8_MMA(1, 1, At, B1); PG8_BAR; PG8_SCHED;
        }
        PG8_STAMP();
        if (wr == 0) PG8_BAR;
        if constexpr (!Epi::AFTER_DRAIN) { E(acc, cur, wr, wc, fr, fq); S.done(cur); }
        PG8_STAMP();
        if (!has_next) break;
#pragma unroll
        for (int a = 0; a < 2; ++a)
#pragma unroll
            for (int b = 0; b < 2; ++b)
#pragma unroll
                for (int m = 0; m < 4; ++m)
#pragma unroll
                    for (int n = 0; n < 2; ++n) acc[a][b][m][n] = (f32x4){0.f, 0.f, 0.f, 0.f};
        cur = nxt; cA = nA; cB = nB; ++ui; nt = cur.nkt;
        if (wr == 1) PG8_BAR;
    }
    PG8_WAIT_V(0);
    PG8_BAR;
    if constexpr (Epi::AFTER_DRAIN) { E.fused(acc, cur, wr, wc, fr, fq, lds, wid, lane); S.done(cur); }
    PG8_STAMP();
    if (STAMP && wid == 0) { stamps[lane] = lane < nts ? (((unsigned long long)(unsigned)ts_hi << 32) | (unsigned)ts_lo) : 0ull;
        if (lane == 62) stamps[62] = rt_entry; if (lane == 63) stamps[63] = (unsigned long long)wall_clock64(); }
#undef PG8_STAMP
#undef PG8_SA
#undef PG8_SB
#undef PG8_STAGE
#undef PG8_LDA
#undef PG8_LDB
#undef PG8_MMA
#undef PG8_WAIT_V
#undef PG8_WAIT_L
#undef PG8_BAR
#undef PG8_SCHED
}
}
#define LAS __attribute__((address_space(3)))
#include <vector>

#define XB_TMO      128
#define XB_XCNT(j)  (256  + 64 * (j))
#define XB_XSUB(j)  (1280 + 64 * (j))
#define XB_XGEN(j)  (2304 + 64 * (j))
#define XB_TOP      3328
#define XB_TOPGEN   3392
#define XCD_BAR_WORDS 3456
#define XB_SPIN_CAP (1u << 18)

__device__ __forceinline__ unsigned xb_ld(unsigned* p)              { return __hip_atomic_load(p, __ATOMIC_RELAXED, __HIP_MEMORY_SCOPE_AGENT); }
__device__ __forceinline__ unsigned xb_add(unsigned* p, unsigned v) { return __hip_atomic_fetch_add(p, v, __ATOMIC_RELAXED, __HIP_MEMORY_SCOPE_AGENT); }
__device__ __forceinline__ unsigned xb_xcc_id() { return (unsigned)__builtin_amdgcn_s_getreg((3 << 11) | 20) & 0xFu; }
#define XB_SPIN(cond, bar) do { unsigned _sp = 0; while (cond) { __builtin_amdgcn_s_sleep(1); \
    if ((++_sp & 255u) == 0u) { if (xb_ld(&(bar)[XB_TMO])) break; if (_sp > XB_SPIN_CAP) { atomicAdd(&(bar)[XB_TMO], 1u); break; } } } } while (0)

struct XcdBarrier {
    unsigned* bar; unsigned x;
    volatile LAS unsigned* st;
};

__device__ __forceinline__ XcdBarrier xcd_barrier_post(unsigned* bar, volatile LAS unsigned* st) {
    XcdBarrier b; b.bar = bar; b.x = xb_xcc_id(); b.st = st;
    if (threadIdx.x == 0) (void)xb_add(&bar[XB_XCNT(b.x)], 1u);
    return b;
}
__device__ __forceinline__ void xcd_barrier_complete(unsigned* bar, unsigned x, unsigned& nloc, unsigned& nx) {
    const unsigned G = gridDim.x * gridDim.y * gridDim.z;
    unsigned sum, cnt, mine, sp = 0u;
    for (;;) {
        sum = 0u; cnt = 0u; mine = 0u;
#pragma unroll
        for (unsigned j = 0; j < 16; ++j) { const unsigned c = xb_ld(&bar[XB_XCNT(j)]); sum += c; cnt += (c > 0u) ? 1u : 0u; mine = (j == x) ? c : mine; }
        if (sum == G) break;
        __builtin_amdgcn_s_sleep(1);
        if ((++sp & 255u) == 0u) { if (xb_ld(&bar[XB_TMO])) break; if (sp > XB_SPIN_CAP) { atomicAdd(&bar[XB_TMO], 1u); break; } }
    }
    nloc = mine > 0u ? mine : 1u; nx = cnt > 0u ? cnt : 1u;
}

__device__ __forceinline__ void xcd_barrier(const XcdBarrier& b) {
    asm volatile("s_waitcnt vmcnt(0)" ::: "memory");
    __syncthreads();
    if (threadIdx.x == 0) {
        unsigned* bar = b.bar;
        __builtin_amdgcn_s_waitcnt(0);
        unsigned nloc = b.st[0], nx = b.st[1];
        if (nloc == 0u) { xcd_barrier_complete(bar, b.x, nloc, nx); b.st[0] = nloc; b.st[1] = nx; }
        const unsigned old = xb_add(&bar[XB_XSUB(b.x)], 1u);
        const unsigned gen = old / nloc;
        if (old + 1u == (gen + 1u) * nloc) {
            __builtin_amdgcn_fence(__ATOMIC_RELEASE, "agent");
            asm volatile("s_waitcnt vmcnt(0)" ::: "memory");
            const unsigned og = xb_add(&bar[XB_TOP], 1u);
            const unsigned tg = og / nx;
            if (og + 1u == (tg + 1u) * nx) xb_add(&bar[XB_TOPGEN], 1u);
            else XB_SPIN(xb_ld(&bar[XB_TOPGEN]) == tg, bar);
            __builtin_amdgcn_fence(__ATOMIC_ACQUIRE, "agent");
            xb_add(&bar[XB_XGEN(b.x)], 1u);
            asm volatile("s_waitcnt vmcnt(0)" ::: "memory");
        } else {
            XB_SPIN(xb_ld(&bar[XB_XGEN(b.x)]) == gen, bar);
            __builtin_amdgcn_fence(__ATOMIC_ACQUIRE, "agent");
            asm volatile("s_waitcnt vmcnt(0)" ::: "memory");
        }
    }
    __syncthreads();
}
namespace cg = cooperative_groups;
using pg8::bf16_t; using pg8::bf16x8; using pg8::f32x4; using pg8::u32x4;

typedef unsigned u32x2 __attribute__((ext_vector_type(2)));
typedef float f32x2v __attribute__((ext_vector_type(2)));

constexpr int D = 2048, TP = 2064, NBP = 4, MPR = NBP * TP, NBS = 128, TSM = 8, MSM = NBS * TSM, MTOT = MPR + MSM, MPAD = 9472;
constexpr float ALPHA = 1.41421356237309515f;
#ifndef REP_P0
#define REP_P0 1
#endif
#ifndef REP_HGRN
#define REP_HGRN 1
#endif
#ifndef REP_ATT
#define REP_ATT 1
#endif
#ifndef REP_LN
#define REP_LN 1
#endif
#ifndef REP_G1
#define REP_G1 1
#endif
#ifndef REP_G2
#define REP_G2 1
#endif
constexpr float LN_EPS = 1e-5f, RMS_EPS = 1e-6f;
constexpr int LDS_BYTES = 131072 + 64;
constexpr size_t OUT_YP = 0, OUT_YS = 16777216, OUT_SP = 18874368, OUT_SS = 19922944, OUT_KP = 53477376, OUT_VP = 53608448, OUT_KS = 53739520, OUT_VS = 57933824;
constexpr size_t SZ_BF = (size_t)MPAD * D * 2, SZ_F32 = (size_t)MPAD * D * 4;
constexpr size_t WS_WT0 = 0, WS_WTO0 = WS_WT0 + 33554432, WS_WT1 = WS_WTO0 + 8388608, WS_WTO1 = WS_WT1 + 18874368, WS_XB = WS_WTO1 + 8388608,
                 WS_QB = WS_XB + SZ_BF, WS_VB = WS_QB + SZ_BF, WS_GB = WS_VB + SZ_BF, WS_OB = WS_GB + SZ_BF, WS_LF = WS_OB + SZ_BF, WS_ZB = WS_LF + SZ_F32,
                 WS_K1 = WS_ZB + SZ_F32, WS_V1 = WS_K1 + 4849664, WS_LB = WS_V1 + 4849664, WS_BAR = WS_LB + 8192, WS_HU = WS_BAR + 16384, WS_HD = WS_HU + 256 * 65536, WS_END = WS_HD + 256 * 512;

struct Params {
    const float *x_prompt, *x_sample, *state, *cache_k, *cache_v, *meta, *w_in0, *lb_logits, *norm_w, *w_out0, *w_in1, *sinks, *w_out1, *ln_g, *ln_b;
    float* out; unsigned char* ws;
};

__device__ __forceinline__ float bf2f(unsigned short b) { return __uint_as_float(((unsigned)b) << 16); }
__device__ __forceinline__ unsigned short f2bf(float f) { unsigned u = __float_as_uint(f); u += 0x7FFFu + ((u >> 16) & 1u); return (unsigned short)(u >> 16); }
__device__ __forceinline__ unsigned pk2(float lo, float hi) { return pg8::cvt_pk_bf16(lo, hi); }
__device__ __forceinline__ float sigmoidf_(float x) { return __builtin_amdgcn_rcpf(1.0f + __builtin_amdgcn_exp2f(x * -1.44269504089f)); }
__device__ __forceinline__ float siluf_(float x) { return x * __builtin_amdgcn_rcpf(1.0f + __builtin_amdgcn_exp2f(x * -1.44269504089f)); }
#define LDS_WAIT() asm volatile("s_waitcnt lgkmcnt(0)" ::: "memory")

__device__ __forceinline__ const float* xrow_ptr(const Params& p, int row) {
    if (row < MPR) { const int b = row / TP, t = row - b * TP; return t < 16 ? p.meta + (size_t)t * D : p.x_prompt + ((size_t)b * 2048 + (t - 16)) * D; }
    return p.x_sample + (size_t)(row - MPR) * D;
}

__device__ __forceinline__ void p0_transpose_item(const float* __restrict__ W, int K, int N, bf16_t* __restrict__ WT, LAS float* scr, int item, int lane) {
    const int nblk = N / 32, kb = item / nblk, nb = item % nblk, k0 = 64 * kb, n0 = 32 * nb;
    f32x4 wv[8];
#pragma unroll
    for (int i = 0; i < 8; ++i) wv[i] = __builtin_nontemporal_load((const f32x4*)(W + (size_t)(k0 + 8 * i + (lane >> 3)) * N + n0 + 4 * (lane & 7)));
#pragma unroll
    for (int i = 0; i < 8; ++i) { LAS float* d_ = scr + (8 * i + (lane >> 3)) * 33 + 4 * (lane & 7); d_[0] = wv[i].x; d_[1] = wv[i].y; d_[2] = wv[i].z; d_[3] = wv[i].w; }
    LDS_WAIT();
    const int c = lane & 7;
#pragma unroll
    for (int j = 0; j < 4; ++j) { const int n = (lane >> 3) + 8 * j; const LAS float* s = scr + (8 * c) * 33 + n;
        u32x4 o; o.x = pk2(s[0 * 33], s[1 * 33]); o.y = pk2(s[2 * 33], s[3 * 33]); o.z = pk2(s[4 * 33], s[5 * 33]); o.w = pk2(s[6 * 33], s[7 * 33]);
        *(u32x4*)(WT + (size_t)(n0 + n) * K + k0 + 8 * c) = o; }
    LDS_WAIT();
}

__device__ __forceinline__ void phase0(const Params& p, LAS unsigned char* lds) {
    int tid_l = threadIdx.x; asm volatile("" : "+v"(tid_l)); const int tid = tid_l, wave = tid >> 6, lane = tid & 63;
    const int NGW = gridDim.x * 8, gw = wave * gridDim.x + blockIdx.x;
    LAS float* scr = (LAS float*)(lds + wave * 8448);
    constexpr int I0 = 32 * 256;
    bf16_t* WT0 = (bf16_t*)(p.ws + WS_WT0);
    for (int it = gw; it < I0; it += NGW) p0_transpose_item(p.w_in0, 2048, 8192, WT0, scr, it, lane);
    bf16_t* XB = (bf16_t*)(p.ws + WS_XB);
    { f32x4 xv[8];
      if (gw < MTOT) { const f32x4* s0_ = (const f32x4*)xrow_ptr(p, gw) + lane;
#pragma unroll
          for (int j = 0; j < 8; ++j) xv[j] = __builtin_nontemporal_load(s0_ + 64 * j); }
      for (int m = gw; m < MTOT; m += NGW) {
          u32x2* dst = (u32x2*)(XB + (size_t)m * D) + lane; u32x2 o[8];
#pragma unroll
          for (int j = 0; j < 8; ++j) { o[j].x = pk2(xv[j].x, xv[j].y); o[j].y = pk2(xv[j].z, xv[j].w); }
          if (m + NGW < MTOT) { const f32x4* sn_ = (const f32x4*)xrow_ptr(p, m + NGW) + lane;
#pragma unroll
              for (int j = 0; j < 8; ++j) xv[j] = __builtin_nontemporal_load(sn_ + 64 * j); }
#pragma unroll
          for (int j = 0; j < 8; ++j) dst[64 * j] = o[j];
      } }
    const int gt = blockIdx.x * 512 + tid, NGT = gridDim.x * 512;
    float* LB = (float*)(p.ws + WS_LB);
    for (int c = gt; c < D; c += NGT) { const float a = p.lb_logits[c], b = p.lb_logits[D + c], cc = p.lb_logits[2 * D + c]; const float m = fmaxf(a, fmaxf(b, cc));
        const float ea = __expf(a - m), eb = __expf(b - m), ec = __expf(cc - m); LB[c] = ea / (ea + eb + ec); }
}
__device__ __forceinline__ void phase0_rest(const Params& p, LAS unsigned char* lds, int li, int nl) {
    int tid_l = threadIdx.x; asm volatile("" : "+v"(tid_l)); const int tid = tid_l, wave = tid >> 6, lane = tid & 63;
    const int gw = li * 8 + wave, NGW = nl * 8;
    LAS float* scr = (LAS float*)(lds + wave * 8448);
    constexpr int I1 = 32 * 64, I2 = 32 * 144, I3 = 32 * 64;
    bf16_t* WTO0 = (bf16_t*)(p.ws + WS_WTO0); bf16_t* WT1 = (bf16_t*)(p.ws + WS_WT1); bf16_t* WTO1 = (bf16_t*)(p.ws + WS_WTO1);
    for (int it = gw; it < I1 + I2 + I3; it += NGW) {
        int r = it;
        if (r < I1) { p0_transpose_item(p.w_out0, 2048, 2048, WTO0, scr, r, lane); continue; } r -= I1;
        if (r < I2) { p0_transpose_item(p.w_in1, 2048, 4608, WT1, scr, r, lane); continue; } r -= I2;
        p0_transpose_item(p.w_out1, 2048, 2048, WTO1, scr, r, lane);
    }
}
__device__ __forceinline__ void phase_cache_shift(const Params& p, int li, int nl) {
    const int gt = li * 512 + threadIdx.x, NGT = nl * 512;
    const f32x4* ck = (const f32x4*)p.cache_k; const f32x4* cv = (const f32x4*)p.cache_v; f32x4* ok = (f32x4*)(p.out + OUT_KS); f32x4* ov = (f32x4*)(p.out + OUT_VS);
    constexpr int PER_B = 120 * 64;
    for (int i0 = gt; i0 < NBS * PER_B; i0 += 4 * NGT) { f32x4 a[4], c[4]; size_t o[4]; bool ok_[4];
#pragma unroll
        for (int u = 0; u < 4; ++u) { const int i = i0 + u * NGT; ok_[u] = i < NBS * PER_B; const int ii = ok_[u] ? i : 0; const int b = ii / PER_B, r = ii - b * PER_B; o[u] = (size_t)b * 8192 + r;
            a[u] = __builtin_nontemporal_load(ck + o[u] + 512); c[u] = __builtin_nontemporal_load(cv + o[u] + 512); }
#pragma unroll
        for (int u = 0; u < 4; ++u) if (ok_[u]) { __builtin_nontemporal_store(a[u], ok + o[u]); __builtin_nontemporal_store(c[u], ov + o[u]); } }
}

struct EpiHgrnIn {
    static constexpr bool PERM = true, AFTER_DRAIN = false;
    unsigned char* ws; float* LF; const float* LB;
    __device__ __forceinline__ void operator()(const f32x4 (&acc)[2][2][4][2], const pg8::Unit& u, int wr, int wc, int fr, int fq) const {
        const int sec = u.pn >> 3, colt = (u.pn & 7) * 256;
        const size_t secoff = sec == 0 ? WS_QB : (sec == 2 ? WS_VB : WS_GB);
        bf16_t* dst = (bf16_t*)(ws + secoff);
        const int row0 = u.pm * 256 + wr * 64 + fr, col0 = colt + wc * 32 + 8 * fq;
        float lb[2][8];
        if (sec == 1) {
#pragma unroll
            for (int bj = 0; bj < 2; ++bj) { const f32x4 a = *(const f32x4*)(LB + col0 + bj * 128), b = *(const f32x4*)(LB + col0 + bj * 128 + 4);
                lb[bj][0] = a.x; lb[bj][1] = a.y; lb[bj][2] = a.z; lb[bj][3] = a.w; lb[bj][4] = b.x; lb[bj][5] = b.y; lb[bj][6] = b.z; lb[bj][7] = b.w; }
        }
#pragma unroll
        for (int ai = 0; ai < 2; ++ai)
#pragma unroll
            for (int m = 0; m < 4; ++m) {
                const int row = row0 + ai * 128 + m * 16; if (row >= MTOT) continue;
#pragma unroll
                for (int bj = 0; bj < 2; ++bj) {
                    const size_t off = (size_t)row * D + col0 + bj * 128;
                    const f32x4 v0 = acc[ai][bj][m][0], v1 = acc[ai][bj][m][1];
                    float x[8] = {v0.x, v0.y, v0.z, v0.w, v1.x, v1.y, v1.z, v1.w};
                    if (sec == 1) {
#pragma unroll
                        for (int j = 0; j < 8; ++j) { const float l = lb[bj][j]; x[j] = l + (1.0f - l) * sigmoidf_(x[j]); }
                        *(f32x4*)(LF + off) = (f32x4){x[0], x[1], x[2], x[3]}; *(f32x4*)(LF + off + 4) = (f32x4){x[4], x[5], x[6], x[7]};
                    } else {
                        if (sec == 3) {
#pragma unroll
                            for (int j = 0; j < 8; ++j) x[j] = siluf_(x[j]);
                        }
                        u32x4 w; w.x = pk2(x[0], x[1]); w.y = pk2(x[2], x[3]); w.z = pk2(x[4], x[5]); w.w = pk2(x[6], x[7]);
                        *(u32x4*)(dst + off) = w;
                    }
                }
            }
    }
};
struct EpiSwaIn {
    static constexpr bool PERM = true, AFTER_DRAIN = false;
    bf16_t* Q; bf16_t* K1; bf16_t* V1; bf16_t* G; float* out;
    __device__ __forceinline__ void operator()(const f32x4 (&acc)[2][2][4][2], const pg8::Unit& u, int wr, int wc, int fr, int fq) const {
        const int pn = u.pn;
        const int row0 = u.pm * 256 + wr * 64 + fr, cw = wc * 32 + 8 * fq;
#pragma unroll
        for (int ai = 0; ai < 2; ++ai)
#pragma unroll
            for (int m = 0; m < 4; ++m) {
                const int row = row0 + ai * 128 + m * 16; if (row >= MTOT) continue;
#pragma unroll
                for (int bj = 0; bj < 2; ++bj) {
                    const f32x4 v0 = acc[ai][bj][m][0], v1 = acc[ai][bj][m][1];
                    float x[8] = {v0.x, v0.y, v0.z, v0.w, v1.x, v1.y, v1.z, v1.w};
                    const int c = cw + bj * 128;
                    if (pn < 8) {
                        constexpr float QS = 0.125f * 1.44269504089f;
                        u32x4 w; w.x = pk2(x[0] * QS, x[1] * QS); w.y = pk2(x[2] * QS, x[3] * QS); w.z = pk2(x[4] * QS, x[5] * QS); w.w = pk2(x[6] * QS, x[7] * QS);
                        *(u32x4*)(Q + (size_t)row * D + pn * 256 + c) = w;
                    } else if (pn >= 10) {
#pragma unroll
                        for (int j = 0; j < 8; ++j) x[j] = siluf_(x[j]);
                        u32x4 w; w.x = pk2(x[0], x[1]); w.y = pk2(x[2], x[3]); w.z = pk2(x[4], x[5]); w.w = pk2(x[6], x[7]);
                        *(u32x4*)(G + (size_t)row * D + (pn - 10) * 256 + c) = w;
                    } else {
                        u32x4 w; w.x = pk2(x[0], x[1]); w.y = pk2(x[2], x[3]); w.z = pk2(x[4], x[5]); w.w = pk2(x[6], x[7]);
                        bf16_t* dst = pn == 8 ? K1 : V1;
                        *(u32x4*)(dst + (size_t)row * 256 + c) = w;
                        float* co = nullptr;
                        if (row < MPR) { const int b = row / TP, t = row - b * TP; if (t >= TP - 128) co = out + (pn == 8 ? OUT_KP : OUT_VP) + ((size_t)b * 128 + (t - (TP - 128))) * 256 + c; }
                        else { const int r = row - MPR, b = r >> 3, t = r & 7; co = out + (pn == 8 ? OUT_KS : OUT_VS) + ((size_t)b * 128 + 120 + t) * 256 + c; }
                        if (co) { __builtin_nontemporal_store(v0, (f32x4*)co); __builtin_nontemporal_store(v1, (f32x4*)(co + 4)); }
                    }
                }
            }
    }
};
constexpr int SPLIT_ROW0 = 8192, SLAB_ROWS = MTOT - 8192;
struct OrderOut {
    pg8::StaticOrder S32; int G, c;
    __device__ void init(int G_, int c_) { S32.init(SPLIT_ROW0, 2048, G_, c_, 2048, 0); G = G_; c = c_; }
    __device__ bool next(int i, pg8::Unit& u) const {
        if (S32.next(i, u)) return true;
        const int R = (256 + G - 1) / G; if (i < R) return false;
        const long j = (long)(i - R) * G + c; if (j >= 160) return false;
        const int un = (int)(j >> 2); u.pm = 32 + (un >> 3); u.pn = un & 7; u.nkt = 8; u.kt0 = 8 * (int)(j & 3); return true;
    }
    __device__ __forceinline__ void a_ready(const pg8::Unit&) const {}
    __device__ __forceinline__ void done(const pg8::Unit&) const {}
};
struct EpiY {
    static constexpr bool PERM = true, AFTER_DRAIN = false;
    bf16_t* Y; float* slab;
    __device__ __forceinline__ void operator()(const f32x4 (&acc)[2][2][4][2], const pg8::Unit& u, int wr, int wc, int fr, int fq) const {
        const int row0 = u.pm * 256 + wr * 64 + fr, col0 = u.pn * 256 + wc * 32 + 8 * fq;
        const bool whole = u.nkt == 32;
        float* sbase = slab + ((size_t)(u.kt0 >> 3) * SLAB_ROWS - SPLIT_ROW0) * D;
#pragma unroll
        for (int ai = 0; ai < 2; ++ai)
#pragma unroll
            for (int m = 0; m < 4; ++m) {
                const int row = row0 + ai * 128 + m * 16; if (row >= MTOT) continue;
#pragma unroll
                for (int bj = 0; bj < 2; ++bj) { const f32x4 v0 = acc[ai][bj][m][0], v1 = acc[ai][bj][m][1]; const size_t off = (size_t)row * D + col0 + bj * 128;
                    if (whole) { u32x4 w; w.x = pk2(v0.x, v0.y); w.y = pk2(v0.z, v0.w); w.z = pk2(v1.x, v1.y); w.w = pk2(v1.z, v1.w); *(u32x4*)(Y + off) = w; }
                    else { *(f32x4*)(sbase + off) = v0; *(f32x4*)(sbase + off + 4) = v1; } }
            }
    }
};

template <int MODE> __device__ __forceinline__ void phase_ln(const Params& p, int layer) {
    int tid_l = threadIdx.x; asm volatile("" : "+v"(tid_l)); const int tid = tid_l, wave = tid >> 6, lane = tid & 63;
    const int NGW = gridDim.x * 8, gw = wave * gridDim.x + blockIdx.x;
    float* ZB = (float*)(p.ws + WS_ZB); bf16_t* XB = (bf16_t*)(p.ws + WS_XB); const bf16_t* YB = (const bf16_t*)(p.ws + WS_VB); const float* SL = (const float*)(p.ws + WS_LF);
    const f32x4* gp = (const f32x4*)(p.ln_g + (size_t)layer * D) + lane; const f32x4* bp = (const f32x4*)(p.ln_b + (size_t)layer * D) + lane;
    f32x4 gam[8], bet[8];
#pragma unroll
    for (int j = 0; j < 8; ++j) { gam[j] = gp[64 * j]; bet[j] = bp[64 * j]; }
    f32x4 nv[8]; u32x2 ny[8];
#define LN_LOAD(m_) do { const u32x2* y_ = (const u32x2*)(YB + (size_t)(m_) * D) + lane; \
        if (MODE == 1) { const f32x4* x_ = (const f32x4*)xrow_ptr(p, (m_)) + lane; _Pragma("unroll") for (int j = 0; j < 8; ++j) nv[j] = __builtin_nontemporal_load(x_ + 64 * j); } \
        else { const u32x2* x_ = (const u32x2*)(XB + (size_t)(m_) * D) + lane; _Pragma("unroll") for (int j = 0; j < 8; ++j) { const u32x2 w_ = x_[64 * j]; nv[j] = (f32x4){bf2f((unsigned short)(w_.x & 0xffffu)), bf2f((unsigned short)(w_.x >> 16)), bf2f((unsigned short)(w_.y & 0xffffu)), bf2f((unsigned short)(w_.y >> 16))}; } } \
        if ((m_) < SPLIT_ROW0) { _Pragma("unroll") for (int j = 0; j < 8; ++j) ny[j] = __builtin_nontemporal_load(y_ + 64 * j); } } while (0)
    if (gw < MTOT) LN_LOAD(gw);
    for (int m = gw; m < MTOT; m += NGW) {
        f32x4 v[8]; float s = 0.f;
        if (m < SPLIT_ROW0) {
#pragma unroll
            for (int j = 0; j < 8; ++j) { const f32x4 y = (f32x4){bf2f((unsigned short)(ny[j].x & 0xffffu)), bf2f((unsigned short)(ny[j].x >> 16)), bf2f((unsigned short)(ny[j].y & 0xffffu)), bf2f((unsigned short)(ny[j].y >> 16))}; v[j] = nv[j] * ALPHA + y; }
        } else {
#pragma unroll
            for (int j = 0; j < 8; ++j) v[j] = nv[j] * ALPHA;
            const f32x4* sl = (const f32x4*)(SL + (size_t)(m - SPLIT_ROW0) * D) + lane;
#pragma unroll
            for (int pc = 0; pc < 4; ++pc)
#pragma unroll
                for (int j = 0; j < 8; ++j) v[j] = v[j] + __builtin_nontemporal_load(sl + (size_t)pc * SLAB_ROWS * (D / 4) + 64 * j);
        }
        if (m + NGW < MTOT) LN_LOAD(m + NGW);
#pragma unroll
        for (int j = 0; j < 8; ++j) s += (v[j].x + v[j].y) + (v[j].z + v[j].w);
#pragma unroll
        for (int o = 1; o < 64; o <<= 1) s += __shfl_xor(s, o);
        const float mean = s * (1.0f / D); float s2 = 0.f;
#pragma unroll
        for (int j = 0; j < 8; ++j) { v[j] = v[j] - mean; s2 += (v[j].x * v[j].x + v[j].y * v[j].y) + (v[j].z * v[j].z + v[j].w * v[j].w); }
#pragma unroll
        for (int o = 1; o < 64; o <<= 1) s2 += __shfl_xor(s2, o);
        const float rstd = rsqrtf(s2 * (1.0f / D) + LN_EPS);
        if (MODE == 1) {
            u32x2* xb = (u32x2*)(XB + (size_t)m * D) + lane;
#pragma unroll
            for (int j = 0; j < 8; ++j) { const f32x4 y = v[j] * rstd * gam[j] + bet[j]; u32x2 o; o.x = pk2(y.x, y.y); o.y = pk2(y.z, y.w); xb[64 * j] = o; }
        } else {
            float* dst = nullptr;
            if (m < MPR) { const int b = m / TP, t = m - b * TP; if (t >= 16) dst = p.out + OUT_YP + ((size_t)b * 2048 + (t - 16)) * D; }
            else dst = p.out + OUT_YS + (size_t)(m - MPR) * D;
            if (dst) { f32x4* d4 = (f32x4*)dst + lane;
#pragma unroll
                for (int j = 0; j < 8; ++j) __builtin_nontemporal_store(v[j] * rstd * gam[j] + bet[j], d4 + 64 * j); }
        }
    }
#undef LN_LOAD
}

constexpr int H_QT = 0, H_KT = 17408, H_KTT = 34816, H_VT = 53248, H_AM = 71680, H_S0T = 80896, H_DEC = 115712, H_SEG = 116224;
#define MFMA16(a, b, c) __builtin_amdgcn_mfma_f32_16x16x32_bf16((a), (b), (c), 0, 0, 0)

__device__ __forceinline__ void hgrn_chain(const Params& p, LAS unsigned char* lds, int item, int pass) {
    const int ci = item >> 2, sg = item & 3;
    const int c_begin = sg == 0 ? 0 : 1 + 8 * sg, c_end = 9 + 8 * sg;
    const bool full = pass != 0;
    if (!full && sg == 3) return;
    int tid_l = threadIdx.x; asm volatile("" : "+v"(tid_l)); const int tid = tid_l, w = tid >> 6, lane = tid & 63, r16 = lane & 15, quad = lane >> 4;
    const int kcol = tid & 127, seg = tid >> 7;
    const int b = ci >> 4, h = ci & 15;
    const bf16_t* QB = (const bf16_t*)(p.ws + WS_QB); const float* LF = (const float*)(p.ws + WS_LF); const bf16_t* VB = (const bf16_t*)(p.ws + WS_VB);
    const bf16_t* GB = (const bf16_t*)(p.ws + WS_GB); bf16_t* OB = (bf16_t*)(p.ws + WS_OB);
    const int colbase = h * 128;
    const int tt = w >> 1, vh = w & 1;
    f32x4 S[8];
#pragma unroll
    for (int i = 0; i < 8; ++i) S[i] = (f32x4){0.f, 0.f, 0.f, 0.f};
    f32x4 dprod = (f32x4){1.f, 1.f, 1.f, 1.f};
    float* HU = (float*)(p.ws + WS_HU); float* HD = (float*)(p.ws + WS_HD);
    if (full) {
        for (int j = 0; j < sg; ++j) { const float* U = HU + (size_t)(ci * 4 + j) * 16384; const f32x4 dj = *(const f32x4*)(HD + (ci * 4 + j) * 128 + 16 * w + 4 * quad);
#pragma unroll
            for (int vt = 0; vt < 8; ++vt)
#pragma unroll
                for (int r = 0; r < 4; ++r) S[vt][r] = dj[r] * S[vt][r] + U[(16 * w + 4 * quad + r) * 128 + 16 * vt + r16]; }
#pragma unroll
        for (int vt = 0; vt < 8; ++vt) *(LAS u32x2*)(lds + H_S0T + (16 * vt + r16) * 272 + (16 * w + 4 * quad) * 2) = (u32x2){pk2(S[vt].x, S[vt].y), pk2(S[vt].z, S[vt].w)};
    }
    float lf[16]; unsigned short qr[16], vr[16];
#define HG_LOAD(c_) do { const int t0_ = 64 * (c_); _Pragma("unroll") for (int i = 0; i < 16; ++i) { const int t_ = t0_ + 16 * seg + i; const bool ok_ = t_ < TP; \
        const size_t off_ = ((size_t)(b * TP + (ok_ ? t_ : 0))) * D + colbase + kcol; \
        float l_; unsigned short q_ = 0, v_; if (full) { l_ = __builtin_nontemporal_load(LF + off_); q_ = __builtin_nontemporal_load(QB + off_); v_ = __builtin_nontemporal_load(VB + off_); } else { l_ = LF[off_]; v_ = VB[off_]; } \
        lf[i] = ok_ ? l_ : 1.f; qr[i] = ok_ ? q_ : (unsigned short)0; vr[i] = ok_ ? v_ : (unsigned short)0; } } while (0)
    f32x4 nw4[4];
#pragma unroll
    for (int i = 0; i < 4; ++i) nw4[i] = *(const f32x4*)(p.norm_w + colbase + 16 * (tid & 7) + 4 * i);
    HG_LOAD(c_begin);
    for (int c = c_begin; c < c_end; ++c) {
        float bl[16]; float run = 1.f;
#pragma unroll
        for (int i = 0; i < 16; ++i) { run *= lf[i]; bl[i] = run; }
        ((LAS float*)(lds + H_SEG))[seg * 128 + kcol] = run;
        __syncthreads();
        float pre = 1.f;
        for (int s = 0; s < seg; ++s) pre *= ((LAS float*)(lds + H_SEG))[s * 128 + kcol];
        unsigned ktp[8], vtp[8]; float eb_last = 1.f;
#pragma unroll
        for (int i = 0; i < 16; i += 2) {
            float kt2[2], qt2[2];
#pragma unroll
            for (int e = 0; e < 2; ++e) { const float eb = pre * bl[i + e], enb = __builtin_amdgcn_rcpf(eb); const float q = bf2f(qr[i + e]); const float kk = 1.0f - lf[i + e];
                qt2[e] = q * eb; kt2[e] = kk * enb; eb_last = eb; }
            ktp[i >> 1] = pk2(kt2[0], kt2[1]); vtp[i >> 1] = (unsigned)vr[i] | ((unsigned)vr[i + 1] << 16);
            if (full) { const unsigned qp = pk2(qt2[0], qt2[1]); const int ts = 16 * seg + i;
                *(LAS unsigned short*)(lds + H_QT + ts * 272 + kcol * 2) = (unsigned short)qp; *(LAS unsigned short*)(lds + H_QT + (ts + 1) * 272 + kcol * 2) = (unsigned short)(qp >> 16);
                *(LAS unsigned short*)(lds + H_KT + ts * 272 + kcol * 2) = (unsigned short)ktp[i >> 1]; *(LAS unsigned short*)(lds + H_KT + (ts + 1) * 272 + kcol * 2) = (unsigned short)(ktp[i >> 1] >> 16); }
        }
        *(LAS u32x4*)(lds + H_KTT + kcol * 144 + seg * 32) = (u32x4){ktp[0], ktp[1], ktp[2], ktp[3]};
        *(LAS u32x4*)(lds + H_KTT + kcol * 144 + seg * 32 + 16) = (u32x4){ktp[4], ktp[5], ktp[6], ktp[7]};
        *(LAS u32x4*)(lds + H_VT + kcol * 144 + seg * 32) = (u32x4){vtp[0], vtp[1], vtp[2], vtp[3]};
        *(LAS u32x4*)(lds + H_VT + kcol * 144 + seg * 32 + 16) = (u32x4){vtp[4], vtp[5], vtp[6], vtp[7]};
        if (seg == 3) ((LAS float*)(lds + H_DEC))[kcol] = eb_last;
        { const int cn = (c + 1 < c_end) ? c + 1 : c; HG_LOAD(cn); }
        __syncthreads();
        const f32x4 dec = *(const LAS f32x4*)(lds + H_DEC + (16 * w + 4 * quad) * 4);
        dprod = dprod * dec;
        if (!full) {
#pragma unroll
            for (int ss = 0; ss < 2; ++ss) { const bf16x8 ka = *(const LAS bf16x8*)(lds + H_KTT + (16 * w + r16) * 144 + (32 * ss + 8 * quad) * 2);
#pragma unroll
                for (int vt = 0; vt < 8; ++vt) { const bf16x8 vb = *(const LAS bf16x8*)(lds + H_VT + (16 * vt + r16) * 144 + (32 * ss + 8 * quad) * 2); S[vt] = MFMA16(ka, vb, S[vt]); } }
#pragma unroll
            for (int vt = 0; vt < 8; ++vt) S[vt] = S[vt] * dec;
        } else {
        const int nt_ = tid >> 3, njj = tid & 7; const int tg = 64 * c + nt_;
        const size_t goff = ((size_t)(tg < TP ? b * TP + tg : MTOT + nt_)) * D + colbase + 16 * njj;
        const u32x4 g0 = __builtin_nontemporal_load((const u32x4*)(GB + goff)), g1 = __builtin_nontemporal_load((const u32x4*)(GB + goff + 8));
        bf16x8 qa[4];
#pragma unroll
        for (int ks = 0; ks < 4; ++ks) qa[ks] = *(const LAS bf16x8*)(lds + H_QT + (16 * tt + r16) * 272 + (32 * ks + 8 * quad) * 2);
        f32x4 O[4];
#pragma unroll
        for (int j = 0; j < 4; ++j) { O[j] = (f32x4){0.f, 0.f, 0.f, 0.f}; const int vt = 4 * vh + j;
#pragma unroll
            for (int ks = 0; ks < 4; ++ks) { const bf16x8 sb = *(const LAS bf16x8*)(lds + H_S0T + (16 * vt + r16) * 272 + (32 * ks + 8 * quad) * 2); O[j] = MFMA16(qa[ks], sb, O[j]); } }
#pragma unroll
        for (int j = 0; j < 2; ++j) { const int st = 2 * vh + j; f32x4 a = (f32x4){0.f, 0.f, 0.f, 0.f};
            if (st <= tt) {
#pragma unroll
                for (int ks = 0; ks < 4; ++ks) { const bf16x8 kb = *(const LAS bf16x8*)(lds + H_KT + (16 * st + r16) * 272 + (32 * ks + 8 * quad) * 2); a = MFMA16(qa[ks], kb, a); } }
#pragma unroll
            for (int r = 0; r < 4; ++r) { const int tl = 16 * tt + 4 * quad + r, sl = 16 * st + r16; const float val = (sl <= tl) ? a[r] : 0.f;
                *(LAS unsigned short*)(lds + H_AM + tl * 144 + sl * 2) = f2bf(val); } }
        __syncthreads();
#pragma unroll
        for (int ss = 0; ss < 2; ++ss) { const bf16x8 aa = *(const LAS bf16x8*)(lds + H_AM + (16 * tt + r16) * 144 + (32 * ss + 8 * quad) * 2);
#pragma unroll
            for (int j = 0; j < 4; ++j) { const int vt = 4 * vh + j; const bf16x8 vb = *(const LAS bf16x8*)(lds + H_VT + (16 * vt + r16) * 144 + (32 * ss + 8 * quad) * 2); O[j] = MFMA16(aa, vb, O[j]); } }
#pragma unroll
        for (int ss = 0; ss < 2; ++ss) { const bf16x8 ka = *(const LAS bf16x8*)(lds + H_KTT + (16 * w + r16) * 144 + (32 * ss + 8 * quad) * 2);
#pragma unroll
            for (int vt = 0; vt < 8; ++vt) { const bf16x8 vb = *(const LAS bf16x8*)(lds + H_VT + (16 * vt + r16) * 144 + (32 * ss + 8 * quad) * 2); S[vt] = MFMA16(ka, vb, S[vt]); } }
#pragma unroll
        for (int vt = 0; vt < 8; ++vt) { S[vt] = S[vt] * dec;
            *(LAS u32x2*)(lds + H_S0T + (16 * vt + r16) * 272 + (16 * w + 4 * quad) * 2) = (u32x2){pk2(S[vt].x, S[vt].y), pk2(S[vt].z, S[vt].w)}; }
#pragma unroll
        for (int j = 0; j < 4; ++j) { const int vt = 4 * vh + j;
#pragma unroll
            for (int r = 0; r < 4; ++r) ((LAS float*)lds)[(16 * tt + 4 * quad + r) * 132 + 16 * vt + r16] = O[j][r]; }
        __syncthreads();
        { const int t = nt_, jj = njj;
          f32x4 o4[4]; float ss = 0.f;
#pragma unroll
          for (int i = 0; i < 4; ++i) { o4[i] = *(const LAS f32x4*)(lds + (t * 132 + 16 * jj + 4 * i) * 4); ss += (o4[i].x * o4[i].x + o4[i].y * o4[i].y) + (o4[i].z * o4[i].z + o4[i].w * o4[i].w); }
          ss += __shfl_xor(ss, 1); ss += __shfl_xor(ss, 2); ss += __shfl_xor(ss, 4);
          const float rstd = rsqrtf(ss * (1.0f / 128.0f) + RMS_EPS);
          { const size_t off = goff;
              const unsigned gw_[8] = {g0.x, g0.y, g0.z, g0.w, g1.x, g1.y, g1.z, g1.w};
              unsigned ow[8];
#pragma unroll
              for (int i = 0; i < 4; ++i) { const f32x4 n4 = nw4[i];
                  const float y0 = o4[i].x * rstd * n4.x * bf2f((unsigned short)(gw_[2 * i] & 0xffffu)), y1 = o4[i].y * rstd * n4.y * bf2f((unsigned short)(gw_[2 * i] >> 16));
                  const float y2 = o4[i].z * rstd * n4.z * bf2f((unsigned short)(gw_[2 * i + 1] & 0xffffu)), y3 = o4[i].w * rstd * n4.w * bf2f((unsigned short)(gw_[2 * i + 1] >> 16));
                  ow[2 * i] = pk2(y0, y1); ow[2 * i + 1] = pk2(y2, y3); }
              *(u32x4*)(OB + off) = (u32x4){ow[0], ow[1], ow[2], ow[3]}; *(u32x4*)(OB + off + 8) = (u32x4){ow[4], ow[5], ow[6], ow[7]}; }
        }
        }
    }
#undef HG_LOAD
    if (!full || sg == 3) {
        float* so = full ? p.out + OUT_SP + ((size_t)(b * 16 + h)) * 16384 : HU + (size_t)item * 16384;
#pragma unroll
        for (int vt = 0; vt < 8; ++vt)
#pragma unroll
            for (int r = 0; r < 4; ++r) { float* d_ = so + (16 * w + 4 * quad + r) * 128 + 16 * vt + r16; if (full) __builtin_nontemporal_store(S[vt][r], d_); else *d_ = S[vt][r]; }
        if (!full && r16 == 0) *(f32x4*)(HD + item * 128 + 16 * w + 4 * quad) = dprod;
    }
    __syncthreads();
}

constexpr int SS_Q = 0, SS_K = 4096, SS_V = 8192, SS_E8 = 12288, SS_A = 12800, SS_B = 13056, SS_QR = 17152, SS_PART = 25600;
struct SampRaw { float lf[2]; unsigned short q[2], v[2]; f32x4 s0[8]; };
__device__ __forceinline__ void hgrn_sample_load(const Params& p, int it, SampRaw& r) {
    int tid_l = threadIdx.x; asm volatile("" : "+v"(tid_l)); const int tid = tid_l, b = it >> 4, h = it & 15;
    const bf16_t* QB = (const bf16_t*)(p.ws + WS_QB); const float* LF = (const float*)(p.ws + WS_LF); const bf16_t* VB = (const bf16_t*)(p.ws + WS_VB);
    const size_t rbase = ((size_t)(MPR + b * 8)) * D + h * 128;
#pragma unroll
    for (int j = 0; j < 2; ++j) { const int rem = tid + 512 * j, t = rem >> 7, k = rem & 127; const size_t o = rbase + (size_t)t * D + k; r.lf[j] = __builtin_nontemporal_load(LF + o); r.q[j] = __builtin_nontemporal_load(QB + o); r.v[j] = __builtin_nontemporal_load(VB + o); }
    { const int v4 = tid & 31, kg = tid >> 5; const float* S0 = p.state + ((size_t)(b * 16 + h)) * 16384;
#pragma unroll
      for (int i = 0; i < 8; ++i) r.s0[i] = __builtin_nontemporal_load((const f32x4*)(S0 + (8 * kg + i) * 128 + 4 * v4)); }
}
__device__ __forceinline__ void hgrn_sample_item(const Params& p, LAS unsigned char* lds, int it, int it_next, SampRaw& raw) {
    int tid_l = threadIdx.x; asm volatile("" : "+v"(tid_l)); const int tid = tid_l, lane = tid & 63;
    const int b = it >> 4, h = it & 15;
    const bf16_t* GB = (const bf16_t*)(p.ws + WS_GB); bf16_t* OB = (bf16_t*)(p.ws + WS_OB);
    const size_t rbase = ((size_t)(MPR + b * 8)) * D + h * 128;
    LAS float* SQ = (LAS float*)(lds + SS_Q); LAS float* SK = (LAS float*)(lds + SS_K); LAS float* SV = (LAS float*)(lds + SS_V); LAS float* SE8 = (LAS float*)(lds + SS_E8);
    LAS float* SA = (LAS float*)(lds + SS_A); LAS float* SB = (LAS float*)(lds + SS_B); LAS float* SQR = (LAS float*)(lds + SS_QR);
    LAS float* PART = (LAS float*)(lds + SS_PART);
    const int v4 = tid & 31, kg = tid >> 5;
    const float* S0 = p.state + ((size_t)(b * 16 + h)) * 16384; float* S1 = p.out + OUT_SS + ((size_t)(b * 16 + h)) * 16384;
    f32x4 s0[8];
#pragma unroll
    for (int i = 0; i < 8; ++i) s0[i] = raw.s0[i];
    const size_t goff3 = rbase + (size_t)(tid >> 6) * D + 2 * lane;
    const unsigned g3 = __builtin_nontemporal_load((const unsigned*)(GB + goff3)); const f32x2v nw3 = *(const f32x2v*)(p.norm_w + h * 128 + 2 * lane);
#pragma unroll
    for (int j = 0; j < 2; ++j) { const int rem = tid + 512 * j; SB[rem] = raw.lf[j]; SQR[rem] = bf2f(raw.q[j]); SV[rem] = bf2f(raw.v[j]); }
    __syncthreads();
    if (it_next < 2048) hgrn_sample_load(p, it_next, raw);
    if (tid < 128) { const int k = tid; float lfv[8], bt[8]; float run = 1.f;
#pragma unroll
        for (int t = 0; t < 8; ++t) { lfv[t] = SB[t * 128 + k]; run *= lfv[t]; bt[t] = run; }
#pragma unroll
        for (int t = 0; t < 8; ++t) { SQ[k * 8 + t] = SQR[t * 128 + k] * bt[t]; SK[k * 8 + t] = (1.0f - lfv[t]) * __builtin_amdgcn_rcpf(bt[t]); }
        SE8[k] = run;
    }
    __syncthreads();
    { const int pair = tid >> 3, ks = tid & 7, t = pair >> 3, s = pair & 7; float a = 0.f;
#pragma unroll
        for (int i = 0; i < 16; ++i) a += SQ[(ks + 8 * i) * 8 + t] * SK[(ks + 8 * i) * 8 + s];
        a += __shfl_xor(a, 1); a += __shfl_xor(a, 2); a += __shfl_xor(a, 4);
        if (ks == 0) SA[pair] = (s <= t) ? a : 0.f; }
    {
        f32x4 vv[8], o[8];
#pragma unroll
        for (int s = 0; s < 8; ++s) { vv[s] = *(const LAS f32x4*)(SV + s * 128 + 4 * v4); o[s] = (f32x4){0.f, 0.f, 0.f, 0.f}; }
#pragma unroll
        for (int i = 0; i < 8; ++i) { const int k = 8 * kg + i;
            const f32x4 qa = *(const LAS f32x4*)(SQ + k * 8), qb = *(const LAS f32x4*)(SQ + k * 8 + 4), ka = *(const LAS f32x4*)(SK + k * 8), kb = *(const LAS f32x4*)(SK + k * 8 + 4);
            const float q8[8] = {qa.x, qa.y, qa.z, qa.w, qb.x, qb.y, qb.z, qb.w}, k8[8] = {ka.x, ka.y, ka.z, ka.w, kb.x, kb.y, kb.z, kb.w};
            f32x4 sn = s0[i];
#pragma unroll
            for (int t = 0; t < 8; ++t) { o[t] = o[t] + s0[i] * q8[t]; sn = sn + vv[t] * k8[t]; }
            __builtin_nontemporal_store(sn * SE8[k], (f32x4*)(S1 + k * 128 + 4 * v4)); }
#pragma unroll
        for (int t = 0; t < 8; ++t) *(LAS f32x4*)(PART + (kg * 8 + t) * 128 + 4 * v4) = o[t];
    }
    __syncthreads();
    { const int t = tid >> 6, vp = lane; f32x2v o2 = (f32x2v){0.f, 0.f};
#pragma unroll
        for (int g = 0; g < 16; ++g) o2 = o2 + *(const LAS f32x2v*)(PART + (g * 8 + t) * 128 + 2 * vp);
#pragma unroll
        for (int s = 0; s < 8; ++s) o2 = o2 + *(const LAS f32x2v*)(SV + s * 128 + 2 * vp) * SA[t * 8 + s];
        float ss = o2.x * o2.x + o2.y * o2.y;
#pragma unroll
        for (int m = 1; m < 64; m <<= 1) ss += __shfl_xor(ss, m);
        const float rstd = rsqrtf(ss * (1.0f / 128.0f) + RMS_EPS);
        const size_t off = rbase + (size_t)t * D + 2 * vp;
        const unsigned g = g3; const f32x2v nw = nw3;
        *(unsigned*)(OB + off) = pk2(o2.x * rstd * nw.x * bf2f((unsigned short)(g & 0xffffu)), o2.y * rstd * nw.y * bf2f((unsigned short)(g >> 16))); }
    __syncthreads();
}

__device__ __forceinline__ void phase_hgrn(const Params& p, LAS unsigned char* lds, const XcdBarrier& xb) {
    const int G = gridDim.x, blk = blockIdx.x;
    const bool early = (G == 256) && ((blk & 3) == 3); constexpr int NEARLY = 64 * 6;
    const int s_lo = (G == 256) ? NEARLY : 0;
    const bool swap = (G == 256) && (((blk >> 2) & 1) != 0);
    for (int stage = 0; stage < 2; ++stage) {
        for (int k = 0; k < 2; ++k) {
            const bool do_chain = (stage == 0) ? (k == 0) : ((k == 0) != swap);
            if (do_chain) { for (int it = blk; it < 256; it += G) hgrn_chain(p, lds, it, stage); }
            else {
                int it, step, end;
                if (stage == 0) { it = early ? (blk >> 2) : 4096; step = 64; end = NEARLY; } else { it = s_lo + blk; step = G; end = 2048; }
                SampRaw raw; if (it < end) hgrn_sample_load(p, it, raw);
                for (; it < end; it += step) hgrn_sample_item(p, lds, it, (it + step < end) ? it + step : 4096, raw);
            }
        }
        if (stage == 0) xcd_barrier(xb);
    }
}

constexpr int A_KS = 0, A_VT = 23040;
constexpr int ATT_PROMPT_ITEMS = NBP * 4 * 65, ATT_ITEMS = ATT_PROMPT_ITEMS + NBS * 4;
struct AttPre { u32x4 r[3][4]; };
__device__ __forceinline__ void attn_load(const Params& p, int it, AttPre& pre) {
    const int tid = threadIdx.x;
    const bf16_t* K1 = (const bf16_t*)(p.ws + WS_K1); const bf16_t* V1 = (const bf16_t*)(p.ws + WS_V1);
    const bool samp = it >= ATT_PROMPT_ITEMS;
    int b, kvh, t0 = 0;
    if (!samp) { b = it / 260; const int rem = it - b * 260; kvh = rem / 65; t0 = 32 * (rem - kvh * 65); } else { const int j = it - ATT_PROMPT_ITEMS; b = j >> 2; kvh = j & 3; }
#pragma unroll
    for (int u = 0; u < 3; ++u) { const int idx = tid + 512 * u;
        const int kA = idx >> 3, cA = idx & 7;
        const int cB = idx / 160, kB = idx - 160 * cB;
        const u32x4 z = (u32x4){0u, 0u, 0u, 0u}; pre.r[u][0] = z; pre.r[u][1] = z; pre.r[u][2] = z; pre.r[u][3] = z;
        if (idx < 1280) {
            if (!samp) { const int pA = t0 - 128 + kA, pB = t0 - 128 + kB;
                if (pA >= 0 && pA < TP) pre.r[u][0] = *(const u32x4*)(K1 + ((size_t)(b * TP + pA)) * 256 + kvh * 64 + 8 * cA);
                if (pB >= 0 && pB < TP) pre.r[u][1] = *(const u32x4*)(V1 + ((size_t)(b * TP + pB)) * 256 + kvh * 64 + 8 * cB); }
            else {
                if (kA < 128) { const size_t o = (((size_t)b * 128 + kA) * 4 + kvh) * 64 + 8 * cA; pre.r[u][0] = *(const u32x4*)(p.cache_k + o); pre.r[u][1] = *(const u32x4*)(p.cache_k + o + 4); }
                else if (kA < 136) pre.r[u][0] = *(const u32x4*)(K1 + ((size_t)(MPR + b * 8 + kA - 128)) * 256 + kvh * 64 + 8 * cA);
                if (kB < 128) { const size_t o = (((size_t)b * 128 + kB) * 4 + kvh) * 64 + 8 * cB; pre.r[u][2] = *(const u32x4*)(p.cache_v + o); pre.r[u][3] = *(const u32x4*)(p.cache_v + o + 4); }
                else if (kB < 136) pre.r[u][2] = *(const u32x4*)(V1 + ((size_t)(MPR + b * 8 + kB - 128)) * 256 + kvh * 64 + 8 * cB);
            }
        } }
}
__device__ __forceinline__ void attn_stage(LAS unsigned char* base, int itp, const AttPre& pre) {
    const int tid = threadIdx.x; const bool samp = itp >= ATT_PROMPT_ITEMS;
#pragma unroll
    for (int u = 0; u < 3; ++u) { const int idx = tid + 512 * u;
        const int kA = idx >> 3, cA = idx & 7, cB = idx / 160, kB = idx - 160 * cB;
        if (idx < 1280) {
            u32x4 kv = pre.r[u][0], vv = samp ? pre.r[u][2] : pre.r[u][1];
            if (samp && kA < 128) { const f32x4 a = __builtin_bit_cast(f32x4, pre.r[u][0]), bq = __builtin_bit_cast(f32x4, pre.r[u][1]); kv = (u32x4){pk2(a.x, a.y), pk2(a.z, a.w), pk2(bq.x, bq.y), pk2(bq.z, bq.w)}; }
            if (samp && kB < 128) { const f32x4 c = __builtin_bit_cast(f32x4, pre.r[u][2]), d = __builtin_bit_cast(f32x4, pre.r[u][3]); vv = (u32x4){pk2(c.x, c.y), pk2(c.z, c.w), pk2(d.x, d.y), pk2(d.z, d.w)}; }
            *(LAS u32x4*)(base + A_KS + kA * 144 + cA * 16) = kv;
            const unsigned vw[4] = {vv.x, vv.y, vv.z, vv.w};
#pragma unroll
            for (int j = 0; j < 4; ++j) { *(LAS unsigned short*)(base + A_VT + (8 * cB + 2 * j) * 336 + kB * 2) = (unsigned short)(vw[j] & 0xffffu);
                *(LAS unsigned short*)(base + A_VT + (8 * cB + 2 * j + 1) * 336 + kB * 2) = (unsigned short)(vw[j] >> 16); }
        } }
}
constexpr int ATT_BUF = 44544;
__device__ __forceinline__ void attn_item(const Params& p, LAS unsigned char* lds_all, int it, int it_n1, int it_n2, int cur, AttPre& pre) {
    int tid_l = threadIdx.x; asm volatile("" : "+v"(tid_l)); const int tid = tid_l, w = tid >> 6, lane = tid & 63, r16 = lane & 15, quad = lane >> 4;
    LAS unsigned char* lds = lds_all + cur * ATT_BUF; LAS unsigned char* ldsn = lds_all + (cur ^ 1) * ATT_BUF;
    const bf16_t* Q1 = (const bf16_t*)(p.ws + WS_QB);
    const bf16_t* GB = (const bf16_t*)(p.ws + WS_GB); bf16_t* OB = (bf16_t*)(p.ws + WS_OB);
    const bool samp = it >= ATT_PROMPT_ITEMS;
    int b, kvh, t0 = 0;
    if (!samp) { b = it / 260; const int rem = it - b * 260; kvh = rem / 65; t0 = 32 * (rem - kvh * 65); } else { const int j = it - ATT_PROMPT_ITEMS; b = j >> 2; kvh = j & 3; }
    const int hq = kvh * 8 + w;
    const float sink_raw = p.sinks[hq];
    bf16x8 qf[2][2]; bool qok[2]; size_t qrow[2];
#pragma unroll
    for (int tt = 0; tt < 2; ++tt) { const int i = 16 * tt + r16;
        if (!samp) { const int t = t0 + i; qok[tt] = t < TP; qrow[tt] = (size_t)(b * TP + (qok[tt] ? t : 0)); } else { qok[tt] = i < 8; qrow[tt] = (size_t)(MPR + b * 8 + (qok[tt] ? i : 0)); }
#pragma unroll
        for (int ds = 0; ds < 2; ++ds) { bf16x8 q = __builtin_nontemporal_load((const bf16x8*)(Q1 + qrow[tt] * D + hq * 64 + 32 * ds + 8 * quad)); if (!qok[tt]) q = (bf16x8){0, 0, 0, 0, 0, 0, 0, 0}; qf[tt][ds] = q; } }
    u32x4 gw[4]; size_t orow[4]; bool ook[4];
#pragma unroll
    for (int k = 0; k < 4; ++k) { const int i = 8 * k + (lane >> 3);
        if (!samp) { const int t = t0 + i; ook[k] = t < TP; orow[k] = (size_t)(b * TP + (ook[k] ? t : 0)); } else { ook[k] = i < 8; orow[k] = (size_t)(MPR + b * 8 + (ook[k] ? i : 0)); }
        gw[k] = __builtin_nontemporal_load((const u32x4*)(GB + orow[k] * D + hq * 64 + 8 * (lane & 7))); }
    __syncthreads();
    f32x4 st[10][2];
#pragma unroll
    for (int kt = 0; kt < 10; ++kt) { st[kt][0] = (f32x4){0.f, 0.f, 0.f, 0.f}; st[kt][1] = (f32x4){0.f, 0.f, 0.f, 0.f};
#pragma unroll
        for (int ds = 0; ds < 2; ++ds) { const bf16x8 ka = *(const LAS bf16x8*)(lds + A_KS + (16 * kt + r16) * 144 + (32 * ds + 8 * quad) * 2);
            st[kt][0] = MFMA16(ka, qf[0][ds], st[kt][0]); if (!samp) st[kt][1] = MFMA16(ka, qf[1][ds], st[kt][1]); } }
    const float sink = sink_raw * 1.44269504089f;
    const int kminv = samp ? 0 : (128 - t0 > 0 ? 128 - t0 : 0);
    const bool midfree = kminv <= 32;
    const int ntt = samp ? 1 : 2;
    bf16x8 pb[5][2]; float inv[2] = {0.f, 0.f};
#pragma unroll
    for (int tt = 0; tt < 2; ++tt) if (tt < ntt) { const int i = 16 * tt + r16; const int lo = (i + 1 > kminv) ? i + 1 : kminv, hi = i + 128;
        float m = -INFINITY;
#pragma unroll
        for (int kt = 0; kt < 10; ++kt) {
            if (kt >= 2 && kt < 8 && midfree) {
#pragma unroll
                for (int r = 0; r < 4; ++r) m = fmaxf(m, st[kt][tt][r]);
            } else {
#pragma unroll
                for (int r = 0; r < 4; ++r) { const int kp = 16 * kt + 4 * quad + r; const float s = (kp >= lo && kp <= hi) ? st[kt][tt][r] : -INFINITY; st[kt][tt][r] = s; m = fmaxf(m, s); }
            } }
        m = fmaxf(m, __shfl_xor(m, 16)); m = fmaxf(m, __shfl_xor(m, 32)); m = fmaxf(m, sink);
        float sum = 0.f;
#pragma unroll
        for (int kt = 0; kt < 10; ++kt)
#pragma unroll
            for (int r = 0; r < 4; ++r) { const float e = __builtin_amdgcn_exp2f(st[kt][tt][r] - m); st[kt][tt][r] = e; sum += e; }
        sum += __shfl_xor(sum, 16); sum += __shfl_xor(sum, 32); sum += __builtin_amdgcn_exp2f(sink - m);
        inv[tt] = __builtin_amdgcn_rcpf(sum);
#pragma unroll
        for (int ks = 0; ks < 5; ++ks) { const f32x4 a = st[2 * ks][tt], c = st[2 * ks + 1][tt];
            const u32x4 pw = (u32x4){pk2(a.x, a.y), pk2(a.z, a.w), pk2(c.x, c.y), pk2(c.z, c.w)}; pb[ks][tt] = __builtin_bit_cast(bf16x8, pw); }
    }
    if (it_n1 < ATT_ITEMS) attn_stage(ldsn, it_n1, pre);
    if (it_n2 < ATT_ITEMS) attn_load(p, it_n2, pre);
    f32x4 o[4][2];
#pragma unroll
    for (int dt = 0; dt < 4; ++dt) { o[dt][0] = (f32x4){0.f, 0.f, 0.f, 0.f}; o[dt][1] = (f32x4){0.f, 0.f, 0.f, 0.f}; }
#pragma unroll
    for (int ks = 0; ks < 5; ++ks)
#pragma unroll
        for (int dt = 0; dt < 4; ++dt) { const u32x2 l8 = *(const LAS u32x2*)(lds + A_VT + (16 * dt + r16) * 336 + (32 * ks + 4 * quad) * 2), h8 = *(const LAS u32x2*)(lds + A_VT + (16 * dt + r16) * 336 + (32 * ks + 16 + 4 * quad) * 2);
            const bf16x8 va = __builtin_bit_cast(bf16x8, (u32x4){l8.x, l8.y, h8.x, h8.y});
            o[dt][0] = MFMA16(va, pb[ks][0], o[dt][0]); if (ntt > 1) o[dt][1] = MFMA16(va, pb[ks][1], o[dt][1]); }
    LAS unsigned char* os = lds_all + 2 * ATT_BUF + w * 4608;
#pragma unroll
    for (int tt = 0; tt < 2; ++tt) if (tt < ntt) {
#pragma unroll
        for (int dt = 0; dt < 4; ++dt) { const f32x4 x = o[dt][tt] * inv[tt];
            *(LAS u32x2*)(os + (16 * tt + r16) * 144 + (16 * dt + 4 * quad) * 2) = (u32x2){pk2(x.x, x.y), pk2(x.z, x.w)}; } }
    LDS_WAIT();
#pragma unroll
    for (int k = 0; k < 4; ++k) if (k < 2 * ntt) { const int i = 8 * k + (lane >> 3);
        const u32x4 ov = *(const LAS u32x4*)(os + i * 144 + (lane & 7) * 16);
        const unsigned ow_[4] = {ov.x, ov.y, ov.z, ov.w}, gg[4] = {gw[k].x, gw[k].y, gw[k].z, gw[k].w}; unsigned rr[4];
#pragma unroll
        for (int j = 0; j < 4; ++j) rr[j] = pk2(__uint_as_float(ow_[j] << 16) * __uint_as_float(gg[j] << 16), __uint_as_float(ow_[j] & 0xffff0000u) * __uint_as_float(gg[j] & 0xffff0000u));
        if (ook[k]) *(u32x4*)(OB + orow[k] * D + hq * 64 + 8 * (lane & 7)) = (u32x4){rr[0], rr[1], rr[2], rr[3]}; }
    LDS_WAIT();
}
__device__ __forceinline__ int att_item_of(int blk, int r, int G) {
    if (G != 256) return blk + r * G;
    const int x = blk & 7, j = blk >> 3;
    if (r < 6) return 256 * r + 32 * x + j;
    return (r == 6 && x == 1 && j < 16) ? 1536 + j : ATT_ITEMS;
}

__global__ void __launch_bounds__(512, 2) fwd_megakernel(Params p) {
    extern __shared__ __attribute__((aligned(16))) unsigned char shm[];
    LAS unsigned char* lds = (LAS unsigned char*)shm;
    const int G = gridDim.x;
    if (threadIdx.x < 4) ((LAS unsigned*)(lds + 131072))[threadIdx.x] = 0u;
    __syncthreads();
    const XcdBarrier xb = xcd_barrier_post((unsigned*)(p.ws + WS_BAR), (volatile LAS unsigned*)(lds + 131072));
    bf16_t* XB = (bf16_t*)(p.ws + WS_XB); bf16_t* OB = (bf16_t*)(p.ws + WS_OB); bf16_t* QB = (bf16_t*)(p.ws + WS_QB); bf16_t* VB = (bf16_t*)(p.ws + WS_VB); bf16_t* GB = (bf16_t*)(p.ws + WS_GB);
    float* ZB = (float*)(p.ws + WS_ZB);
    phase0(p, lds);
    xcd_barrier(xb);
    { pg8::Gemm g{XB, (const bf16_t*)(p.ws + WS_WT0), MPAD, 8192, 2048}; pg8::StaticOrder S; S.init(MPAD, 8192, G, blockIdx.x);
      EpiHgrnIn E{p.ws, (float*)(p.ws + WS_LF), (const float*)(p.ws + WS_LB)};
      pg8::gemm_phase<EpiHgrnIn, pg8::StaticOrder, false>(lds, g, S, E, nullptr);
      const int heavy = (37 * 32) % G; const int li = heavy ? (int)blockIdx.x - heavy : (int)blockIdx.x;
      if (li >= 0) phase0_rest(p, lds, li, heavy ? G - heavy : G); }
    xcd_barrier(xb);
    phase_hgrn(p, lds, xb);
    xcd_barrier(xb);
    { pg8::Gemm g{OB, (const bf16_t*)(p.ws + WS_WTO0), MPAD, 2048, 2048}; OrderOut S; S.init(G, blockIdx.x);
      EpiY E{VB, (float*)(p.ws + WS_LF)};
      pg8::gemm_phase<EpiY, OrderOut, false>(lds, g, S, E, nullptr); }
    xcd_barrier(xb);
    phase_ln<1>(p, 0);
    xcd_barrier(xb);
    { pg8::Gemm g{XB, (const bf16_t*)(p.ws + WS_WT1), MPAD, 4608, 2048}; pg8::StaticOrder S; S.init(MPAD, 4608, G, blockIdx.x);
      EpiSwaIn E{QB, (bf16_t*)(p.ws + WS_K1), (bf16_t*)(p.ws + WS_V1), GB, p.out};
      pg8::gemm_phase<EpiSwaIn, pg8::StaticOrder, false>(lds, g, S, E, nullptr);
      const int heavy = (37 * 18) % G; const int li = heavy ? (int)blockIdx.x - heavy : (int)blockIdx.x;
      if (li >= 0) phase_cache_shift(p, li, heavy ? G - heavy : G); }
    xcd_barrier(xb);
    { AttPre pre; int it = att_item_of(blockIdx.x, 0, G), n1 = att_item_of(blockIdx.x, 1, G);
      if (it < ATT_ITEMS) { attn_load(p, it, pre); attn_stage(lds, it, pre); }
      if (n1 < ATT_ITEMS) attn_load(p, n1, pre);
      for (int r = 0; it < ATT_ITEMS; ++r) { const int n2 = (n1 < ATT_ITEMS) ? att_item_of(blockIdx.x, r + 2, G) : ATT_ITEMS; attn_item(p, lds, it, n1, n2, r & 1, pre); it = n1; n1 = n2; } }
    xcd_barrier(xb);
    { pg8::Gemm g{OB, (const bf16_t*)(p.ws + WS_WTO1), MPAD, 2048, 2048}; OrderOut S; S.init(G, blockIdx.x);
      EpiY E{VB, (float*)(p.ws + WS_LF)};
      pg8::gemm_phase<EpiY, OrderOut, false>(lds, g, S, E, nullptr); }
    xcd_barrier(xb);
    for (int rep = 0; rep < REP_LN; ++rep) phase_ln<2>(p, 1);
}

extern "C" void kernel_launch(void* const* d_in, const int* in_sizes, int n_in, void* d_out, int out_size, void* d_ws, size_t ws_size, hipStream_t stream) {
    static int grid_blocks = 0;
    if (!grid_blocks) {
        int dev = 0, cus = 0, per_cu = 0;
        hipGetDevice(&dev);
        hipDeviceGetAttribute(&cus, hipDeviceAttributeMultiprocessorCount, dev);
        hipFuncSetAttribute((const void*)fwd_megakernel, hipFuncAttributeMaxDynamicSharedMemorySize, LDS_BYTES);
        hipOccupancyMaxActiveBlocksPerMultiprocessor(&per_cu, (const void*)fwd_megakernel, 512, LDS_BYTES);
        if (per_cu < 1) { fprintf(stderr, "kernel_launch: occupancy query reports %d blocks/CU\n", per_cu); per_cu = 1; }
        grid_blocks = cus;
    }
    if (ws_size < WS_END) { fprintf(stderr, "kernel_launch: workspace too small (%zu < %zu)\n", ws_size, (size_t)WS_END); return; }
    Params p{};
    p.x_prompt = (const float*)d_in[0]; p.x_sample = (const float*)d_in[1]; p.state = (const float*)d_in[2]; p.cache_k = (const float*)d_in[3]; p.cache_v = (const float*)d_in[4];
    p.meta = (const float*)d_in[5]; p.w_in0 = (const float*)d_in[6]; p.lb_logits = (const float*)d_in[7]; p.norm_w = (const float*)d_in[8]; p.w_out0 = (const float*)d_in[9];
    p.w_in1 = (const float*)d_in[10]; p.sinks = (const float*)d_in[11]; p.w_out1 = (const float*)d_in[12]; p.ln_g = (const float*)d_in[13]; p.ln_b = (const float*)d_in[14];
    p.out = (float*)d_out; p.ws = (unsigned char*)d_ws;
    if (hipMemsetAsync((char*)d_ws + WS_BAR, 0, 16384, stream) != hipSuccess) { fprintf(stderr, "kernel_launch: memset of the barrier words failed\n"); return; }
    void* args[] = {&p};
    hipError_t e = hipLaunchCooperativeKernel((const void*)fwd_megakernel, dim3(grid_blocks), dim3(512), args, LDS_BYTES, stream);
    if (e != hipSuccess) fprintf(stderr, "cooperative launch failed: %s (grid %d)\n", hipGetErrorString(e), grid_blocks);
}
```

```cpp
#include <hip/hip_runtime.h>
#include <hip/hip_cooperative_groups.h>
#include <cstdio>
#include <cstdint>
namespace pg8 {
#define PG8_LAS __attribute__((address_space(3)))
typedef unsigned short bf16_t;
typedef short bf16x8 __attribute__((ext_vector_type(8)));
typedef float f32x4 __attribute__((ext_vector_type(4)));
typedef unsigned u32x4 __attribute__((ext_vector_type(4)));
constexpr int BM = 256, BK = 64, HALF = 128, HTB = HALF * BK * 2  , STAGE_BYTES = 8 * HTB, NXCD = 8, WGM = 8;

__host__ __device__ __forceinline__ int lds_byte(int r, int c) { const int st = (r >> 4) * 2 + (c >> 5), rr = r & 15, cc = c & 31, ob = rr * 64 + cc * 2; return st * 1024 + (ob ^ (((ob >> 9) & 1) << 5)); }
__host__ __device__ __forceinline__ void stage_rc(int b, int& R, int& C) { const int st = b / 1024, sb = b % 1024, swz = sb ^ (((sb >> 9) & 1) << 5); R = (st >> 1) * 16 + swz / 64; C = (st & 1) * 32 + (swz % 64) / 2; }
__host__ __device__ __forceinline__ int perm32(int rho) { const int n = rho >> 4, i = rho & 15; return 8 * (i >> 2) + 4 * n + (i & 3); }

struct Unit { int pm, pn, kt0, nkt; };
struct Gemm { const bf16_t* A; const bf16_t* Bt; int M, N, K; };

struct StaticOrder {
    int reps = 1;
    int nM, nN, nwg, G, c, nkt, nfull, sk;
    __host__ __device__ void init(int M, int N, int G_, int c_, int K = 2048, int split = 0) { nM = M / BM; nN = N / BM; nwg = nM * nN; G = G_; c = c_; nkt = K / BK; nfull = nwg; sk = 1;
        if (split) { const int R = nwg / G, rem = nwg - R * G; if (rem > 0 && rem * 4 <= G && (nkt % 8) == 0) { nfull = R * G; sk = 4; } } }
    __host__ __device__ bool next(int i, Unit& u) const {
        if (reps > 1) { const int R = (nwg + G - 1) / G; if (i >= R * reps) return false; i = i % R; }
        long L = (long)i * G + c; u.kt0 = 0; u.nkt = nkt;
        if (L >= nfull && sk > 1) { if (L >= nfull + G) return false; const int j = (int)(L - nfull); L = nfull + j / sk; u.nkt = nkt / sk; u.kt0 = (j % sk) * u.nkt; }
        if (L >= nwg) return false;
        int wgid = (int)L; { const int q = nwg / NXCD, r = nwg % NXCD, xcd = wgid % NXCD, off = wgid / NXCD; wgid = (xcd < r ? xcd * (q + 1) : r * (q + 1) + (xcd - r) * q) + off; }
        const int nig = WGM * nN, gid = wgid / nig, fm = gid * WGM, gsz = (nM - fm) < WGM ? (nM - fm) : WGM;
        u.pm = fm + ((wgid % nig) % gsz); u.pn = (wgid % nig) / gsz; return true;
    }
    __device__ __forceinline__ void a_ready(const Unit&) const {}
    __device__ __forceinline__ void done(const Unit&) const {}
};
__device__ __forceinline__ unsigned cvt_pk_bf16(float lo, float hi) { unsigned r; asm volatile("v_cvt_pk_bf16_f32 %0, %1, %2" : "=v"(r) : "v"(lo), "v"(hi)); return r; }
template <class Epi, class Sched, bool STAMP = false>
__device__ __forceinline__ void gemm_phase(PG8_LAS unsigned char* lds, const Gemm g, const Sched& S, const Epi& E, unsigned long long* stamps) {
    int tid_l = threadIdx.x; asm volatile("" : "+v"(tid_l));
    const int tid = tid_l, wid = __builtin_amdgcn_readfirstlane(tid >> 6), lane = tid & 63, wr = wid >> 2, wc = wid & 3, fr = lane & 15, fq = lane >> 4;
    const int K = g.K;
    int ts_lo = 0, ts_hi = 0, nts = 0; const unsigned long long rt_entry = STAMP ? (unsigned long long)wall_clock64() : 0ull;
#define PG8_STAMP() do { if (STAMP && wid == 0 && nts < 64) { const unsigned long long _c = (unsigned long long)clock64(); \
        ts_lo = (lane == nts) ? (int)(unsigned)_c : ts_lo; ts_hi = (lane == nts) ? (int)(unsigned)(_c >> 32) : ts_hi; ++nts; } } while (0)
    PG8_STAMP();
    unsigned voffA[2], voffB[2];
#pragma unroll
    for (int i = 0; i < 2; ++i) { int R, C; stage_rc(tid * 16 + i * 8192, R, C); const int Rb = Epi::PERM ? ((R & ~31) + perm32(R & 31)) : R;
        voffA[i] = (unsigned)(R * K + C) * 2u; voffB[i] = (unsigned)(Rb * K + C) * 2u; }
    const size_t kstep = (size_t)(BK * 2);
    const size_t hstep = (size_t)HALF * K * 2;
    const size_t tstep = 2 * hstep;
    const unsigned ldsw = (unsigned)wid * 1024u;
    const int aoff = lds_byte(wr * 64 + fr, fq * 8), boff = lds_byte(wc * 32 + fr, fq * 8);
#define PG8_SA(b, h) (((b) * 2 + (h)) * HTB)
#define PG8_SB(b, h) ((4 + (b) * 2 + (h)) * HTB)
#define PG8_STAGE(bufoff, gbase, voff) do { _Pragma("unroll") for (int _i = 0; _i < 2; ++_i) \
        __builtin_amdgcn_global_load_lds((const unsigned*)((const char*)(gbase) + (voff)[_i]), (PG8_LAS unsigned*)(lds + (bufoff) + ldsw + _i * 8192), 16, 0, 0); } while (0)
#define PG8_LDA(dst, b, h) do { _Pragma("unroll") for (int m = 0; m < 4; ++m) _Pragma("unroll") for (int k = 0; k < 2; ++k) dst[m][k] = *(const PG8_LAS bf16x8*)(lds + PG8_SA(b, h) + aoff + m * 2048 + k * 1024); } while (0)
#define PG8_LDB(dst, b, h) do { _Pragma("unroll") for (int n = 0; n < 2; ++n) _Pragma("unroll") for (int k = 0; k < 2; ++k) dst[n][k] = *(const PG8_LAS bf16x8*)(lds + PG8_SB(b, h) + boff + n * 2048 + k * 1024); } while (0)
#define PG8_MMA(ai, bj, At, Bt) do { __builtin_amdgcn_s_setprio(1); _Pragma("unroll") for (int m = 0; m < 4; ++m) _Pragma("unroll") for (int n = 0; n < 2; ++n) _Pragma("unroll") for (int k = 0; k < 2; ++k) \
        acc[ai][bj][m][n] = __builtin_amdgcn_mfma_f32_16x16x32_bf16(Bt[n][k], At[m][k], acc[ai][bj][m][n], 0, 0, 0); __builtin_amdgcn_s_setprio(0); } while (0)
#define PG8_WAIT_V(n) asm volatile("s_waitcnt vmcnt(" #n ")" ::: "memory")
#define PG8_WAIT_L(n) asm volatile("s_waitcnt lgkmcnt(" #n ")" ::: "memory")
#define PG8_BAR __builtin_amdgcn_s_barrier()
#define PG8_SCHED __builtin_amdgcn_sched_barrier(0)
    Unit cur, nxt; int ui = 0;
    if (!S.next(0, cur)) return;
    f32x4 acc[2][2][4][2];
#pragma unroll
    for (int a = 0; a < 2; ++a)
#pragma unroll
        for (int b = 0; b < 2; ++b)
#pragma unroll
            for (int m = 0; m < 4; ++m)
#pragma unroll
                for (int n = 0; n < 2; ++n) acc[a][b][m][n] = (f32x4){0.f, 0.f, 0.f, 0.f};
    bf16x8 At[4][2], B0[2][2], B1[2][2];
    const char* cA = (const char*)g.A + (size_t)cur.pm * tstep + (size_t)cur.kt0 * kstep; const char* cB = (const char*)g.Bt + (size_t)cur.pn * tstep + (size_t)cur.kt0 * kstep;
    int nt = cur.nkt;
    S.a_ready(cur);
    PG8_STAGE(PG8_SB(0, 0), cB, voffB); PG8_STAGE(PG8_SB(0, 1), cB + hstep, voffB); PG8_STAGE(PG8_SA(0, 0), cA, voffA); PG8_STAGE(PG8_SA(0, 1), cA + hstep, voffA);
    if (wr == 1) PG8_BAR;
    PG8_WAIT_V(2); PG8_BAR;
    PG8_STAGE(PG8_SB(1, 0), cB + kstep, voffB); PG8_STAGE(PG8_SA(1, 0), cA + kstep, voffA); PG8_STAGE(PG8_SB(1, 1), cB + hstep + kstep, voffB);
    PG8_WAIT_V(6); PG8_BAR;
    PG8_STAMP();
    for (;;) {
        const bool has_next = S.next(ui + 1, nxt);
        const char* nA = has_next ? (const char*)g.A + (size_t)nxt.pm * tstep + (size_t)nxt.kt0 * kstep : cA; const char* nB = has_next ? (const char*)g.Bt + (size_t)nxt.pn * tstep + (size_t)nxt.kt0 * kstep : cB;
        for (int t = 0; t < nt; t += 2) {
            const bool last = (t == nt - 2);
            const char* a1 = cA + (size_t)(t + 1) * kstep;
            const char* a2 = last ? nA : cA + (size_t)(t + 2) * kstep; const char* b2 = last ? nB : cB + (size_t)(t + 2) * kstep;
            const char* a3 = a2 + kstep; const char* b3 = b2 + kstep;
            if (last && has_next) S.a_ready(nxt);
            PG8_LDB(B0, 0, 0); PG8_LDB(B1, 0, 1); PG8_SCHED; PG8_LDA(At, 0, 0); PG8_STAGE(PG8_SA(1, 1), a1 + hstep, voffA);
            PG8_WAIT_V(8); PG8_WAIT_L(0); PG8_BAR; PG8_MMA(0, 0, At, B0); PG8_MMA(0, 1, At, B1); PG8_BAR; PG8_SCHED;
            PG8_LDA(At, 0, 1); PG8_STAGE(PG8_SB(0, 0), b2, voffB); PG8_STAGE(PG8_SB(0, 1), b2 + hstep, voffB); PG8_STAGE(PG8_SA(0, 0), a2, voffA);
            PG8_WAIT_V(8); PG8_WAIT_L(0); PG8_BAR; PG8_MMA(1, 0, At, B0); PG8_MMA(1, 1, At, B1); PG8_BAR; PG8_SCHED;
            PG8_LDB(B0, 1, 0); PG8_LDB(B1, 1, 1); PG8_SCHED; PG8_LDA(At, 1, 0); PG8_STAGE(PG8_SA(0, 1), a2 + hstep, voffA);
            PG8_WAIT_V(8); PG8_WAIT_L(0); PG8_BAR; PG8_MMA(0, 0, At, B0); PG8_MMA(0, 1, At, B1); PG8_BAR; PG8_SCHED;
            PG8_LDA(At, 1, 1); PG8_STAGE(PG8_SB(1, 0), b3, voffB); PG8_STAGE(PG8_SB(1, 1), b3 + hstep, voffB); PG8_STAGE(PG8_SA(1, 0), a3, voffA);
            PG8_WAIT_V(8); PG8_WAIT_L(0); PG8_BAR; PG8_MMA(1, 0, At, B0); PG8_MMA(1, 1, At, B1); PG8_BAR; PG8_SCHED;
        }
        PG8_STAMP();
        if (wr == 0) PG8_BAR;
        if constexpr (!Epi::AFTER_DRAIN) { E(acc, cur, wr, wc, fr, fq); S.done(cur); }
        PG8_STAMP();
        if (!has_next) break;
#pragma unroll
        for (int a = 0; a < 2; ++a)
#pragma unroll
            for (int b = 0; b < 2; ++b)
#pragma unroll
                for (int m = 0; m < 4; ++m)
#pragma unroll
                    for (int n = 0; n < 2; ++n) acc[a][b][m][n] = (f32x4){0.f, 0.f, 0.f, 0.f};
        cur = nxt; cA = nA; cB = nB; ++ui; nt = cur.nkt;
        if (wr == 1) PG8_BAR;
    }
    PG8_WAIT_V(0);
    PG8_BAR;
    if constexpr (Epi::AFTER_DRAIN) { E.fused(acc, cur, wr, wc, fr, fq, lds, wid, lane); S.done(cur); }
    PG8_STAMP();
    if (STAMP && wid == 0) { stamps[lane] = lane < nts ? (((unsigned long long)(unsigned)ts_hi << 32) | (unsigned)ts_lo) : 0ull;
        if (lane == 62) stamps[62] = rt_entry; if (lane == 63) stamps[63] = (unsigned long long)wall_clock64(); }
#undef PG8_STAMP
#undef PG8_SA
#undef PG8_SB
#undef PG8_STAGE
#undef PG8_LDA
#undef PG8_LDB
#undef PG8_MMA
#undef PG8_WAIT_V
#undef PG8_WAIT_L
#undef PG8_BAR
#undef PG8_SCHED
}
}
#define LAS __attribute__((address_space(3)))
#include <vector>

#define XB_TMO      128
#define XB_XCNT(j)  (256  + 64 * (j))
#define XB_XSUB(j)  (1280 + 64 * (j))
#define XB_XGEN(j)  (2304 + 64 * (j))
#define XB_TOP      3328
#define XB_TOPGEN   3392
#define XCD_BAR_WORDS 3456
#define XB_SPIN_CAP (1u << 18)

__device__ __forceinline__ unsigned xb_ld(unsigned* p)              { return __hip_atomic_load(p, __ATOMIC_RELAXED, __HIP_MEMORY_SCOPE_AGENT); }
__device__ __forceinline__ unsigned xb_add(unsigned* p, unsigned v) { return __hip_atomic_fetch_add(p, v, __ATOMIC_RELAXED, __HIP_MEMORY_SCOPE_AGENT); }
__device__ __forceinline__ unsigned xb_xcc_id() { return (unsigned)__builtin_amdgcn_s_getreg((3 << 11) | 20) & 0xFu; }
#define XB_SPIN(cond, bar) do { unsigned _sp = 0; while (cond) { __builtin_amdgcn_s_sleep(1); \
    if ((++_sp & 255u) == 0u) { if (xb_ld(&(bar)[XB_TMO])) break; if (_sp > XB_SPIN_CAP) { atomicAdd(&(bar)[XB_TMO], 1u); break; } } } } while (0)

struct XcdBarrier {
    unsigned* bar; unsigned x;
    volatile LAS unsigned* st;
};

__device__ __forceinline__ XcdBarrier xcd_barrier_post(unsigned* bar, volatile LAS unsigned* st) {
    XcdBarrier b; b.bar = bar; b.x = xb_xcc_id(); b.st = st;
    if (threadIdx.x == 0) (void)xb_add(&bar[XB_XCNT(b.x)], 1u);
    return b;
}
__device__ __forceinline__ void xcd_barrier_complete(unsigned* bar, unsigned x, unsigned& nloc, unsigned& nx) {
    const unsigned G = gridDim.x * gridDim.y * gridDim.z;
    unsigned sum, cnt, mine, sp = 0u;
    for (;;) {
        sum = 0u; cnt = 0u; mine = 0u;
#pragma unroll
        for (unsigned j = 0; j < 16; ++j) { const unsigned c = xb_ld(&bar[XB_XCNT(j)]); sum += c; cnt += (c > 0u) ? 1u : 0u; mine = (j == x) ? c : mine; }
        if (sum == G) break;
        __builtin_amdgcn_s_sleep(1);
        if ((++sp & 255u) == 0u) { if (xb_ld(&bar[XB_TMO])) break; if (sp > XB_SPIN_CAP) { atomicAdd(&bar[XB_TMO], 1u); break; } }
    }
    nloc = mine > 0u ? mine : 1u; nx = cnt > 0u ? cnt : 1u;
}

__device__ __forceinline__ void xcd_barrier(const XcdBarrier& b) {
    asm volatile("s_waitcnt vmcnt(0)" ::: "memory");
    __syncthreads();
    if (threadIdx.x == 0) {
        unsigned* bar = b.bar;
        __builtin_amdgcn_s_waitcnt(0);
        unsigned nloc = b.st[0], nx = b.st[1];
        if (nloc == 0u) { xcd_barrier_complete(bar, b.x, nloc, nx); b.st[0] = nloc; b.st[1] = nx; }
        const unsigned old = xb_add(&bar[XB_XSUB(b.x)], 1u);
        const unsigned gen = old / nloc;
        if (old + 1u == (gen + 1u) * nloc) {
            __builtin_amdgcn_fence(__ATOMIC_RELEASE, "agent");
            asm volatile("s_waitcnt vmcnt(0)" ::: "memory");
            const unsigned og = xb_add(&bar[XB_TOP], 1u);
            const unsigned tg = og / nx;
            if (og + 1u == (tg + 1u) * nx) xb_add(&bar[XB_TOPGEN], 1u);
            else XB_SPIN(xb_ld(&bar[XB_TOPGEN]) == tg, bar);
            __builtin_amdgcn_fence(__ATOMIC_ACQUIRE, "agent");
            xb_add(&bar[XB_XGEN(b.x)], 1u);
            asm volatile("s_waitcnt vmcnt(0)" ::: "memory");
        } else {
            XB_SPIN(xb_ld(&bar[XB_XGEN(b.x)]) == gen, bar);
            __builtin_amdgcn_fence(__ATOMIC_ACQUIRE, "agent");
            asm volatile("s_waitcnt vmcnt(0)" ::: "memory");
        }
    }
    __syncthreads();
}
namespace cg = cooperative_groups;
using pg8::bf16_t; using pg8::bf16x8; using pg8::f32x4; using pg8::u32x4;

typedef unsigned u32x2 __attribute__((ext_vector_type(2)));
typedef float f32x2v __attribute__((ext_vector_type(2)));

constexpr int D = 2048, TP = 2064, NBP = 4, MPR = NBP * TP, NBS = 128, TSM = 8, MSM = NBS * TSM, MTOT = MPR + MSM, MPAD = 9472;
constexpr float ALPHA = 1.41421356237309515f;
#ifndef REP_P0
#define REP_P0 1
#endif
#ifndef REP_HGRN
#define REP_HGRN 1
#endif
#ifndef REP_ATT
#define REP_ATT 1
#endif
#ifndef REP_LN
#define REP_LN 1
#endif
#ifndef REP_G1
#define REP_G1 1
#endif
#ifndef REP_G2
#define REP_G2 1
#endif
constexpr float LN_EPS = 1e-5f, RMS_EPS = 1e-6f;
constexpr int LDS_BYTES = 131072 + 64;
constexpr size_t OUT_YP = 0, OUT_YS = 16777216, OUT_SP = 18874368, OUT_SS = 19922944, OUT_KP = 53477376, OUT_VP = 53608448, OUT_KS = 53739520, OUT_VS = 57933824;
constexpr size_t SZ_BF = (size_t)MPAD * D * 2, SZ_F32 = (size_t)MPAD * D * 4;
constexpr size_t WS_WT0 = 0, WS_WTO0 = WS_WT0 + 33554432, WS_WT1 = WS_WTO0 + 8388608, WS_WTO1 = WS_WT1 + 18874368, WS_XB = WS_WTO1 + 8388608,
                 WS_QB = WS_XB + SZ_BF, WS_VB = WS_QB + SZ_BF, WS_GB = WS_VB + SZ_BF, WS_OB = WS_GB + SZ_BF, WS_LF = WS_OB + SZ_BF, WS_ZB = WS_LF + SZ_F32,
                 WS_K1 = WS_ZB + SZ_F32, WS_V1 = WS_K1 + 4849664, WS_LB = WS_V1 + 4849664, WS_BAR = WS_LB + 8192, WS_HU = WS_BAR + 16384, WS_HD = WS_HU + 256 * 65536, WS_END = WS_HD + 256 * 512;

struct Params {
    const float *x_prompt, *x_sample, *state, *cache_k, *cache_v, *meta, *w_in0, *lb_logits, *norm_w, *w_out0, *w_in1, *sinks, *w_out1, *ln_g, *ln_b;
    float* out; unsigned char* ws;
};

__device__ __forceinline__ float bf2f(unsigned short b) { return __uint_as_float(((unsigned)b) << 16); }
__device__ __forceinline__ unsigned short f2bf(float f) { unsigned u = __float_as_uint(f); u += 0x7FFFu + ((u >> 16) & 1u); return (unsigned short)(u >> 16); }
__device__ __forceinline__ unsigned pk2(float lo, float hi) { return pg8::cvt_pk_bf16(lo, hi); }
__device__ __forceinline__ float sigmoidf_(float x) { return __builtin_amdgcn_rcpf(1.0f + __builtin_amdgcn_exp2f(x * -1.44269504089f)); }
__device__ __forceinline__ float siluf_(float x) { return x * __builtin_amdgcn_rcpf(1.0f + __builtin_amdgcn_exp2f(x * -1.44269504089f)); }
#define LDS_WAIT() asm volatile("s_waitcnt lgkmcnt(0)" ::: "memory")

__device__ __forceinline__ const float* xrow_ptr(const Params& p, int row) {
    if (row < MPR) { const int b = row / TP, t = row - b * TP; return t < 16 ? p.meta + (size_t)t * D : p.x_prompt + ((size_t)b * 2048 + (t - 16)) * D; }
    return p.x_sample + (size_t)(row - MPR) * D;
}

struct WSel { const float* W; int N; bf16_t* WT; int r; };
__device__ __forceinline__ void p0_item_load(const WSel& s, int lane, f32x4 (&wv)[8]) {
    const int nblk = s.N / 32, kb = s.r / nblk, nb = s.r % nblk, k0 = 64 * kb, n0 = 32 * nb;
#pragma unroll
    for (int i = 0; i < 8; ++i) wv[i] = __builtin_nontemporal_load((const f32x4*)(s.W + (size_t)(k0 + 8 * i + (lane >> 3)) * s.N + n0 + 4 * (lane & 7)));
}
__device__ __forceinline__ void p0_item_store(const WSel& s, int lane, const f32x4 (&wv)[8], LAS float* scr) {
    constexpr int K = 2048;
    const int nblk = s.N / 32, kb = s.r / nblk, nb = s.r % nblk, k0 = 64 * kb, n0 = 32 * nb;
#pragma unroll
    for (int i = 0; i < 8; ++i) { LAS float* d_ = scr + (8 * i + (lane >> 3)) * 33 + 4 * (lane & 7); d_[0] = wv[i].x; d_[1] = wv[i].y; d_[2] = wv[i].z; d_[3] = wv[i].w; }
    LDS_WAIT();
    const int c = lane & 7;
#pragma unroll
    for (int j = 0; j < 4; ++j) { const int n = (lane >> 3) + 8 * j; const LAS float* q = scr + (8 * c) * 33 + n;
        u32x4 o; o.x = pk2(q[0 * 33], q[1 * 33]); o.y = pk2(q[2 * 33], q[3 * 33]); o.z = pk2(q[4 * 33], q[5 * 33]); o.w = pk2(q[6 * 33], q[7 * 33]);
        *(u32x4*)(s.WT + (size_t)(n0 + n) * K + k0 + 8 * c) = o; }
    LDS_WAIT();
}
__device__ __forceinline__ WSel p0_select(const Params& p, int set, int it) {
    constexpr int I1 = 32 * 64, I2 = 32 * 144;
    WSel s;
    if (set == 0) { s.W = p.w_in0; s.N = 8192; s.WT = (bf16_t*)(p.ws + WS_WT0); s.r = it; return s; }
    if (it < I1) { s.W = p.w_out0; s.N = 2048; s.WT = (bf16_t*)(p.ws + WS_WTO0); s.r = it; }
    else if (it < I1 + I2) { s.W = p.w_in1; s.N = 4608; s.WT = (bf16_t*)(p.ws + WS_WT1); s.r = it - I1; }
    else { s.W = p.w_out1; s.N = 2048; s.WT = (bf16_t*)(p.ws + WS_WTO1); s.r = it - I1 - I2; }
    return s;
}
__device__ __forceinline__ void p0_convert_items(const Params& p, int set, int first, int step, int total, LAS float* scr, int lane) {
    if (first >= total) return;
    f32x4 wv[8]; WSel cur = p0_select(p, set, first); p0_item_load(cur, lane, wv);
    for (int it = first; it < total; it += step) {
        f32x4 wc[8];
#pragma unroll
        for (int i = 0; i < 8; ++i) wc[i] = wv[i];
        const WSel me = cur;
        if (it + step < total) { cur = p0_select(p, set, it + step); p0_item_load(cur, lane, wv); }
        p0_item_store(me, lane, wc, scr);
    }
}

__device__ __forceinline__ void phase0(const Params& p, LAS unsigned char* lds) {
    int tid_l = threadIdx.x; asm volatile("" : "+v"(tid_l)); const int tid = tid_l, wave = tid >> 6, lane = tid & 63;
    const int NGW = gridDim.x * 8, gw = wave * gridDim.x + blockIdx.x;
    LAS float* scr = (LAS float*)(lds + wave * 8448);
    constexpr int I0 = 32 * 256;
    bf16_t* WT0 = (bf16_t*)(p.ws + WS_WT0);
    p0_convert_items(p, 0, gw, NGW, I0, scr, lane);
    bf16_t* XB = (bf16_t*)(p.ws + WS_XB);
    { f32x4 xv[8];
      if (gw < MTOT) { const f32x4* s0_ = (const f32x4*)xrow_ptr(p, gw) + lane;
#pragma unroll
          for (int j = 0; j < 8; ++j) xv[j] = __builtin_nontemporal_load(s0_ + 64 * j); }
      for (int m = gw; m < MTOT; m += NGW) {
          u32x2* dst = (u32x2*)(XB + (size_t)m * D) + lane; u32x2 o[8];
#pragma unroll
          for (int j = 0; j < 8; ++j) { o[j].x = pk2(xv[j].x, xv[j].y); o[j].y = pk2(xv[j].z, xv[j].w); }
          if (m + NGW < MTOT) { const f32x4* sn_ = (const f32x4*)xrow_ptr(p, m + NGW) + lane;
#pragma unroll
              for (int j = 0; j < 8; ++j) xv[j] = __builtin_nontemporal_load(sn_ + 64 * j); }
#pragma unroll
          for (int j = 0; j < 8; ++j) dst[64 * j] = o[j];
      } }
    const int gt = blockIdx.x * 512 + tid, NGT = gridDim.x * 512;
    float* LB = (float*)(p.ws + WS_LB);
    for (int c = gt; c < D; c += NGT) { const float a = p.lb_logits[c], b = p.lb_logits[D + c], cc = p.lb_logits[2 * D + c]; const float m = fmaxf(a, fmaxf(b, cc));
        const float ea = __expf(a - m), eb = __expf(b - m), ec = __expf(cc - m); LB[c] = ea / (ea + eb + ec); }
}
__device__ __forceinline__ void phase0_rest(const Params& p, LAS unsigned char* lds, int li, int nl) {
    int tid_l = threadIdx.x; asm volatile("" : "+v"(tid_l)); const int tid = tid_l, wave = tid >> 6, lane = tid & 63;
    const int gw = li * 8 + wave, NGW = nl * 8;
    LAS float* scr = (LAS float*)(lds + wave * 8448);
    constexpr int I1 = 32 * 64, I2 = 32 * 144, I3 = 32 * 64;
    bf16_t* WTO0 = (bf16_t*)(p.ws + WS_WTO0); bf16_t* WT1 = (bf16_t*)(p.ws + WS_WT1); bf16_t* WTO1 = (bf16_t*)(p.ws + WS_WTO1);
    p0_convert_items(p, 1, gw, NGW, I1 + I2 + I3, scr, lane);
}
__device__ __forceinline__ void phase_cache_shift(const Params& p, int li, int nl) {
    const int gt = li * 512 + threadIdx.x, NGT = nl * 512;
    const f32x4* ck = (const f32x4*)p.cache_k; const f32x4* cv = (const f32x4*)p.cache_v; f32x4* ok = (f32x4*)(p.out + OUT_KS); f32x4* ov = (f32x4*)(p.out + OUT_VS);
    constexpr int PER_B = 120 * 64;
    for (int i0 = gt; i0 < NBS * PER_B; i0 += 4 * NGT) { f32x4 a[4], c[4]; size_t o[4]; bool ok_[4];
#pragma unroll
        for (int u = 0; u < 4; ++u) { const int i = i0 + u * NGT; ok_[u] = i < NBS * PER_B; const int ii = ok_[u] ? i : 0; const int b = ii / PER_B, r = ii - b * PER_B; o[u] = (size_t)b * 8192 + r;
            a[u] = __builtin_nontemporal_load(ck + o[u] + 512); c[u] = __builtin_nontemporal_load(cv + o[u] + 512); }
#pragma unroll
        for (int u = 0; u < 4; ++u) if (ok_[u]) { __builtin_nontemporal_store(a[u], ok + o[u]); __builtin_nontemporal_store(c[u], ov + o[u]); } }
}

struct EpiHgrnIn {
    static constexpr bool PERM = true, AFTER_DRAIN = false;
    unsigned char* ws; float* LF; const float* LB;
    __device__ __forceinline__ void operator()(const f32x4 (&acc)[2][2][4][2], const pg8::Unit& u, int wr, int wc, int fr, int fq) const {
        const int sec = u.pn >> 3, colt = (u.pn & 7) * 256;
        const size_t secoff = sec == 0 ? WS_QB : (sec == 2 ? WS_VB : WS_GB);
        bf16_t* dst = (bf16_t*)(ws + secoff);
        const int row0 = u.pm * 256 + wr * 64 + fr, col0 = colt + wc * 32 + 8 * fq;
        float lb[2][8];
        if (sec == 1) {
#pragma unroll
            for (int bj = 0; bj < 2; ++bj) { const f32x4 a = *(const f32x4*)(LB + col0 + bj * 128), b = *(const f32x4*)(LB + col0 + bj * 128 + 4);
                lb[bj][0] = a.x; lb[bj][1] = a.y; lb[bj][2] = a.z; lb[bj][3] = a.w; lb[bj][4] = b.x; lb[bj][5] = b.y; lb[bj][6] = b.z; lb[bj][7] = b.w; }
        }
#pragma unroll
        for (int ai = 0; ai < 2; ++ai)
#pragma unroll
            for (int m = 0; m < 4; ++m) {
                const int row = row0 + ai * 128 + m * 16; if (row >= MTOT) continue;
#pragma unroll
                for (int bj = 0; bj < 2; ++bj) {
                    const size_t off = (size_t)row * D + col0 + bj * 128;
                    const f32x4 v0 = acc[ai][bj][m][0], v1 = acc[ai][bj][m][1];
                    float x[8] = {v0.x, v0.y, v0.z, v0.w, v1.x, v1.y, v1.z, v1.w};
                    if (sec == 1) {
#pragma unroll
                        for (int j = 0; j < 8; ++j) { const float l = lb[bj][j]; x[j] = l + (1.0f - l) * sigmoidf_(x[j]); }
                        *(f32x4*)(LF + off) = (f32x4){x[0], x[1], x[2], x[3]}; *(f32x4*)(LF + off + 4) = (f32x4){x[4], x[5], x[6], x[7]};
                    } else {
                        if (sec == 3) {
#pragma unroll
                            for (int j = 0; j < 8; ++j) x[j] = siluf_(x[j]);
                        }
                        u32x4 w; w.x = pk2(x[0], x[1]); w.y = pk2(x[2], x[3]); w.z = pk2(x[4], x[5]); w.w = pk2(x[6], x[7]);
                        *(u32x4*)(dst + off) = w;
                    }
                }
            }
    }
};
struct EpiSwaIn {
    static constexpr bool PERM = true, AFTER_DRAIN = false;
    bf16_t* Q; bf16_t* K1; bf16_t* V1; bf16_t* G; float* out;
    __device__ __forceinline__ void operator()(const f32x4 (&acc)[2][2][4][2], const pg8::Unit& u, int wr, int wc, int fr, int fq) const {
        const int pn = u.pn;
        const int row0 = u.pm * 256 + wr * 64 + fr, cw = wc * 32 + 8 * fq;
#pragma unroll
        for (int ai = 0; ai < 2; ++ai)
#pragma unroll
            for (int m = 0; m < 4; ++m) {
                const int row = row0 + ai * 128 + m * 16; if (row >= MTOT) continue;
#pragma unroll
                for (int bj = 0; bj < 2; ++bj) {
                    const f32x4 v0 = acc[ai][bj][m][0], v1 = acc[ai][bj][m][1];
                    float x[8] = {v0.x, v0.y, v0.z, v0.w, v1.x, v1.y, v1.z, v1.w};
                    const int c = cw + bj * 128;
                    if (pn < 8) {
                        constexpr float QS = 0.125f * 1.44269504089f;
                        u32x4 w; w.x = pk2(x[0] * QS, x[1] * QS); w.y = pk2(x[2] * QS, x[3] * QS); w.z = pk2(x[4] * QS, x[5] * QS); w.w = pk2(x[6] * QS, x[7] * QS);
                        *(u32x4*)(Q + (size_t)row * D + pn * 256 + c) = w;
                    } else if (pn >= 10) {
#pragma unroll
                        for (int j = 0; j < 8; ++j) x[j] = siluf_(x[j]);
                        u32x4 w; w.x = pk2(x[0], x[1]); w.y = pk2(x[2], x[3]); w.z = pk2(x[4], x[5]); w.w = pk2(x[6], x[7]);
                        *(u32x4*)(G + (size_t)row * D + (pn - 10) * 256 + c) = w;
                    } else {
                        u32x4 w; w.x = pk2(x[0], x[1]); w.y = pk2(x[2], x[3]); w.z = pk2(x[4], x[5]); w.w = pk2(x[6], x[7]);
                        bf16_t* dst = pn == 8 ? K1 : V1;
                        *(u32x4*)(dst + (size_t)row * 256 + c) = w;
                        float* co = nullptr;
                        if (row < MPR) { const int b = row / TP, t = row - b * TP; if (t >= TP - 128) co = out + (pn == 8 ? OUT_KP : OUT_VP) + ((size_t)b * 128 + (t - (TP - 128))) * 256 + c; }
                        else { const int r = row - MPR, b = r >> 3, t = r & 7; co = out + (pn == 8 ? OUT_KS : OUT_VS) + ((size_t)b * 128 + 120 + t) * 256 + c; }
                        if (co) { __builtin_nontemporal_store(v0, (f32x4*)co); __builtin_nontemporal_store(v1, (f32x4*)(co + 4)); }
                    }
                }
            }
    }
};
constexpr int SPLIT_ROW0 = 8192, SLAB_ROWS = MTOT - 8192;
struct OrderOut {
    pg8::StaticOrder S32; int G, c;
    __device__ void init(int G_, int c_) { S32.init(SPLIT_ROW0, 2048, G_, c_, 2048, 0); G = G_; c = c_; }
    __device__ bool next(int i, pg8::Unit& u) const {
        if (S32.next(i, u)) return true;
        const int R = (256 + G - 1) / G; if (i < R) return false;
        const long j = (long)(i - R) * G + c; if (j >= 160) return false;
        const int un = (int)(j >> 2); u.pm = 32 + (un >> 3); u.pn = un & 7; u.nkt = 8; u.kt0 = 8 * (int)(j & 3); return true;
    }
    __device__ __forceinline__ void a_ready(const pg8::Unit&) const {}
    __device__ __forceinline__ void done(const pg8::Unit&) const {}
};
struct EpiY {
    static constexpr bool PERM = true, AFTER_DRAIN = false;
    bf16_t* Y; float* slab;
    __device__ __forceinline__ void operator()(const f32x4 (&acc)[2][2][4][2], const pg8::Unit& u, int wr, int wc, int fr, int fq) const {
        const int row0 = u.pm * 256 + wr * 64 + fr, col0 = u.pn * 256 + wc * 32 + 8 * fq;
        const bool whole = u.nkt == 32;
        float* sbase = slab + ((size_t)(u.kt0 >> 3) * SLAB_ROWS - SPLIT_ROW0) * D;
#pragma unroll
        for (int ai = 0; ai < 2; ++ai)
#pragma unroll
            for (int m = 0; m < 4; ++m) {
                const int row = row0 + ai * 128 + m * 16; if (row >= MTOT) continue;
#pragma unroll
                for (int bj = 0; bj < 2; ++bj) { const f32x4 v0 = acc[ai][bj][m][0], v1 = acc[ai][bj][m][1]; const size_t off = (size_t)row * D + col0 + bj * 128;
                    if (whole) { u32x4 w; w.x = pk2(v0.x, v0.y); w.y = pk2(v0.z, v0.w); w.z = pk2(v1.x, v1.y); w.w = pk2(v1.z, v1.w); *(u32x4*)(Y + off) = w; }
                    else { *(f32x4*)(sbase + off) = v0; *(f32x4*)(sbase + off + 4) = v1; } }
            }
    }
};

template <int MODE> __device__ __forceinline__ void phase_ln(const Params& p, int layer) {
    int tid_l = threadIdx.x; asm volatile("" : "+v"(tid_l)); const int tid = tid_l, wave = tid >> 6, lane = tid & 63;
    const int NGW = gridDim.x * 8, gw = wave * gridDim.x + blockIdx.x;
    float* ZB = (float*)(p.ws + WS_ZB); bf16_t* XB = (bf16_t*)(p.ws + WS_XB); const bf16_t* YB = (const bf16_t*)(p.ws + WS_VB); const float* SL = (const float*)(p.ws + WS_LF);
    const f32x4* gp = (const f32x4*)(p.ln_g + (size_t)layer * D) + lane; const f32x4* bp = (const f32x4*)(p.ln_b + (size_t)layer * D) + lane;
    f32x4 gam[8], bet[8];
#pragma unroll
    for (int j = 0; j < 8; ++j) { gam[j] = gp[64 * j]; bet[j] = bp[64 * j]; }
    f32x4 nv[8]; u32x2 ny[8];
#define LN_LOAD(m_) do { const u32x2* y_ = (const u32x2*)(YB + (size_t)(m_) * D) + lane; \
        if (MODE == 1) { const f32x4* x_ = (const f32x4*)xrow_ptr(p, (m_)) + lane; _Pragma("unroll") for (int j = 0; j < 8; ++j) nv[j] = __builtin_nontemporal_load(x_ + 64 * j); } \
        else { const u32x2* x_ = (const u32x2*)(XB + (size_t)(m_) * D) + lane; _Pragma("unroll") for (int j = 0; j < 8; ++j) { const u32x2 w_ = x_[64 * j]; nv[j] = (f32x4){bf2f((unsigned short)(w_.x & 0xffffu)), bf2f((unsigned short)(w_.x >> 16)), bf2f((unsigned short)(w_.y & 0xffffu)), bf2f((unsigned short)(w_.y >> 16))}; } } \
        if ((m_) < SPLIT_ROW0) { _Pragma("unroll") for (int j = 0; j < 8; ++j) ny[j] = __builtin_nontemporal_load(y_ + 64 * j); } } while (0)
    if (gw < MTOT) LN_LOAD(gw);
    for (int m = gw; m < MTOT; m += NGW) {
        f32x4 v[8]; float s = 0.f;
        if (m < SPLIT_ROW0) {
#pragma unroll
            for (int j = 0; j < 8; ++j) { const f32x4 y = (f32x4){bf2f((unsigned short)(ny[j].x & 0xffffu)), bf2f((unsigned short)(ny[j].x >> 16)), bf2f((unsigned short)(ny[j].y & 0xffffu)), bf2f((unsigned short)(ny[j].y >> 16))}; v[j] = nv[j] * ALPHA + y; }
        } else {
#pragma unroll
            for (int j = 0; j < 8; ++j) v[j] = nv[j] * ALPHA;
            const f32x4* sl = (const f32x4*)(SL + (size_t)(m - SPLIT_ROW0) * D) + lane;
#pragma unroll
            for (int pc = 0; pc < 4; ++pc)
#pragma unroll
                for (int j = 0; j < 8; ++j) v[j] = v[j] + __builtin_nontemporal_load(sl + (size_t)pc * SLAB_ROWS * (D / 4) + 64 * j);
        }
        if (m + NGW < MTOT) LN_LOAD(m + NGW);
#pragma unroll
        for (int j = 0; j < 8; ++j) s += (v[j].x + v[j].y) + (v[j].z + v[j].w);
#pragma unroll
        for (int o = 1; o < 64; o <<= 1) s += __shfl_xor(s, o);
        const float mean = s * (1.0f / D); float s2 = 0.f;
#pragma unroll
        for (int j = 0; j < 8; ++j) { v[j] = v[j] - mean; s2 += (v[j].x * v[j].x + v[j].y * v[j].y) + (v[j].z * v[j].z + v[j].w * v[j].w); }
#pragma unroll
        for (int o = 1; o < 64; o <<= 1) s2 += __shfl_xor(s2, o);
        const float rstd = rsqrtf(s2 * (1.0f / D) + LN_EPS);
        if (MODE == 1) {
            u32x2* xb = (u32x2*)(XB + (size_t)m * D) + lane;
#pragma unroll
            for (int j = 0; j < 8; ++j) { const f32x4 y = v[j] * rstd * gam[j] + bet[j]; u32x2 o; o.x = pk2(y.x, y.y); o.y = pk2(y.z, y.w); xb[64 * j] = o; }
        } else {
            float* dst = nullptr;
            if (m < MPR) { const int b = m / TP, t = m - b * TP; if (t >= 16) dst = p.out + OUT_YP + ((size_t)b * 2048 + (t - 16)) * D; }
            else dst = p.out + OUT_YS + (size_t)(m - MPR) * D;
            if (dst) { f32x4* d4 = (f32x4*)dst + lane;
#pragma unroll
                for (int j = 0; j < 8; ++j) __builtin_nontemporal_store(v[j] * rstd * gam[j] + bet[j], d4 + 64 * j); }
        }
    }
#undef LN_LOAD
}

constexpr int H_QT = 0, H_KT = 17408, H_KTT = 34816, H_VT = 53248, H_AM = 71680, H_S0T = 80896, H_DEC = 115712, H_SEG = 116224;
#define MFMA16(a, b, c) __builtin_amdgcn_mfma_f32_16x16x32_bf16((a), (b), (c), 0, 0, 0)

__device__ __forceinline__ void hgrn_chain(const Params& p, LAS unsigned char* lds, int item, int pass) {
    const int ci = item >> 2, sg = item & 3;
    const int c_begin = sg == 0 ? 0 : 1 + 8 * sg, c_end = 9 + 8 * sg;
    const bool full = pass != 0;
    if (!full && sg == 3) return;
    int tid_l = threadIdx.x; asm volatile("" : "+v"(tid_l)); const int tid = tid_l, w = tid >> 6, lane = tid & 63, r16 = lane & 15, quad = lane >> 4;
    const int kcol = tid & 127, seg = tid >> 7;
    const int b = ci >> 4, h = ci & 15;
    const bf16_t* QB = (const bf16_t*)(p.ws + WS_QB); const float* LF = (const float*)(p.ws + WS_LF); const bf16_t* VB = (const bf16_t*)(p.ws + WS_VB);
    const bf16_t* GB = (const bf16_t*)(p.ws + WS_GB); bf16_t* OB = (bf16_t*)(p.ws + WS_OB);
    const int colbase = h * 128;
    const int tt = w >> 1, vh = w & 1;
    f32x4 S[8];
#pragma unroll
    for (int i = 0; i < 8; ++i) S[i] = (f32x4){0.f, 0.f, 0.f, 0.f};
    f32x4 dprod = (f32x4){1.f, 1.f, 1.f, 1.f};
    float* HU = (float*)(p.ws + WS_HU); float* HD = (float*)(p.ws + WS_HD);
    if (full) {
        for (int j = 0; j < sg; ++j) { const float* U = HU + (size_t)(ci * 4 + j) * 16384; const f32x4 dj = *(const f32x4*)(HD + (ci * 4 + j) * 128 + 16 * w + 4 * quad);
#pragma unroll
            for (int vt = 0; vt < 8; ++vt)
#pragma unroll
                for (int r = 0; r < 4; ++r) S[vt][r] = dj[r] * S[vt][r] + U[(16 * w + 4 * quad + r) * 128 + 16 * vt + r16]; }
#pragma unroll
        for (int vt = 0; vt < 8; ++vt) *(LAS u32x2*)(lds + H_S0T + (16 * vt + r16) * 272 + (16 * w + 4 * quad) * 2) = (u32x2){pk2(S[vt].x, S[vt].y), pk2(S[vt].z, S[vt].w)};
    }
    float lf[16]; unsigned short qr[16], vr[16];
#define HG_LOAD(c_) do { const int t0_ = 64 * (c_); _Pragma("unroll") for (int i = 0; i < 16; ++i) { const int t_ = t0_ + 16 * seg + i; const bool ok_ = t_ < TP; \
        const size_t off_ = ((size_t)(b * TP + (ok_ ? t_ : 0))) * D + colbase + kcol; \
        float l_; unsigned short q_ = 0, v_; if (full) { l_ = __builtin_nontemporal_load(LF + off_); q_ = __builtin_nontemporal_load(QB + off_); v_ = __builtin_nontemporal_load(VB + off_); } else { l_ = LF[off_]; v_ = VB[off_]; } \
        lf[i] = ok_ ? l_ : 1.f; qr[i] = ok_ ? q_ : (unsigned short)0; vr[i] = ok_ ? v_ : (unsigned short)0; } } while (0)
    f32x4 nw4[4];
#pragma unroll
    for (int i = 0; i < 4; ++i) nw4[i] = *(const f32x4*)(p.norm_w + colbase + 16 * (tid & 7) + 4 * i);
    HG_LOAD(c_begin);
    for (int c = c_begin; c < c_end; ++c) {
        float bl[16]; float run = 1.f;
#pragma unroll
        for (int i = 0; i < 16; ++i) { run *= lf[i]; bl[i] = run; }
        ((LAS float*)(lds + H_SEG))[seg * 128 + kcol] = run;
        __syncthreads();
        float pre = 1.f;
        for (int s = 0; s < seg; ++s) pre *= ((LAS float*)(lds + H_SEG))[s * 128 + kcol];
        unsigned ktp[8], vtp[8]; float eb_last = 1.f;
#pragma unroll
        for (int i = 0; i < 16; i += 2) {
            float kt2[2], qt2[2];
#pragma unroll
            for (int e = 0; e < 2; ++e) { const float eb = pre * bl[i + e], enb = __builtin_amdgcn_rcpf(eb); const float q = bf2f(qr[i + e]); const float kk = 1.0f - lf[i + e];
                qt2[e] = q * eb; kt2[e] = kk * enb; eb_last = eb; }
            ktp[i >> 1] = pk2(kt2[0], kt2[1]); vtp[i >> 1] = (unsigned)vr[i] | ((unsigned)vr[i + 1] << 16);
            if (full) { const unsigned qp = pk2(qt2[0], qt2[1]); const int ts = 16 * seg + i;
                *(LAS unsigned short*)(lds + H_QT + ts * 272 + kcol * 2) = (unsigned short)qp; *(LAS unsigned short*)(lds + H_QT + (ts + 1) * 272 + kcol * 2) = (unsigned short)(qp >> 16);
                *(LAS unsigned short*)(lds + H_KT + ts * 272 + kcol * 2) = (unsigned short)ktp[i >> 1]; *(LAS unsigned short*)(lds + H_KT + (ts + 1) * 272 + kcol * 2) = (unsigned short)(ktp[i >> 1] >> 16); }
        }
        *(LAS u32x4*)(lds + H_KTT + kcol * 144 + seg * 32) = (u32x4){ktp[0], ktp[1], ktp[2], ktp[3]};
        *(LAS u32x4*)(lds + H_KTT + kcol * 144 + seg * 32 + 16) = (u32x4){ktp[4], ktp[5], ktp[6], ktp[7]};
        *(LAS u32x4*)(lds + H_VT + kcol * 144 + seg * 32) = (u32x4){vtp[0], vtp[1], vtp[2], vtp[3]};
        *(LAS u32x4*)(lds + H_VT + kcol * 144 + seg * 32 + 16) = (u32x4){vtp[4], vtp[5], vtp[6], vtp[7]};
        if (seg == 3) ((LAS float*)(lds + H_DEC))[kcol] = eb_last;
        { const int cn = (c + 1 < c_end) ? c + 1 : c; HG_LOAD(cn); }
        __syncthreads();
        const f32x4 dec = *(const LAS f32x4*)(lds + H_DEC + (16 * w + 4 * quad) * 4);
        dprod = dprod * dec;
        if (!full) {
#pragma unroll
            for (int ss = 0; ss < 2; ++ss) { const bf16x8 ka = *(const LAS bf16x8*)(lds + H_KTT + (16 * w + r16) * 144 + (32 * ss + 8 * quad) * 2);
#pragma unroll
                for (int vt = 0; vt < 8; ++vt) { const bf16x8 vb = *(const LAS bf16x8*)(lds + H_VT + (16 * vt + r16) * 144 + (32 * ss + 8 * quad) * 2); S[vt] = MFMA16(ka, vb, S[vt]); } }
#pragma unroll
            for (int vt = 0; vt < 8; ++vt) S[vt] = S[vt] * dec;
        } else {
        const int nt_ = tid >> 3, njj = tid & 7; const int tg = 64 * c + nt_;
        const size_t goff = ((size_t)(tg < TP ? b * TP + tg : MTOT + nt_)) * D + colbase + 16 * njj;
        const u32x4 g0 = __builtin_nontemporal_load((const u32x4*)(GB + goff)), g1 = __builtin_nontemporal_load((const u32x4*)(GB + goff + 8));
        bf16x8 qa[4];
#pragma unroll
        for (int ks = 0; ks < 4; ++ks) qa[ks] = *(const LAS bf16x8*)(lds + H_QT + (16 * tt + r16) * 272 + (32 * ks + 8 * quad) * 2);
        f32x4 O[4];
#pragma unroll
        for (int j = 0; j < 4; ++j) { O[j] = (f32x4){0.f, 0.f, 0.f, 0.f}; const int vt = 4 * vh + j;
#pragma unroll
            for (int ks = 0; ks < 4; ++ks) { const bf16x8 sb = *(const LAS bf16x8*)(lds + H_S0T + (16 * vt + r16) * 272 + (32 * ks + 8 * quad) * 2); O[j] = MFMA16(qa[ks], sb, O[j]); } }
#pragma unroll
        for (int j = 0; j < 2; ++j) { const int st = 2 * vh + j; f32x4 a = (f32x4){0.f, 0.f, 0.f, 0.f};
            if (st <= tt) {
#pragma unroll
                for (int ks = 0; ks < 4; ++ks) { const bf16x8 kb = *(const LAS bf16x8*)(lds + H_KT + (16 * st + r16) * 272 + (32 * ks + 8 * quad) * 2); a = MFMA16(qa[ks], kb, a); } }
#pragma unroll
            for (int r = 0; r < 4; ++r) { const int tl = 16 * tt + 4 * quad + r, sl = 16 * st + r16; const float val = (sl <= tl) ? a[r] : 0.f;
                *(LAS unsigned short*)(lds + H_AM + tl * 144 + sl * 2) = f2bf(val); } }
        __syncthreads();
#pragma unroll
        for (int ss = 0; ss < 2; ++ss) { const bf16x8 aa = *(const LAS bf16x8*)(lds + H_AM + (16 * tt + r16) * 144 + (32 * ss + 8 * quad) * 2);
#pragma unroll
            for (int j = 0; j < 4; ++j) { const int vt = 4 * vh + j; const bf16x8 vb = *(const LAS bf16x8*)(lds + H_VT + (16 * vt + r16) * 144 + (32 * ss + 8 * quad) * 2); O[j] = MFMA16(aa, vb, O[j]); } }
#pragma unroll
        for (int ss = 0; ss < 2; ++ss) { const bf16x8 ka = *(const LAS bf16x8*)(lds + H_KTT + (16 * w + r16) * 144 + (32 * ss + 8 * quad) * 2);
#pragma unroll
            for (int vt = 0; vt < 8; ++vt) { const bf16x8 vb = *(const LAS bf16x8*)(lds + H_VT + (16 * vt + r16) * 144 + (32 * ss + 8 * quad) * 2); S[vt] = MFMA16(ka, vb, S[vt]); } }
#pragma unroll
        for (int vt = 0; vt < 8; ++vt) { S[vt] = S[vt] * dec;
            *(LAS u32x2*)(lds + H_S0T + (16 * vt + r16) * 272 + (16 * w + 4 * quad) * 2) = (u32x2){pk2(S[vt].x, S[vt].y), pk2(S[vt].z, S[vt].w)}; }
#pragma unroll
        for (int j = 0; j < 4; ++j) { const int vt = 4 * vh + j;
#pragma unroll
            for (int r = 0; r < 4; ++r) ((LAS float*)lds)[(16 * tt + 4 * quad + r) * 132 + 16 * vt + r16] = O[j][r]; }
        __syncthreads();
        { const int t = nt_, jj = njj;
          f32x4 o4[4]; float ss = 0.f;
#pragma unroll
          for (int i = 0; i < 4; ++i) { o4[i] = *(const LAS f32x4*)(lds + (t * 132 + 16 * jj + 4 * i) * 4); ss += (o4[i].x * o4[i].x + o4[i].y * o4[i].y) + (o4[i].z * o4[i].z + o4[i].w * o4[i].w); }
          ss += __shfl_xor(ss, 1); ss += __shfl_xor(ss, 2); ss += __shfl_xor(ss, 4);
          const float rstd = rsqrtf(ss * (1.0f / 128.0f) + RMS_EPS);
          { const size_t off = goff;
              const unsigned gw_[8] = {g0.x, g0.y, g0.z, g0.w, g1.x, g1.y, g1.z, g1.w};
              unsigned ow[8];
#pragma unroll
              for (int i = 0; i < 4; ++i) { const f32x4 n4 = nw4[i];
                  const float y0 = o4[i].x * rstd * n4.x * bf2f((unsigned short)(gw_[2 * i] & 0xffffu)), y1 = o4[i].y * rstd * n4.y * bf2f((unsigned short)(gw_[2 * i] >> 16));
                  const float y2 = o4[i].z * rstd * n4.z * bf2f((unsigned short)(gw_[2 * i + 1] & 0xffffu)), y3 = o4[i].w * rstd * n4.w * bf2f((unsigned short)(gw_[2 * i + 1] >> 16));
                  ow[2 * i] = pk2(y0, y1); ow[2 * i + 1] = pk2(y2, y3); }
              *(u32x4*)(OB + off) = (u32x4){ow[0], ow[1], ow[2], ow[3]}; *(u32x4*)(OB + off + 8) = (u32x4){ow[4], ow[5], ow[6], ow[7]}; }
        }
        }
    }
#undef HG_LOAD
    if (!full || sg == 3) {
        float* so = full ? p.out + OUT_SP + ((size_t)(b * 16 + h)) * 16384 : HU + (size_t)item * 16384;
#pragma unroll
        for (int vt = 0; vt < 8; ++vt)
#pragma unroll
            for (int r = 0; r < 4; ++r) { float* d_ = so + (16 * w + 4 * quad + r) * 128 + 16 * vt + r16; if (full) __builtin_nontemporal_store(S[vt][r], d_); else *d_ = S[vt][r]; }
        if (!full && r16 == 0) *(f32x4*)(HD + item * 128 + 16 * w + 4 * quad) = dprod;
    }
    __syncthreads();
}

constexpr int SS_Q = 0, SS_K = 4096, SS_V = 8192, SS_E8 = 12288, SS_A = 12800, SS_B = 13056, SS_QR = 17152, SS_PART = 25600;
struct SampRaw { float lf[2]; unsigned short q[2], v[2]; f32x4 s0[8]; };
__device__ __forceinline__ void hgrn_sample_load(const Params& p, int it, SampRaw& r) {
    int tid_l = threadIdx.x; asm volatile("" : "+v"(tid_l)); const int tid = tid_l, b = it >> 4, h = it & 15;
    const bf16_t* QB = (const bf16_t*)(p.ws + WS_QB); const float* LF = (const float*)(p.ws + WS_LF); const bf16_t* VB = (const bf16_t*)(p.ws + WS_VB);
    const size_t rbase = ((size_t)(MPR + b * 8)) * D + h * 128;
#pragma unroll
    for (int j = 0; j < 2; ++j) { const int rem = tid + 512 * j, t = rem >> 7, k = rem & 127; const size_t o = rbase + (size_t)t * D + k; r.lf[j] = __builtin_nontemporal_load(LF + o); r.q[j] = __builtin_nontemporal_load(QB + o); r.v[j] = __builtin_nontemporal_load(VB + o); }
    { const int v4 = tid & 31, kg = tid >> 5; const float* S0 = p.state + ((size_t)(b * 16 + h)) * 16384;
#pragma unroll
      for (int i = 0; i < 8; ++i) r.s0[i] = __builtin_nontemporal_load((const f32x4*)(S0 + (8 * kg + i) * 128 + 4 * v4)); }
}
__device__ __forceinline__ void hgrn_sample_item(const Params& p, LAS unsigned char* lds, int it, int it_next, SampRaw& raw) {
    int tid_l = threadIdx.x; asm volatile("" : "+v"(tid_l)); const int tid = tid_l, lane = tid & 63;
    const int b = it >> 4, h = it & 15;
    const bf16_t* GB = (const bf16_t*)(p.ws + WS_GB); bf16_t* OB = (bf16_t*)(p.ws + WS_OB);
    const size_t rbase = ((size_t)(MPR + b * 8)) * D + h * 128;
    LAS float* SQ = (LAS float*)(lds + SS_Q); LAS float* SK = (LAS float*)(lds + SS_K); LAS float* SV = (LAS float*)(lds + SS_V); LAS float* SE8 = (LAS float*)(lds + SS_E8);
    LAS float* SA = (LAS float*)(lds + SS_A); LAS float* SB = (LAS float*)(lds + SS_B); LAS float* SQR = (LAS float*)(lds + SS_QR);
    LAS float* PART = (LAS float*)(lds + SS_PART);
    const int v4 = tid & 31, kg = tid >> 5;
    const float* S0 = p.state + ((size_t)(b * 16 + h)) * 16384; float* S1 = p.out + OUT_SS + ((size_t)(b * 16 + h)) * 16384;
    f32x4 s0[8];
#pragma unroll
    for (int i = 0; i < 8; ++i) s0[i] = raw.s0[i];
    const size_t goff3 = rbase + (size_t)(tid >> 6) * D + 2 * lane;
    const unsigned g3 = __builtin_nontemporal_load((const unsigned*)(GB + goff3)); const f32x2v nw3 = *(const f32x2v*)(p.norm_w + h * 128 + 2 * lane);
#pragma unroll
    for (int j = 0; j < 2; ++j) { const int rem = tid + 512 * j; SB[rem] = raw.lf[j]; SQR[rem] = bf2f(raw.q[j]); SV[rem] = bf2f(raw.v[j]); }
    __syncthreads();
    if (it_next < 2048) hgrn_sample_load(p, it_next, raw);
    if (tid < 128) { const int k = tid; float lfv[8], bt[8]; float run = 1.f;
#pragma unroll
        for (int t = 0; t < 8; ++t) { lfv[t] = SB[t * 128 + k]; run *= lfv[t]; bt[t] = run; }
#pragma unroll
        for (int t = 0; t < 8; ++t) { SQ[k * 8 + t] = SQR[t * 128 + k] * bt[t]; SK[k * 8 + t] = (1.0f - lfv[t]) * __builtin_amdgcn_rcpf(bt[t]); }
        SE8[k] = run;
    }
    __syncthreads();
    { const int pair = tid >> 3, ks = tid & 7, t = pair >> 3, s = pair & 7; float a = 0.f;
#pragma unroll
        for (int i = 0; i < 16; ++i) a += SQ[(ks + 8 * i) * 8 + t] * SK[(ks + 8 * i) * 8 + s];
        a += __shfl_xor(a, 1); a += __shfl_xor(a, 2); a += __shfl_xor(a, 4);
        if (ks == 0) SA[pair] = (s <= t) ? a : 0.f; }
    {
        f32x4 vv[8], o[8];
#pragma unroll
        for (int s = 0; s < 8; ++s) { vv[s] = *(const LAS f32x4*)(SV + s * 128 + 4 * v4); o[s] = (f32x4){0.f, 0.f, 0.f, 0.f}; }
#pragma unroll
        for (int i = 0; i < 8; ++i) { const int k = 8 * kg + i;
            const f32x4 qa = *(const LAS f32x4*)(SQ + k * 8), qb = *(const LAS f32x4*)(SQ + k * 8 + 4), ka = *(const LAS f32x4*)(SK + k * 8), kb = *(const LAS f32x4*)(SK + k * 8 + 4);
            const float q8[8] = {qa.x, qa.y, qa.z, qa.w, qb.x, qb.y, qb.z, qb.w}, k8[8] = {ka.x, ka.y, ka.z, ka.w, kb.x, kb.y, kb.z, kb.w};
            f32x4 sn = s0[i];
#pragma unroll
            for (int t = 0; t < 8; ++t) { o[t] = o[t] + s0[i] * q8[t]; sn = sn + vv[t] * k8[t]; }
            __builtin_nontemporal_store(sn * SE8[k], (f32x4*)(S1 + k * 128 + 4 * v4)); }
#pragma unroll
        for (int t = 0; t < 8; ++t) *(LAS f32x4*)(PART + (kg * 8 + t) * 128 + 4 * v4) = o[t];
    }
    __syncthreads();
    { const int t = tid >> 6, vp = lane; f32x2v o2 = (f32x2v){0.f, 0.f};
#pragma unroll
        for (int g = 0; g < 16; ++g) o2 = o2 + *(const LAS f32x2v*)(PART + (g * 8 + t) * 128 + 2 * vp);
#pragma unroll
        for (int s = 0; s < 8; ++s) o2 = o2 + *(const LAS f32x2v*)(SV + s * 128 + 2 * vp) * SA[t * 8 + s];
        float ss = o2.x * o2.x + o2.y * o2.y;
#pragma unroll
        for (int m = 1; m < 64; m <<= 1) ss += __shfl_xor(ss, m);
        const float rstd = rsqrtf(ss * (1.0f / 128.0f) + RMS_EPS);
        const size_t off = rbase + (size_t)t * D + 2 * vp;
        const unsigned g = g3; const f32x2v nw = nw3;
        *(unsigned*)(OB + off) = pk2(o2.x * rstd * nw.x * bf2f((unsigned short)(g & 0xffffu)), o2.y * rstd * nw.y * bf2f((unsigned short)(g >> 16))); }
    __syncthreads();
}

__device__ __forceinline__ void phase_hgrn(const Params& p, LAS unsigned char* lds, const XcdBarrier& xb) {
    const int G = gridDim.x, blk = blockIdx.x;
    const bool early = (G == 256) && ((blk & 3) == 3); constexpr int NEARLY = 64 * 6;
    const int s_lo = (G == 256) ? NEARLY : 0;
    const bool swap = (G == 256) && (((blk >> 2) & 1) != 0);
    for (int stage = 0; stage < 2; ++stage) {
        for (int k = 0; k < 2; ++k) {
            const bool do_chain = (stage == 0) ? (k == 0) : ((k == 0) != swap);
            if (do_chain) { for (int it = blk; it < 256; it += G) hgrn_chain(p, lds, it, stage); }
            else {
                int it, step, end;
                if (stage == 0) { it = early ? (blk >> 2) : 4096; step = 64; end = NEARLY; } else { it = s_lo + blk; step = G; end = 2048; }
                SampRaw raw; if (it < end) hgrn_sample_load(p, it, raw);
                for (; it < end; it += step) hgrn_sample_item(p, lds, it, (it + step < end) ? it + step : 4096, raw);
            }
        }
        if (stage == 0) xcd_barrier(xb);
    }
}

constexpr int A_KS = 0, A_VT = 23040;
constexpr int ATT_PROMPT_ITEMS = NBP * 4 * 65, ATT_ITEMS = ATT_PROMPT_ITEMS + NBS * 4;
struct AttPre { u32x4 r[3][4]; };
__device__ __forceinline__ void attn_load(const Params& p, int it, AttPre& pre) {
    const int tid = threadIdx.x;
    const bf16_t* K1 = (const bf16_t*)(p.ws + WS_K1); const bf16_t* V1 = (const bf16_t*)(p.ws + WS_V1);
    const bool samp = it >= ATT_PROMPT_ITEMS;
    int b, kvh, t0 = 0;
    if (!samp) { b = it / 260; const int rem = it - b * 260; kvh = rem / 65; t0 = 32 * (rem - kvh * 65); } else { const int j = it - ATT_PROMPT_ITEMS; b = j >> 2; kvh = j & 3; }
#pragma unroll
    for (int u = 0; u < 3; ++u) { const int idx = tid + 512 * u;
        const int kA = idx >> 3, cA = idx & 7;
        const int cB = idx / 160, kB = idx - 160 * cB;
        const u32x4 z = (u32x4){0u, 0u, 0u, 0u}; pre.r[u][0] = z; pre.r[u][1] = z; pre.r[u][2] = z; pre.r[u][3] = z;
        if (idx < 1280) {
            if (!samp) { const int pA = t0 - 128 + kA, pB = t0 - 128 + kB;
                if (pA >= 0 && pA < TP) pre.r[u][0] = *(const u32x4*)(K1 + ((size_t)(b * TP + pA)) * 256 + kvh * 64 + 8 * cA);
                if (pB >= 0 && pB < TP) pre.r[u][1] = *(const u32x4*)(V1 + ((size_t)(b * TP + pB)) * 256 + kvh * 64 + 8 * cB); }
            else {
                if (kA < 128) { const size_t o = (((size_t)b * 128 + kA) * 4 + kvh) * 64 + 8 * cA; pre.r[u][0] = *(const u32x4*)(p.cache_k + o); pre.r[u][1] = *(const u32x4*)(p.cache_k + o + 4); }
                else if (kA < 136) pre.r[u][0] = *(const u32x4*)(K1 + ((size_t)(MPR + b * 8 + kA - 128)) * 256 + kvh * 64 + 8 * cA);
                if (kB < 128) { const size_t o = (((size_t)b * 128 + kB) * 4 + kvh) * 64 + 8 * cB; pre.r[u][2] = *(const u32x4*)(p.cache_v + o); pre.r[u][3] = *(const u32x4*)(p.cache_v + o + 4); }
                else if (kB < 136) pre.r[u][2] = *(const u32x4*)(V1 + ((size_t)(MPR + b * 8 + kB - 128)) * 256 + kvh * 64 + 8 * cB);
            }
        } }
}
__device__ __forceinline__ void attn_stage(LAS unsigned char* base, int itp, const AttPre& pre) {
    const int tid = threadIdx.x; const bool samp = itp >= ATT_PROMPT_ITEMS;
#pragma unroll
    for (int u = 0; u < 3; ++u) { const int idx = tid + 512 * u;
        const int kA = idx >> 3, cA = idx & 7, cB = idx / 160, kB = idx - 160 * cB;
        if (idx < 1280) {
            u32x4 kv = pre.r[u][0], vv = samp ? pre.r[u][2] : pre.r[u][1];
            if (samp && kA < 128) { const f32x4 a = __builtin_bit_cast(f32x4, pre.r[u][0]), bq = __builtin_bit_cast(f32x4, pre.r[u][1]); kv = (u32x4){pk2(a.x, a.y), pk2(a.z, a.w), pk2(bq.x, bq.y), pk2(bq.z, bq.w)}; }
            if (samp && kB < 128) { const f32x4 c = __builtin_bit_cast(f32x4, pre.r[u][2]), d = __builtin_bit_cast(f32x4, pre.r[u][3]); vv = (u32x4){pk2(c.x, c.y), pk2(c.z, c.w), pk2(d.x, d.y), pk2(d.z, d.w)}; }
            *(LAS u32x4*)(base + A_KS + kA * 144 + cA * 16) = kv;
            const unsigned vw[4] = {vv.x, vv.y, vv.z, vv.w};
#pragma unroll
            for (int j = 0; j < 4; ++j) { *(LAS unsigned short*)(base + A_VT + (8 * cB + 2 * j) * 336 + kB * 2) = (unsigned short)(vw[j] & 0xffffu);
                *(LAS unsigned short*)(base + A_VT + (8 * cB + 2 * j + 1) * 336 + kB * 2) = (unsigned short)(vw[j] >> 16); }
        } }
}
constexpr int ATT_BUF = 44544;
__device__ __forceinline__ void attn_item(const Params& p, LAS unsigned char* lds_all, int it, int it_n1, int it_n2, int cur, AttPre& pre) {
    int tid_l = threadIdx.x; asm volatile("" : "+v"(tid_l)); const int tid = tid_l, w = tid >> 6, lane = tid & 63, r16 = lane & 15, quad = lane >> 4;
    LAS unsigned char* lds = lds_all + cur * ATT_BUF; LAS unsigned char* ldsn = lds_all + (cur ^ 1) * ATT_BUF;
    const bf16_t* Q1 = (const bf16_t*)(p.ws + WS_QB);
    const bf16_t* GB = (const bf16_t*)(p.ws + WS_GB); bf16_t* OB = (bf16_t*)(p.ws + WS_OB);
    const bool samp = it >= ATT_PROMPT_ITEMS;
    int b, kvh, t0 = 0;
    if (!samp) { b = it / 260; const int rem = it - b * 260; kvh = rem / 65; t0 = 32 * (rem - kvh * 65); } else { const int j = it - ATT_PROMPT_ITEMS; b = j >> 2; kvh = j & 3; }
    const int hq = kvh * 8 + w;
    const float sink_raw = p.sinks[hq];
    bf16x8 qf[2][2]; bool qok[2]; size_t qrow[2];
#pragma unroll
    for (int tt = 0; tt < 2; ++tt) { const int i = 16 * tt + r16;
        if (!samp) { const int t = t0 + i; qok[tt] = t < TP; qrow[tt] = (size_t)(b * TP + (qok[tt] ? t : 0)); } else { qok[tt] = i < 8; qrow[tt] = (size_t)(MPR + b * 8 + (qok[tt] ? i : 0)); }
#pragma unroll
        for (int ds = 0; ds < 2; ++ds) { bf16x8 q = __builtin_nontemporal_load((const bf16x8*)(Q1 + qrow[tt] * D + hq * 64 + 32 * ds + 8 * quad)); if (!qok[tt]) q = (bf16x8){0, 0, 0, 0, 0, 0, 0, 0}; qf[tt][ds] = q; } }
    u32x4 gw[4]; size_t orow[4]; bool ook[4];
#pragma unroll
    for (int k = 0; k < 4; ++k) { const int i = 8 * k + (lane >> 3);
        if (!samp) { const int t = t0 + i; ook[k] = t < TP; orow[k] = (size_t)(b * TP + (ook[k] ? t : 0)); } else { ook[k] = i < 8; orow[k] = (size_t)(MPR + b * 8 + (ook[k] ? i : 0)); }
        gw[k] = __builtin_nontemporal_load((const u32x4*)(GB + orow[k] * D + hq * 64 + 8 * (lane & 7))); }
    __syncthreads();
    f32x4 st[10][2];
#pragma unroll
    for (int kt = 0; kt < 10; ++kt) { st[kt][0] = (f32x4){0.f, 0.f, 0.f, 0.f}; st[kt][1] = (f32x4){0.f, 0.f, 0.f, 0.f};
#pragma unroll
        for (int ds = 0; ds < 2; ++ds) { const bf16x8 ka = *(const LAS bf16x8*)(lds + A_KS + (16 * kt + r16) * 144 + (32 * ds + 8 * quad) * 2);
            st[kt][0] = MFMA16(ka, qf[0][ds], st[kt][0]); if (!samp) st[kt][1] = MFMA16(ka, qf[1][ds], st[kt][1]); } }
    const float sink = sink_raw * 1.44269504089f;
    const int kminv = samp ? 0 : (128 - t0 > 0 ? 128 - t0 : 0);
    const bool midfree = kminv <= 32;
    const int ntt = samp ? 1 : 2;
    bf16x8 pb[5][2]; float inv[2] = {0.f, 0.f};
#pragma unroll
    for (int tt = 0; tt < 2; ++tt) if (tt < ntt) { const int i = 16 * tt + r16; const int lo = (i + 1 > kminv) ? i + 1 : kminv, hi = i + 128;
        float m = -INFINITY;
#pragma unroll
        for (int kt = 0; kt < 10; ++kt) {
            if (kt >= 2 && kt < 8 && midfree) {
#pragma unroll
                for (int r = 0; r < 4; ++r) m = fmaxf(m, st[kt][tt][r]);
            } else {
#pragma unroll
                for (int r = 0; r < 4; ++r) { const int kp = 16 * kt + 4 * quad + r; const float s = (kp >= lo && kp <= hi) ? st[kt][tt][r] : -INFINITY; st[kt][tt][r] = s; m = fmaxf(m, s); }
            } }
        m = fmaxf(m, __shfl_xor(m, 16)); m = fmaxf(m, __shfl_xor(m, 32)); m = fmaxf(m, sink);
        float sum = 0.f;
#pragma unroll
        for (int kt = 0; kt < 10; ++kt)
#pragma unroll
            for (int r = 0; r < 4; ++r) { const float e = __builtin_amdgcn_exp2f(st[kt][tt][r] - m); st[kt][tt][r] = e; sum += e; }
        sum += __shfl_xor(sum, 16); sum += __shfl_xor(sum, 32); sum += __builtin_amdgcn_exp2f(sink - m);
        inv[tt] = __builtin_amdgcn_rcpf(sum);
#pragma unroll
        for (int ks = 0; ks < 5; ++ks) { const f32x4 a = st[2 * ks][tt], c = st[2 * ks + 1][tt];
            const u32x4 pw = (u32x4){pk2(a.x, a.y), pk2(a.z, a.w), pk2(c.x, c.y), pk2(c.z, c.w)}; pb[ks][tt] = __builtin_bit_cast(bf16x8, pw); }
    }
    if (it_n1 < ATT_ITEMS) attn_stage(ldsn, it_n1, pre);
    if (it_n2 < ATT_ITEMS) attn_load(p, it_n2, pre);
    f32x4 o[4][2];
#pragma unroll
    for (int dt = 0; dt < 4; ++dt) { o[dt][0] = (f32x4){0.f, 0.f, 0.f, 0.f}; o[dt][1] = (f32x4){0.f, 0.f, 0.f, 0.f}; }
#pragma unroll
    for (int ks = 0; ks < 5; ++ks)
#pragma unroll
        for (int dt = 0; dt < 4; ++dt) { const u32x2 l8 = *(const LAS u32x2*)(lds + A_VT + (16 * dt + r16) * 336 + (32 * ks + 4 * quad) * 2), h8 = *(const LAS u32x2*)(lds + A_VT + (16 * dt + r16) * 336 + (32 * ks + 16 + 4 * quad) * 2);
            const bf16x8 va = __builtin_bit_cast(bf16x8, (u32x4){l8.x, l8.y, h8.x, h8.y});
            o[dt][0] = MFMA16(va, pb[ks][0], o[dt][0]); if (ntt > 1) o[dt][1] = MFMA16(va, pb[ks][1], o[dt][1]); }
    LAS unsigned char* os = lds_all + 2 * ATT_BUF + w * 4608;
#pragma unroll
    for (int tt = 0; tt < 2; ++tt) if (tt < ntt) {
#pragma unroll
        for (int dt = 0; dt < 4; ++dt) { const f32x4 x = o[dt][tt] * inv[tt];
            *(LAS u32x2*)(os + (16 * tt + r16) * 144 + (16 * dt + 4 * quad) * 2) = (u32x2){pk2(x.x, x.y), pk2(x.z, x.w)}; } }
    LDS_WAIT();
#pragma unroll
    for (int k = 0; k < 4; ++k) if (k < 2 * ntt) { const int i = 8 * k + (lane >> 3);
        const u32x4 ov = *(const LAS u32x4*)(os + i * 144 + (lane & 7) * 16);
        const unsigned ow_[4] = {ov.x, ov.y, ov.z, ov.w}, gg[4] = {gw[k].x, gw[k].y, gw[k].z, gw[k].w}; unsigned rr[4];
#pragma unroll
        for (int j = 0; j < 4; ++j) rr[j] = pk2(__uint_as_float(ow_[j] << 16) * __uint_as_float(gg[j] << 16), __uint_as_float(ow_[j] & 0xffff0000u) * __uint_as_float(gg[j] & 0xffff0000u));
        if (ook[k]) *(u32x4*)(OB + orow[k] * D + hq * 64 + 8 * (lane & 7)) = (u32x4){rr[0], rr[1], rr[2], rr[3]}; }
    LDS_WAIT();
}
__device__ __forceinline__ int att_item_of(int blk, int r, int G) {
    if (G != 256) return blk + r * G;
    const int x = blk & 7, j = blk >> 3;
    if (r < 6) return 256 * r + 32 * x + j;
    return (r == 6 && x == 1 && j < 16) ? 1536 + j : ATT_ITEMS;
}

__global__ void __launch_bounds__(512, 2) fwd_megakernel(Params p) {
    extern __shared__ __attribute__((aligned(16))) unsigned char shm[];
    LAS unsigned char* lds = (LAS unsigned char*)shm;
    const int G = gridDim.x;
    if (threadIdx.x < 4) ((LAS unsigned*)(lds + 131072))[threadIdx.x] = 0u;
    __syncthreads();
    const XcdBarrier xb = xcd_barrier_post((unsigned*)(p.ws + WS_BAR), (volatile LAS unsigned*)(lds + 131072));
    bf16_t* XB = (bf16_t*)(p.ws + WS_XB); bf16_t* OB = (bf16_t*)(p.ws + WS_OB); bf16_t* QB = (bf16_t*)(p.ws + WS_QB); bf16_t* VB = (bf16_t*)(p.ws + WS_VB); bf16_t* GB = (bf16_t*)(p.ws + WS_GB);
    float* ZB = (float*)(p.ws + WS_ZB);
    phase0(p, lds);
    xcd_barrier(xb);
    { pg8::Gemm g{XB, (const bf16_t*)(p.ws + WS_WT0), MPAD, 8192, 2048}; pg8::StaticOrder S; S.init(MPAD, 8192, G, blockIdx.x);
      EpiHgrnIn E{p.ws, (float*)(p.ws + WS_LF), (const float*)(p.ws + WS_LB)};
      pg8::gemm_phase<EpiHgrnIn, pg8::StaticOrder, false>(lds, g, S, E, nullptr);
      const int heavy = (37 * 32) % G; const int li = heavy ? (int)blockIdx.x - heavy : (int)blockIdx.x;
      if (li >= 0) phase0_rest(p, lds, li, heavy ? G - heavy : G); }
    xcd_barrier(xb);
    phase_hgrn(p, lds, xb);
    xcd_barrier(xb);
    { pg8::Gemm g{OB, (const bf16_t*)(p.ws + WS_WTO0), MPAD, 2048, 2048}; OrderOut S; S.init(G, blockIdx.x);
      EpiY E{VB, (float*)(p.ws + WS_LF)};
      pg8::gemm_phase<EpiY, OrderOut, false>(lds, g, S, E, nullptr); }
    xcd_barrier(xb);
    phase_ln<1>(p, 0);
    xcd_barrier(xb);
    { pg8::Gemm g{XB, (const bf16_t*)(p.ws + WS_WT1), MPAD, 4608, 2048}; pg8::StaticOrder S; S.init(MPAD, 4608, G, blockIdx.x);
      EpiSwaIn E{QB, (bf16_t*)(p.ws + WS_K1), (bf16_t*)(p.ws + WS_V1), GB, p.out};
      pg8::gemm_phase<EpiSwaIn, pg8::StaticOrder, false>(lds, g, S, E, nullptr);
      const int heavy = (37 * 18) % G; const int li = heavy ? (int)blockIdx.x - heavy : (int)blockIdx.x;
      if (li >= 0) phase_cache_shift(p, li, heavy ? G - heavy : G); }
    xcd_barrier(xb);
    { AttPre pre; int it = att_item_of(blockIdx.x, 0, G), n1 = att_item_of(blockIdx.x, 1, G);
      if (it < ATT_ITEMS) { attn_load(p, it, pre); attn_stage(lds, it, pre); }
      if (n1 < ATT_ITEMS) attn_load(p, n1, pre);
      for (int r = 0; it < ATT_ITEMS; ++r) { const int n2 = (n1 < ATT_ITEMS) ? att_item_of(blockIdx.x, r + 2, G) : ATT_ITEMS; attn_item(p, lds, it, n1, n2, r & 1, pre); it = n1; n1 = n2; } }
    xcd_barrier(xb);
    { pg8::Gemm g{OB, (const bf16_t*)(p.ws + WS_WTO1), MPAD, 2048, 2048}; OrderOut S; S.init(G, blockIdx.x);
      EpiY E{VB, (float*)(p.ws + WS_LF)};
      pg8::gemm_phase<EpiY, OrderOut, false>(lds, g, S, E, nullptr); }
    xcd_barrier(xb);
    for (int rep = 0; rep < REP_LN; ++rep) phase_ln<2>(p, 1);
}

extern "C" void kernel_launch(void* const* d_in, const int* in_sizes, int n_in, void* d_out, int out_size, void* d_ws, size_t ws_size, hipStream_t stream) {
    static int grid_blocks = 0;
    if (!grid_blocks) {
        int dev = 0, cus = 0, per_cu = 0;
        hipGetDevice(&dev);
        hipDeviceGetAttribute(&cus, hipDeviceAttributeMultiprocessorCount, dev);
        hipFuncSetAttribute((const void*)fwd_megakernel, hipFuncAttributeMaxDynamicSharedMemorySize, LDS_BYTES);
        hipOccupancyMaxActiveBlocksPerMultiprocessor(&per_cu, (const void*)fwd_megakernel, 512, LDS_BYTES);
        if (per_cu < 1) { fprintf(stderr, "kernel_launch: occupancy query reports %d blocks/CU\n", per_cu); per_cu = 1; }
        grid_blocks = cus;
    }
    if (ws_size < WS_END) { fprintf(stderr, "kernel_launch: workspace too small (%zu < %zu)\n", ws_size, (size_t)WS_END); return; }
    Params p{};
    p.x_prompt = (const float*)d_in[0]; p.x_sample = (const float*)d_in[1]; p.state = (const float*)d_in[2]; p.cache_k = (const float*)d_in[3]; p.cache_v = (const float*)d_in[4];
    p.meta = (const float*)d_in[5]; p.w_in0 = (const float*)d_in[6]; p.lb_logits = (const float*)d_in[7]; p.norm_w = (const float*)d_in[8]; p.w_out0 = (const float*)d_in[9];
    p.w_in1 = (const float*)d_in[10]; p.sinks = (const float*)d_in[11]; p.w_out1 = (const float*)d_in[12]; p.ln_g = (const float*)d_in[13]; p.ln_b = (const float*)d_in[14];
    p.out = (float*)d_out; p.ws = (unsigned char*)d_ws;
    if (hipMemsetAsync((char*)d_ws + WS_BAR, 0, 16384, stream) != hipSuccess) { fprintf(stderr, "kernel_launch: memset of the barrier words failed\n"); return; }
    void* args[] = {&p};
    hipError_t e = hipLaunchCooperativeKernel((const void*)fwd_megakernel, dim3(grid_blocks), dim3(512), args, LDS_BYTES, stream);
    if (e != hipSuccess) fprintf(stderr, "cooperative launch failed: %s (grid %d)\n", hipGetErrorString(e), grid_blocks);
}
```
